# Optimizing an MI355X kernel written in HIP

```python
import math
import jax, jax.numpy as jnp
from jax import lax
import numpy as np

D_MODEL = 1024
BATCH = 4
SEQ = 8192
DEPTH = 1

HEAD_DIM = 64
N_HEADS_A = 8
N_HEADS_B = 8
WIDTH_A = N_HEADS_A * HEAD_DIM
WIDTH_B = N_HEADS_B * HEAD_DIM
ROPE_DIM = HEAD_DIM // 4
ROPE_THETA = 500000.0
IDX_HEADS = 8
IDX_DIM = 64
TOPK_MAX = 256
BLOCK_Q = 128
D_FF = 4 * D_MODEL
EPS = 1e-6
IN_SPLITS = (WIDTH_A, WIDTH_A, WIDTH_A,
             WIDTH_B, WIDTH_B, WIDTH_B,
             IDX_HEADS * IDX_DIM, IDX_DIM,
             IDX_HEADS,
             D_MODEL, D_MODEL)
IN_COLS = sum(IN_SPLITS)

kernel_name = "hybrid_dsa_stickbreaking_sqrelu_block"


def rmsnorm(x, g):
    x32 = x.astype(jnp.float32)
    y = x32 * lax.rsqrt(jnp.mean(x32 * x32, axis=-1, keepdims=True) + EPS)
    return (y * g.astype(jnp.float32)).astype(x.dtype)


def rope_tables(seq_len):
    pos = jnp.arange(seq_len, dtype=jnp.float32)
    inv_freq = ROPE_THETA ** (-jnp.arange(0, ROPE_DIM, 2, dtype=jnp.float32) / ROPE_DIM)
    ang = pos[:, None] * inv_freq[None, :]
    return jnp.cos(ang), jnp.sin(ang)


def partial_rope(x, cos, sin):
    half = ROPE_DIM // 2
    x1 = x[..., :half]
    x2 = x[..., half:ROPE_DIM]
    cos = cos.astype(x.dtype)
    sin = sin.astype(x.dtype)
    return jnp.concatenate([x1 * cos - x2 * sin, x2 * cos + x1 * sin, x[..., ROPE_DIM:]], axis=-1)


def to_blocks(a, nblk):
    return a.reshape((a.shape[0], nblk, BLOCK_Q) + a.shape[2:]).swapaxes(0, 1)


def from_blocks(a):
    a = a.swapaxes(0, 1)
    return a.reshape((a.shape[0], a.shape[1] * a.shape[2]) + a.shape[3:])


def token_mixers(q_a, k_a, v_a, q_b, k_b, v_b, q_i, k_i, w_i):
    L = q_a.shape[1]
    nblk = L // BLOCK_Q
    topk = min(TOPK_MAX, L // 4)
    f32 = jnp.float32
    key_pos = jnp.arange(L, dtype=jnp.int32)
    scale = HEAD_DIM ** -0.5
    idx_scale = (IDX_DIM ** -0.5) * (IDX_HEADS ** -0.5)

    def block_fn(args):
        qa, qi, wi, qb, t0 = args
        t = t0 + jnp.arange(BLOCK_Q, dtype=jnp.int32)
        rel = jax.nn.relu(jnp.einsum('bqhd,bsd->bqhs', qi, k_i).astype(f32))
        isc = jnp.einsum('bqhs,bqh->bqs', rel, wi.astype(f32)) * idx_scale
        causal = key_pos[None, :] <= t[:, None]
        isc = jnp.where(causal[None], isc, -jnp.inf)
        _, sel = lax.top_k(isc, topk)
        valid = sel <= t[None, :, None]
        kg = jax.vmap(lambda kb, ib: kb[ib])(k_a, sel)
        vg = jax.vmap(lambda vb, ib: vb[ib])(v_a, sel)
        logit = jnp.einsum('bqhd,bqkhd->bqhk', qa, kg).astype(f32) * scale
        logit = jnp.where(valid[:, :, None, :], logit, -jnp.inf)
        p = jax.nn.softmax(logit, axis=-1).astype(vg.dtype)
        oa = jnp.einsum('bqhk,bqkhd->bqhd', p, vg)
        z = jnp.einsum('bqhd,bshd->bhqs', qb, k_b).astype(f32) * scale
        strict = (key_pos[None, :] < t[:, None])[None, None]
        log_1mb = jnp.where(strict, jax.nn.log_sigmoid(-z), 0.0)
        after = lax.cumsum(log_1mb, axis=3, reverse=True) - log_1mb
        att = jnp.where(strict, jnp.exp(jax.nn.log_sigmoid(z) + after), 0.0)
        ob = jnp.einsum('bhqs,bshd->bqhd', att.astype(v_b.dtype), v_b)
        return oa, ob

    starts = jnp.arange(nblk, dtype=jnp.int32) * BLOCK_Q
    oa, ob = lax.map(block_fn, (to_blocks(q_a, nblk), to_blocks(q_i, nblk),
                                to_blocks(w_i, nblk), to_blocks(q_b, nblk), starts))
    return from_blocks(oa), from_blocks(ob)


def setup_inputs(seed: int = 0) -> dict:
    key = jax.random.key(seed)
    ks = jax.random.split(key, 16)
    f32 = jnp.float32
    nrm = lambda k, shape, fan_in: jax.random.normal(k, shape, f32) * (fan_in ** -0.5)
    gain = lambda k: 1.0 + 0.05 * jax.random.normal(k, (DEPTH, D_MODEL), f32)
    return {
        "x": jax.random.normal(ks[0], (BATCH, SEQ, D_MODEL), f32),
        "c": jax.random.normal(ks[1], (BATCH, D_MODEL), f32),
        "w_ada": nrm(ks[2], (DEPTH, D_MODEL, 6 * D_MODEL), D_MODEL),
        "b_ada": 0.01 * jax.random.normal(ks[3], (DEPTH, 6 * D_MODEL), f32),
        "g_pre_mix": gain(ks[4]),
        "w_in": nrm(ks[5], (DEPTH, D_MODEL, IN_COLS), D_MODEL),
        "w_up_a": nrm(ks[6], (DEPTH, WIDTH_A, D_MODEL), WIDTH_A),
        "w_up_b": nrm(ks[7], (DEPTH, WIDTH_B, D_MODEL), WIDTH_B),
        "w_out": nrm(ks[8], (DEPTH, D_MODEL, D_MODEL), D_MODEL),
        "g_post_mix": gain(ks[9]),
        "g_pre_ffn": gain(ks[10]),
        "w_ff1": nrm(ks[11], (DEPTH, D_MODEL, D_FF), D_MODEL),
        "w_ff2": nrm(ks[12], (DEPTH, D_FF, D_MODEL), D_FF),
        "g_post_ffn": gain(ks[13]),
    }


def reference(x, c, w_ada, b_ada, g_pre_mix, w_in, w_up_a, w_up_b, w_out, g_post_mix,
              g_pre_ffn, w_ff1, w_ff2, g_post_ffn):
    B, L, D = x.shape
    cos, sin = rope_tables(L)
    cos_h, sin_h = cos[:, None, :], sin[:, None, :]
    split_at = list(np.cumsum(IN_SPLITS)[:-1])
    for l in range(DEPTH):
        mod = jax.nn.silu(c) @ w_ada[l] + b_ada[l]
        sh1, sc1, ga1, sh2, sc2, ga2 = [m[:, None, :] for m in jnp.split(mod, 6, axis=-1)]

        h = rmsnorm(x, g_pre_mix[l]) * (1.0 + sc1) + sh1
        proj = h @ w_in[l]
        qa, ka, va, qb, kb, vb, qi, ki, wi, gate_a, gate_b = jnp.split(proj, split_at, axis=-1)
        heads = lambda t, n: t.reshape(B, L, n, HEAD_DIM)
        qa = partial_rope(heads(qa, N_HEADS_A), cos_h, sin_h)
        ka = partial_rope(heads(ka, N_HEADS_A), cos_h, sin_h)
        va = heads(va, N_HEADS_A)
        qb, kb, vb = heads(qb, N_HEADS_B), heads(kb, N_HEADS_B), heads(vb, N_HEADS_B)
        qi = partial_rope(qi.reshape(B, L, IDX_HEADS, IDX_DIM), cos_h, sin_h)
        ki = partial_rope(ki, cos, sin)
        oa, ob = token_mixers(qa, ka, va, qb, kb, vb, qi, ki, wi)
        ya = oa.reshape(B, L, WIDTH_A) @ w_up_a[l]
        yb = ob.reshape(B, L, WIDTH_B) @ w_up_b[l]
        merged = jax.nn.sigmoid(gate_a) * ya + jax.nn.sigmoid(gate_b) * yb
        y = merged @ w_out[l]
        x = x + ga1 * rmsnorm(y, g_post_mix[l])

        h = rmsnorm(x, g_pre_ffn[l]) * (1.0 + sc2) + sh2
        u = jax.nn.relu(h @ w_ff1[l])
        y = (u * u) @ w_ff2[l]
        x = x + ga2 * rmsnorm(y, g_post_ffn[l])
    return x
```

```cpp
#include <hip/hip_runtime.h>
#include <hip/hip_cooperative_groups.h>
#include <cstdio>
#include <cstdint>
namespace cg = cooperative_groups;

#ifndef MK_SINGLE
#define MK_SINGLE 1
#endif
#define DIAG 0

#define LAS __attribute__((address_space(3)))
typedef _Float16 f16;
typedef _Float16 f16x2 __attribute__((ext_vector_type(2)));
typedef _Float16 f16x8 __attribute__((ext_vector_type(8)));
typedef float f32x2 __attribute__((ext_vector_type(2)));
typedef float f32x4 __attribute__((ext_vector_type(4)));
typedef unsigned u32x4 __attribute__((ext_vector_type(4)));
typedef unsigned u32x2 __attribute__((ext_vector_type(2)));

constexpr int BATCH = 4, SEQ = 8192, DM = 1024, M = BATCH * SEQ, DFF = 4096;
constexpr int NPROJ = 5888;
constexpr float EPS = 1e-6f;
constexpr int TOPK = 256;

constexpr size_t MiB = 1u << 20;
constexpr size_t WS_WIN = 0, WS_WUPA = 12 * MiB, WS_WUPB = 13 * MiB, WS_WOUT = 14 * MiB, WS_WFF1 = 16 * MiB, WS_WFF2 = 24 * MiB;
constexpr size_t WS_MOD = 32 * MiB, WS_ROPE = 33 * MiB;
constexpr size_t WS_H = 40 * MiB;
constexpr size_t WS_KA = 104 * MiB, WS_VA = 136 * MiB, WS_KB = 168 * MiB, WS_VB = 200 * MiB, WS_QI = 232 * MiB, WS_QA = 264 * MiB, WS_QB = 296 * MiB;
constexpr size_t WS_GA = 328 * MiB, WS_GB = 392 * MiB, WS_KI = 456 * MiB, WS_WI = 460 * MiB;
constexpr size_t WS_OA = 40 * MiB, WS_OB = 72 * MiB;
constexpr size_t WS_T1 = 104 * MiB, WS_MG = 168 * MiB, WS_Y = 232 * MiB, WS_U = 104 * MiB, WS_Y2 = 360 * MiB;
constexpr size_t WS_END = 512 * MiB;

constexpr int LDS_BYTES = 147456;
constexpr int NTHREADS = 512;

namespace pg8 {
constexpr int BM = 256, BK = 64, HALF = 128, HTB = HALF * BK * 2, STAGE_BYTES = 8 * HTB, NXCD = 8, WGM = 8;
__host__ __device__ __forceinline__ int lds_byte(int r, int c) { const int st = (r >> 4) * 2 + (c >> 5), rr = r & 15, cc = c & 31, ob = rr * 64 + cc * 2; return st * 1024 + (ob ^ (((ob >> 9) & 1) << 5)); }
__host__ __device__ __forceinline__ void stage_rc(int b, int& R, int& C) { const int st = b / 1024, sb = b % 1024, swz = sb ^ (((sb >> 9) & 1) << 5); R = (st >> 1) * 16 + swz / 64; C = (st & 1) * 32 + (swz % 64) / 2; }
__host__ __device__ __forceinline__ int perm32(int rho) { const int n = rho >> 4, i = rho & 15; return 8 * (i >> 2) + 4 * n + (i & 3); }

struct Unit { int pm, pn; };
struct Gemm { const f16* A; const f16* Bt; int M, N, K; };

struct StaticOrder {
    int nM, nN, nwg, G, c;
    __host__ __device__ void init(int M_, int N_, int G_, int c_) { nM = M_ / BM; nN = N_ / BM; nwg = nM * nN; G = G_; c = c_; }
    __host__ __device__ bool next(int i, Unit& u) const {
        const long L = (long)i * G + c; if (L >= nwg) return false;
        int wgid = (int)L; { const int q = nwg / NXCD, r = nwg % NXCD, xcd = wgid % NXCD, off = wgid / NXCD; wgid = (xcd < r ? xcd * (q + 1) : r * (q + 1) + (xcd - r) * q) + off; }
        const int nig = WGM * nN, gid = wgid / nig, fm = gid * WGM, gsz = (nM - fm) < WGM ? (nM - fm) : WGM;
        u.pm = fm + ((wgid % nig) % gsz); u.pn = (wgid % nig) / gsz; return true;
    }
};

template <class Epi>
__device__ __forceinline__ void gemm_phase(LAS unsigned char* lds, const Gemm g, const StaticOrder& S, const Epi& E) {
    const int tid = threadIdx.x, wid = __builtin_amdgcn_readfirstlane(tid >> 6), lane = tid & 63, wr = wid >> 2, wc = wid & 3, fr = lane & 15, fq = lane >> 4;
    const int K = g.K, nt = K / BK;
    unsigned voffA[2], voffB[2];
#pragma unroll
    for (int i = 0; i < 2; ++i) { int R, C; stage_rc(tid * 16 + i * 8192, R, C); const int Rb = Epi::PERM ? ((R & ~31) + perm32(R & 31)) : R;
        voffA[i] = (unsigned)(R * K + C) * 2u; voffB[i] = (unsigned)(Rb * K + C) * 2u; }
    const size_t kstep = (size_t)(BK * 2);
    const size_t hstep = (size_t)HALF * K * 2;
    const size_t tstep = 2 * hstep;
    const unsigned ldsw = (unsigned)wid * 1024u;
    const int aoff = lds_byte(wr * 64 + fr, fq * 8), boff = lds_byte(wc * 32 + fr, fq * 8);
#define PG8_SA(b, h) (((b) * 2 + (h)) * HTB)
#define PG8_SB(b, h) ((4 + (b) * 2 + (h)) * HTB)
#define PG8_STAGE(bufoff, gbase, voff) do { _Pragma("unroll") for (int _i = 0; _i < 2; ++_i) \
        __builtin_amdgcn_global_load_lds((const unsigned*)((const char*)(gbase) + (voff)[_i]), (LAS unsigned*)(lds + (bufoff) + ldsw + _i * 8192), 16, 0, 0); } while (0)
#define PG8_LDA(dst, b, h) do { _Pragma("unroll") for (int m = 0; m < 4; ++m) _Pragma("unroll") for (int k = 0; k < 2; ++k) dst[m][k] = *(const LAS f16x8*)(lds + PG8_SA(b, h) + aoff + m * 2048 + k * 1024); } while (0)
#define PG8_LDB(dst, b, h) do { _Pragma("unroll") for (int n = 0; n < 2; ++n) _Pragma("unroll") for (int k = 0; k < 2; ++k) dst[n][k] = *(const LAS f16x8*)(lds + PG8_SB(b, h) + boff + n * 2048 + k * 1024); } while (0)
#define PG8_MMA(ai, bj, At, Bt) do { __builtin_amdgcn_s_setprio(1); _Pragma("unroll") for (int m = 0; m < 4; ++m) _Pragma("unroll") for (int n = 0; n < 2; ++n) _Pragma("unroll") for (int k = 0; k < 2; ++k) \
        acc[ai][bj][m][n] = __builtin_amdgcn_mfma_f32_16x16x32_f16(Bt[n][k], At[m][k], acc[ai][bj][m][n], 0, 0, 0); __builtin_amdgcn_s_setprio(0); } while (0)
#define PG8_WAIT_V(n) asm volatile("s_waitcnt vmcnt(" #n ")" ::: "memory")
#define PG8_WAIT_L(n) asm volatile("s_waitcnt lgkmcnt(" #n ")" ::: "memory")
#define PG8_BAR __builtin_amdgcn_s_barrier()
#define PG8_SCHED __builtin_amdgcn_sched_barrier(0)
    Unit cur, nxt; int ui = 0;
    if (!S.next(0, cur)) return;
    f32x4 acc[2][2][4][2];
#pragma unroll
    for (int a = 0; a < 2; ++a)
#pragma unroll
        for (int b = 0; b < 2; ++b)
#pragma unroll
            for (int m = 0; m < 4; ++m)
#pragma unroll
                for (int n = 0; n < 2; ++n) acc[a][b][m][n] = (f32x4){0.f, 0.f, 0.f, 0.f};
    f16x8 At[4][2], B0[2][2], B1[2][2];
    const char* cA = (const char*)g.A + (size_t)cur.pm * tstep; const char* cB = (const char*)g.Bt + (size_t)cur.pn * tstep;
    {
        PG8_STAGE(PG8_SB(0, 0), cB, voffB); PG8_STAGE(PG8_SB(0, 1), cB + hstep, voffB); PG8_STAGE(PG8_SA(0, 0), cA, voffA); PG8_STAGE(PG8_SA(0, 1), cA + hstep, voffA);
        if (wr == 1) PG8_BAR;
        PG8_WAIT_V(2); PG8_BAR;
        PG8_STAGE(PG8_SB(1, 0), cB + kstep, voffB); PG8_STAGE(PG8_SA(1, 0), cA + kstep, voffA); PG8_STAGE(PG8_SB(1, 1), cB + hstep + kstep, voffB);
        PG8_WAIT_V(6); PG8_BAR;
    }
    for (;;) {
        const bool has_next = S.next(ui + 1, nxt);
        const char* nA = has_next ? (const char*)g.A + (size_t)nxt.pm * tstep : cA; const char* nB = has_next ? (const char*)g.Bt + (size_t)nxt.pn * tstep : cB;
        for (int t = 0; t < nt; t += 2) {
            const bool last = (t == nt - 2);
            const char* a1 = cA + (size_t)(t + 1) * kstep;
            const char* a2 = last ? nA : cA + (size_t)(t + 2) * kstep; const char* b2 = last ? nB : cB + (size_t)(t + 2) * kstep;
            const char* a3 = a2 + kstep; const char* b3 = b2 + kstep;
            PG8_LDB(B0, 0, 0); PG8_LDB(B1, 0, 1); PG8_SCHED; PG8_LDA(At, 0, 0); PG8_STAGE(PG8_SA(1, 1), a1 + hstep, voffA);
            PG8_WAIT_V(8); PG8_WAIT_L(0); PG8_BAR; PG8_MMA(0, 0, At, B0); PG8_MMA(0, 1, At, B1); PG8_BAR; PG8_SCHED;
            PG8_LDA(At, 0, 1); PG8_STAGE(PG8_SB(0, 0), b2, voffB); PG8_STAGE(PG8_SB(0, 1), b2 + hstep, voffB); PG8_STAGE(PG8_SA(0, 0), a2, voffA);
            PG8_WAIT_V(8); PG8_WAIT_L(0); PG8_BAR; PG8_MMA(1, 0, At, B0); PG8_MMA(1, 1, At, B1); PG8_BAR; PG8_SCHED;
            PG8_LDB(B0, 1, 0); PG8_LDB(B1, 1, 1); PG8_SCHED; PG8_LDA(At, 1, 0); PG8_STAGE(PG8_SA(0, 1), a2 + hstep, voffA);
            PG8_WAIT_V(8); PG8_WAIT_L(0); PG8_BAR; PG8_MMA(0, 0, At, B0); PG8_MMA(0, 1, At, B1); PG8_BAR; PG8_SCHED;
            PG8_LDA(At, 1, 1); PG8_STAGE(PG8_SB(1, 0), b3, voffB); PG8_STAGE(PG8_SB(1, 1), b3 + hstep, voffB); PG8_STAGE(PG8_SA(1, 0), a3, voffA);
            PG8_WAIT_V(8); PG8_WAIT_L(0); PG8_BAR; PG8_MMA(1, 0, At, B0); PG8_MMA(1, 1, At, B1); PG8_BAR; PG8_SCHED;
        }
        if (wr == 0) PG8_BAR;
        E(acc, cur, wr, wc, fr, fq);
        if (!has_next) break;
#pragma unroll
        for (int a = 0; a < 2; ++a)
#pragma unroll
            for (int b = 0; b < 2; ++b)
#pragma unroll
                for (int m = 0; m < 4; ++m)
#pragma unroll
                    for (int n = 0; n < 2; ++n) acc[a][b][m][n] = (f32x4){0.f, 0.f, 0.f, 0.f};
        cur = nxt; cA = nA; cB = nB; ++ui;
        if (wr == 1) PG8_BAR;
    }
    PG8_WAIT_V(0);
    PG8_BAR;
#undef PG8_SA
#undef PG8_SB
#undef PG8_STAGE
#undef PG8_LDA
#undef PG8_LDB
#undef PG8_MMA
#undef PG8_WAIT_V
#undef PG8_WAIT_L
#undef PG8_BAR
#undef PG8_SCHED
}
}

__device__ __forceinline__ unsigned pkh(float lo, float hi) { f32x2 v = {lo, hi}; f16x2 h = __builtin_convertvector(v, f16x2); return __builtin_bit_cast(unsigned, h); }
__device__ __forceinline__ f32x2 unpkh(unsigned u) { f16x2 h = __builtin_bit_cast(f16x2, u); return __builtin_convertvector(h, f32x2); }
__device__ __forceinline__ float sigmoidf_(float x) { return 1.f / (1.f + __expf(-x)); }
__device__ __forceinline__ f16x2 ash2(unsigned u) { return __builtin_bit_cast(f16x2, u); }
__device__ __forceinline__ float dot2x4(u32x4 a, u32x4 b, float d) {
    const unsigned a0 = a.x, a1 = a.y, a2 = a.z, a3 = a.w, b0 = b.x, b1 = b.y, b2 = b.z, b3 = b.w;
    d = __builtin_amdgcn_fdot2(ash2(a0), ash2(b0), d, false);
    d = __builtin_amdgcn_fdot2(ash2(a1), ash2(b1), d, false);
    d = __builtin_amdgcn_fdot2(ash2(a2), ash2(b2), d, false);
    d = __builtin_amdgcn_fdot2(ash2(a3), ash2(b3), d, false);
    return d;
}
__device__ __forceinline__ float wave_sum(float v) {
#pragma unroll
    for (int o = 1; o < 64; o <<= 1) v += __shfl_xor(v, o);
    return v;
}
__device__ __forceinline__ float wave_max(float v) {
#pragma unroll
    for (int o = 1; o < 64; o <<= 1) v = fmaxf(v, __shfl_xor(v, o));
    return v;
}
__device__ __forceinline__ unsigned fkey(float f) { const unsigned u = __float_as_uint(f); return (u & 0x80000000u) ? ~u : (u | 0x80000000u); }

struct Ctx {
    const float *x, *c, *w_ada, *b_ada, *g_pre_mix, *w_in, *w_up_a, *w_up_b, *w_out, *g_post_mix, *g_pre_ffn, *w_ff1, *w_ff2, *g_post_ffn;
    float* out; unsigned char* ws;
    int G, vcu;
};

struct EpiProj {
    static constexpr bool PERM = true;
    unsigned char* ws;
    __device__ __forceinline__ void operator()(const f32x4 (&acc)[2][2][4][2], const pg8::Unit& u, int wr, int wc, int fr, int fq) const {
        const int pn = u.pn, rowb = u.pm * 256 + wr * 64 + fr;
        const float* RC = (const float*)(ws + WS_ROPE); const float* RS = RC + SEQ * 8;
        f16* base; int ld, colb; bool rope = false; float sc = 1.f; int nbj = 2;
        if (pn < 14) {
            const int t = pn >> 1;
            const size_t off = (t == 0) ? WS_QA : (t == 1) ? WS_KA : (t == 2) ? WS_VA : (t == 3) ? WS_QB : (t == 4) ? WS_KB : (t == 5) ? WS_VB : WS_QI;
            base = (f16*)(ws + off); ld = 512; colb = (pn & 1) * 256 + wc * 32 + 8 * fq;
            rope = (t == 0 || t == 1 || t == 6) && ((wc & 1) == 0);
            sc = (t == 0 || t == 3) ? 0.125f : 1.f;
        } else if (pn < 22) {
            base = (f16*)(ws + (pn < 18 ? WS_GA : WS_GB)); ld = 1024; colb = ((pn - 14) & 3) * 256 + wc * 32 + 8 * fq;
        } else {
            nbj = 1;
            if (wc >= 2) {
                if (wc == 2 && fq == 0) {
                    float* WI = (float*)(ws + WS_WI);
#pragma unroll
                    for (int ai = 0; ai < 2; ++ai)
#pragma unroll
                        for (int m = 0; m < 4; ++m) { const int row = rowb + ai * 128 + m * 16;
                            *(f32x4*)(WI + (size_t)row * 8) = acc[ai][0][m][0]; *(f32x4*)(WI + (size_t)row * 8 + 4) = acc[ai][0][m][1]; }
                }
                return;
            }
            base = (f16*)(ws + WS_KI); ld = 64; colb = wc * 32 + 8 * fq; rope = (wc == 0);
        }
        const float sgn = (fq == 0) ? -1.f : 1.f;
#pragma unroll
        for (int ai = 0; ai < 2; ++ai)
#pragma unroll
            for (int m = 0; m < 4; ++m) {
                const int row = rowb + ai * 128 + m * 16, pos = row & (SEQ - 1);
                f32x4 c0 = {1.f, 1.f, 1.f, 1.f}, c1 = c0, s0 = {0.f, 0.f, 0.f, 0.f}, s1 = s0;
                if (rope) { c0 = *(const f32x4*)(RC + pos * 8); c1 = *(const f32x4*)(RC + pos * 8 + 4); s0 = *(const f32x4*)(RS + pos * 8); s1 = *(const f32x4*)(RS + pos * 8 + 4); }
#pragma unroll
                for (int bj = 0; bj < 2; ++bj) { if (bj < nbj) {
                    f32x4 v0 = acc[ai][bj][m][0], v1 = acc[ai][bj][m][1];
                    if (rope) {
                        f32x4 p0, p1;
#pragma unroll
                        for (int i = 0; i < 4; ++i) { p0[i] = __shfl_xor(v0[i], 16); p1[i] = __shfl_xor(v1[i], 16); }
                        if (fq < 2) { v0 = v0 * c0 + (p0 * s0) * sgn; v1 = v1 * c1 + (p1 * s1) * sgn; }
                    }
                    v0 = v0 * sc; v1 = v1 * sc;
                    u32x4 w; w.x = pkh(v0[0], v0[1]); w.y = pkh(v0[2], v0[3]); w.z = pkh(v1[0], v1[1]); w.w = pkh(v1[2], v1[3]);
                    *(u32x4*)(base + (size_t)row * ld + colb + bj * 128) = w; } }
            }
    }
};

template <int MODE>
struct EpiGate {
    static constexpr bool PERM = true;
    const f16* G; const f16* T1; f16* O;
    __device__ __forceinline__ void operator()(const f32x4 (&acc)[2][2][4][2], const pg8::Unit& u, int wr, int wc, int fr, int fq) const {
        const int rowb = u.pm * 256 + wr * 64 + fr, colb = u.pn * 256 + wc * 32 + 8 * fq;
#pragma unroll
        for (int ai = 0; ai < 2; ++ai)
#pragma unroll
            for (int m = 0; m < 4; ++m) { const size_t ro = (size_t)(rowb + ai * 128 + m * 16) * 1024 + colb;
#pragma unroll
                for (int bj = 0; bj < 2; ++bj) {
                    const u32x4 gw = *(const u32x4*)(G + ro + bj * 128);
                    f32x2 g0 = unpkh(gw.x), g1 = unpkh(gw.y), g2 = unpkh(gw.z), g3 = unpkh(gw.w);
                    const f32x4 a0 = acc[ai][bj][m][0], a1 = acc[ai][bj][m][1];
                    float r[8] = {sigmoidf_(g0.x) * a0[0], sigmoidf_(g0.y) * a0[1], sigmoidf_(g1.x) * a0[2], sigmoidf_(g1.y) * a0[3],
                                  sigmoidf_(g2.x) * a1[0], sigmoidf_(g2.y) * a1[1], sigmoidf_(g3.x) * a1[2], sigmoidf_(g3.y) * a1[3]};
                    if (MODE == 1) { const u32x4 tw = *(const u32x4*)(T1 + ro + bj * 128);
                        f32x2 t0 = unpkh(tw.x), t1 = unpkh(tw.y), t2 = unpkh(tw.z), t3 = unpkh(tw.w);
                        r[0] += t0.x; r[1] += t0.y; r[2] += t1.x; r[3] += t1.y; r[4] += t2.x; r[5] += t2.y; r[6] += t3.x; r[7] += t3.y; }
                    u32x4 w; w.x = pkh(r[0], r[1]); w.y = pkh(r[2], r[3]); w.z = pkh(r[4], r[5]); w.w = pkh(r[6], r[7]);
                    *(u32x4*)(O + ro + bj * 128) = w; } }
    }
};

struct EpiSqRelu {
    static constexpr bool PERM = true;
    f16* O; int ldc;
    __device__ __forceinline__ void operator()(const f32x4 (&acc)[2][2][4][2], const pg8::Unit& u, int wr, int wc, int fr, int fq) const {
        const int rowb = u.pm * 256 + wr * 64 + fr, colb = u.pn * 256 + wc * 32 + 8 * fq;
#pragma unroll
        for (int ai = 0; ai < 2; ++ai)
#pragma unroll
            for (int m = 0; m < 4; ++m) { const size_t ro = (size_t)(rowb + ai * 128 + m * 16) * ldc + colb;
#pragma unroll
                for (int bj = 0; bj < 2; ++bj) {
                    f32x4 a0 = acc[ai][bj][m][0], a1 = acc[ai][bj][m][1];
#pragma unroll
                    for (int i = 0; i < 4; ++i) { a0[i] = fmaxf(a0[i], 0.f); a1[i] = fmaxf(a1[i], 0.f); }
                    a0 = a0 * a0; a1 = a1 * a1;
                    u32x4 w; w.x = pkh(a0[0], a0[1]); w.y = pkh(a0[2], a0[3]); w.z = pkh(a1[0], a1[1]); w.w = pkh(a1[2], a1[3]);
                    *(u32x4*)(O + ro + bj * 128) = w; } }
    }
};

struct EpiF32 {
    static constexpr bool PERM = false;
    float* C; int ldc;
    __device__ __forceinline__ void operator()(const f32x4 (&acc)[2][2][4][2], const pg8::Unit& u, int wr, int wc, int fr, int fq) const {
        const int row0 = u.pm * 256 + wr * 64 + fr, col0 = u.pn * 256 + wc * 32 + 4 * fq;
#pragma unroll
        for (int ai = 0; ai < 2; ++ai)
#pragma unroll
            for (int m = 0; m < 4; ++m) { float* rowp = C + (size_t)(row0 + ai * 128 + m * 16) * ldc + col0;
#pragma unroll
                for (int bj = 0; bj < 2; ++bj)
#pragma unroll
                    for (int n = 0; n < 2; ++n) *(f32x4*)(rowp + bj * 128 + n * 16) = acc[ai][bj][m][n]; }
    }
};

__device__ __forceinline__ int win_src(int n) {
    if (n < 3584) return n;
    if (n < 5632) return n + 72;
    if (n < 5704) return n - 5632 + 3584;
    return -1;
}
template <bool MAP>
__device__ __forceinline__ void p0_transpose_item(const float* W, int K, int N, f16* WT, LAS float* scr, int nblk, int item, int lane) {
    const int kb = item / nblk, nb = item % nblk, k0 = 64 * kb, n0 = 32 * nb;
    const int nd = n0 + (lane & 31); const int sc = MAP ? win_src(nd) : nd;
#pragma unroll 8
    for (int i = 0; i < 32; ++i) { const int kk = 2 * i + (lane >> 5); scr[kk * 33 + (lane & 31)] = (sc >= 0) ? W[(size_t)(k0 + kk) * N + sc] : 0.f; }
    asm volatile("s_waitcnt lgkmcnt(0)" ::: "memory");
    const int c = lane & 7;
#pragma unroll
    for (int j = 0; j < 4; ++j) { const int n = (lane >> 3) + 8 * j; const LAS float* s = scr + (8 * c) * 33 + n;
        u32x4 o; o.x = pkh(s[0 * 33], s[1 * 33]); o.y = pkh(s[2 * 33], s[3 * 33]); o.z = pkh(s[4 * 33], s[5 * 33]); o.w = pkh(s[6 * 33], s[7 * 33]);
        *(u32x4*)(WT + (size_t)(n0 + n) * K + k0 + 8 * c) = o; }
    asm volatile("s_waitcnt lgkmcnt(0)" ::: "memory");
}

__device__ __forceinline__ void p0_prologue(const Ctx& C, LAS unsigned char* lds) {
    const int tid = threadIdx.x, lane = tid & 63, wave = tid >> 6;
    {
        LAS float* SL = (LAS float*)lds;
        LAS float* RED = (LAS float*)(lds + 16384);
        for (int i = tid; i < 4096; i += NTHREADS) { const float v = C.c[i]; SL[i] = v / (1.f + expf(-v)); }
        __syncthreads();
        float* MOD = (float*)(C.ws + WS_MOD);
        for (int it = C.vcu; it < 192; it += C.G) {
            const int n0 = it * 32, col = n0 + (lane & 31), ks = lane >> 5;
            float a0 = 0.f, a1 = 0.f, a2 = 0.f, a3 = 0.f;
#pragma unroll 16
            for (int i = 0; i < 64; ++i) { const int k = wave * 128 + 2 * i + ks; const float w = C.w_ada[(size_t)k * 6144 + col];
                a0 += SL[k] * w; a1 += SL[1024 + k] * w; a2 += SL[2048 + k] * w; a3 += SL[3072 + k] * w; }
            a0 += __shfl_xor(a0, 32); a1 += __shfl_xor(a1, 32); a2 += __shfl_xor(a2, 32); a3 += __shfl_xor(a3, 32);
            if (lane < 32) { RED[wave * 128 + lane] = a0; RED[wave * 128 + 32 + lane] = a1; RED[wave * 128 + 64 + lane] = a2; RED[wave * 128 + 96 + lane] = a3; }
            __syncthreads();
            if (tid < 128) { float s = 0.f;
#pragma unroll
                for (int w = 0; w < 8; ++w) s += RED[w * 128 + tid];
                const int b = tid >> 5, cc = n0 + (tid & 31); MOD[b * 6144 + cc] = s + C.b_ada[cc]; }
            __syncthreads();
        }
    }
    {
        float* RC = (float*)(C.ws + WS_ROPE); float* RS = RC + SEQ * 8;
        const float invf[8] = {1.0f, 0.1939227432012558f, 0.03760603070259094f, 0.007292664609849453f, 0.0014142135623842478f, 0.00027424818836152554f, 5.3182957344688475e-05f, 1.0313385246263351e-05f};
        for (int i = C.vcu * NTHREADS + tid; i < SEQ * 8; i += C.G * NTHREADS) { const int pos = i >> 3, j = i & 7;
            float f = invf[0];
#pragma unroll
            for (int q = 1; q < 8; ++q) f = (j == q) ? invf[q] : f;
            const float ang = (float)pos * f; RC[i] = cosf(ang); RS[i] = sinf(ang); }
    }
    {
        __syncthreads();
        LAS float* scr = (LAS float*)(lds + wave * 16384);
        const int gw = C.vcu * 8 + wave, NGW = C.G * 8;
        constexpr int I_IN = (DM / 64) * (NPROJ / 32), I_UP = (512 / 64) * (DM / 32), I_OUT = (DM / 64) * (DM / 32), I_F1 = (DM / 64) * (DFF / 32), I_F2 = (DFF / 64) * (DM / 32);
        constexpr int NITEMS = I_IN + 2 * I_UP + I_OUT + I_F1 + I_F2;
        for (int it = gw; it < NITEMS; it += NGW) {
            int r = it;
            if (r < I_IN) { p0_transpose_item<true>(C.w_in, DM, 5704, (f16*)(C.ws + WS_WIN), scr, NPROJ / 32, r, lane); continue; } r -= I_IN;
            if (r < I_UP) { p0_transpose_item<false>(C.w_up_a, 512, DM, (f16*)(C.ws + WS_WUPA), scr, DM / 32, r, lane); continue; } r -= I_UP;
            if (r < I_UP) { p0_transpose_item<false>(C.w_up_b, 512, DM, (f16*)(C.ws + WS_WUPB), scr, DM / 32, r, lane); continue; } r -= I_UP;
            if (r < I_OUT) { p0_transpose_item<false>(C.w_out, DM, DM, (f16*)(C.ws + WS_WOUT), scr, DM / 32, r, lane); continue; } r -= I_OUT;
            if (r < I_F1) { p0_transpose_item<false>(C.w_ff1, DM, DFF, (f16*)(C.ws + WS_WFF1), scr, DFF / 32, r, lane); continue; } r -= I_F1;
            p0_transpose_item<false>(C.w_ff2, DFF, DM, (f16*)(C.ws + WS_WFF2), scr, DM / 32, r, lane);
        }
    }
}

__device__ __forceinline__ void p1_norm_rows(const Ctx& C) {
    const int tid = threadIdx.x, lane = tid & 63, wave = tid >> 6;
    const int gw = C.vcu * 8 + wave, NGW = C.G * 8;
    const float* MOD = (const float*)(C.ws + WS_MOD);
    f16* H = (f16*)(C.ws + WS_H);
    for (int m = gw; m < M; m += NGW) {
        const int b = m / SEQ;
        const f32x4* xr = (const f32x4*)(C.x + (size_t)m * DM) + lane;
        f32x4 v[4]; float s = 0.f;
#pragma unroll
        for (int j = 0; j < 4; ++j) { v[j] = xr[64 * j]; s += (v[j].x * v[j].x + v[j].y * v[j].y) + (v[j].z * v[j].z + v[j].w * v[j].w); }
        const float r = 1.0f / sqrtf(wave_sum(s) * (1.f / DM) + EPS);
        u32x2* o8 = (u32x2*)(H + (size_t)m * DM) + lane;
#pragma unroll
        for (int j = 0; j < 4; ++j) {
            const f32x4 g = ((const f32x4*)C.g_pre_mix)[lane + 64 * j];
            const f32x4 sh = ((const f32x4*)(MOD + b * 6144))[lane + 64 * j];
            const f32x4 sc = ((const f32x4*)(MOD + b * 6144 + 1024))[lane + 64 * j];
            const f32x4 y = (v[j] * r) * g * (sc + 1.0f) + sh;
            u32x2 w; w.x = pkh(y.x, y.y); w.y = pkh(y.z, y.w); o8[64 * j] = w;
        }
    }
}
__device__ __forceinline__ void p7_rows(const Ctx& C) {
    const int tid = threadIdx.x, lane = tid & 63, wave = tid >> 6;
    const int gw = C.vcu * 8 + wave, NGW = C.G * 8;
    const float* MOD = (const float*)(C.ws + WS_MOD);
    const float* Y = (const float*)(C.ws + WS_Y);
    f16* H = (f16*)(C.ws + WS_H);
    for (int m = gw; m < M; m += NGW) {
        const int b = m / SEQ;
        const f32x4* yr = (const f32x4*)(Y + (size_t)m * DM) + lane;
        const f32x4* xr = (const f32x4*)(C.x + (size_t)m * DM) + lane;
        f32x4 y[4], xv[4]; float s = 0.f;
#pragma unroll
        for (int j = 0; j < 4; ++j) { y[j] = yr[64 * j]; xv[j] = xr[64 * j]; s += (y[j].x * y[j].x + y[j].y * y[j].y) + (y[j].z * y[j].z + y[j].w * y[j].w); }
        const float r = 1.0f / sqrtf(wave_sum(s) * (1.f / DM) + EPS);
        float s2 = 0.f;
        f32x4* orow = (f32x4*)(C.out + (size_t)m * DM) + lane;
#pragma unroll
        for (int j = 0; j < 4; ++j) {
            const f32x4 g = ((const f32x4*)C.g_post_mix)[lane + 64 * j];
            const f32x4 ga = ((const f32x4*)(MOD + b * 6144 + 2048))[lane + 64 * j];
            xv[j] = xv[j] + ga * ((y[j] * r) * g);
            orow[64 * j] = xv[j];
            s2 += (xv[j].x * xv[j].x + xv[j].y * xv[j].y) + (xv[j].z * xv[j].z + xv[j].w * xv[j].w);
        }
        const float r2 = 1.0f / sqrtf(wave_sum(s2) * (1.f / DM) + EPS);
        u32x2* o8 = (u32x2*)(H + (size_t)m * DM) + lane;
#pragma unroll
        for (int j = 0; j < 4; ++j) {
            const f32x4 g = ((const f32x4*)C.g_pre_ffn)[lane + 64 * j];
            const f32x4 sh = ((const f32x4*)(MOD + b * 6144 + 3072))[lane + 64 * j];
            const f32x4 sc = ((const f32x4*)(MOD + b * 6144 + 4096))[lane + 64 * j];
            const f32x4 h = (xv[j] * r2) * g * (sc + 1.0f) + sh;
            u32x2 w; w.x = pkh(h.x, h.y); w.y = pkh(h.z, h.w); o8[64 * j] = w;
        }
    }
}
__device__ __forceinline__ void p10_rows(const Ctx& C) {
    const int tid = threadIdx.x, lane = tid & 63, wave = tid >> 6;
    const int gw = C.vcu * 8 + wave, NGW = C.G * 8;
    const float* MOD = (const float*)(C.ws + WS_MOD);
    const float* Y = (const float*)(C.ws + WS_Y2);
    for (int m = gw; m < M; m += NGW) {
        const int b = m / SEQ;
        const f32x4* yr = (const f32x4*)(Y + (size_t)m * DM) + lane;
        f32x4* orow = (f32x4*)(C.out + (size_t)m * DM) + lane;
        f32x4 y[4], xv[4]; float s = 0.f;
#pragma unroll
        for (int j = 0; j < 4; ++j) { y[j] = yr[64 * j]; xv[j] = orow[64 * j]; s += (y[j].x * y[j].x + y[j].y * y[j].y) + (y[j].z * y[j].z + y[j].w * y[j].w); }
        const float r = 1.0f / sqrtf(wave_sum(s) * (1.f / DM) + EPS);
#pragma unroll
        for (int j = 0; j < 4; ++j) {
            const f32x4 g = ((const f32x4*)C.g_post_ffn)[lane + 64 * j];
            const f32x4 ga = ((const f32x4*)(MOD + b * 6144 + 5120))[lane + 64 * j];
            orow[64 * j] = xv[j] + ga * ((y[j] * r) * g);
        }
    }
}

constexpr int RL_SK = 0, RL_QI = 32768, RL_QA = 33792, RL_HIST = 34816, RL_SEL = 35840, RL_LG = 36864, RL_WC = 45056, RL_MISC = 45184, RL_W = 45248;
__device__ __forceinline__ void row_unit(const Ctx& C, LAS unsigned char* lds, int b, int t) {
    const int tid = threadIdx.x, lane = tid & 63, wid = tid >> 6;
    LAS unsigned* SK = (LAS unsigned*)(lds + RL_SK);
    LAS u32x4* QI4 = (LAS u32x4*)(lds + RL_QI);
    LAS u32x4* QA4 = (LAS u32x4*)(lds + RL_QA);
    LAS unsigned* HIST = (LAS unsigned*)(lds + RL_HIST);
    LAS int* SEL = (LAS int*)(lds + RL_SEL);
    LAS float* LG = (LAS float*)(lds + RL_LG);
    LAS unsigned* WC = (LAS unsigned*)(lds + RL_WC);
    LAS unsigned* MISC = (LAS unsigned*)(lds + RL_MISC);
    LAS float* WL = (LAS float*)(lds + RL_W);
    const f16* QI = (const f16*)(C.ws + WS_QI); const f16* KI = (const f16*)(C.ws + WS_KI); const float* WI = (const float*)(C.ws + WS_WI);
    f16* QA = (f16*)(C.ws + WS_QA); const f16* KA = (const f16*)(C.ws + WS_KA); const f16* VA = (const f16*)(C.ws + WS_VA);
    const size_t row = (size_t)b * SEQ + t, brow = (size_t)b * SEQ;
    if (tid < 64) QI4[tid] = ((const u32x4*)(QI + row * 512))[tid];
    else if (tid < 128) QA4[tid - 64] = ((const u32x4*)(QA + row * 512))[tid - 64];
    else if (tid < 136) WL[tid - 128] = WI[row * 8 + (tid - 128)];
    __syncthreads();
    const int n = t + 1;
    int n_sel;
    if (n > TOPK) {
        float w[8];
#pragma unroll
        for (int h = 0; h < 8; ++h) w[h] = WL[h];
        for (int s = tid; s < n; s += NTHREADS) {
            const u32x4* kp = (const u32x4*)(KI + (brow + s) * 64);
            u32x4 k[8];
#pragma unroll
            for (int i = 0; i < 8; ++i) k[i] = kp[i];
            float sc = 0.f;
#pragma unroll
            for (int h = 0; h < 8; ++h) { float d = 0.f;
#pragma unroll
                for (int i = 0; i < 8; ++i) d = dot2x4(QI4[h * 8 + i], k[i], d);
                sc += w[h] * fmaxf(d, 0.f); }
            SK[s] = fkey(sc);
        }
        unsigned prefix = 0; int need = TOPK;
#pragma unroll 1
        for (int pass = 0; pass < 4; ++pass) {
            const int shift = 24 - 8 * pass;
            if (tid < 256) HIST[tid] = 0;
            __syncthreads();
            for (int s = tid; s < n; s += NTHREADS) { const unsigned key = SK[s];
                const bool match = (pass == 0) ? true : ((key >> (shift + 8)) == prefix);
                if (match) atomicAdd((unsigned*)&HIST[(key >> shift) & 255u], 1u); }
            __syncthreads();
            if (wid == 0) {
                const int c0 = (int)HIST[4 * lane], c1 = (int)HIST[4 * lane + 1], c2 = (int)HIST[4 * lane + 2], c3 = (int)HIST[4 * lane + 3];
                const int tot = c0 + c1 + c2 + c3;
                int S = tot;
#pragma unroll
                for (int o = 1; o < 64; o <<= 1) { const int u = __shfl_down(S, o); if (lane + o < 64) S += u; }
                const int above = S - tot;
                if (above < need && need <= S) {
                    int a = above, d, cnt;
                    if (a + c3 >= need) { d = 3; cnt = c3; }
                    else { a += c3; if (a + c2 >= need) { d = 2; cnt = c2; }
                    else { a += c2; if (a + c1 >= need) { d = 1; cnt = c1; }
                    else { a += c1; d = 0; cnt = c0; } } }
                    MISC[0] = (unsigned)(4 * lane + d); MISC[1] = (unsigned)(need - a); MISC[2] = (unsigned)cnt;
                }
            }
            __syncthreads();
            prefix = (prefix << 8) | MISC[0]; need = (int)MISC[1];
        }
        const unsigned T = prefix; const int need_eq = need;
        int run_eq = 0, run_sel = 0;
        for (int c0 = 0; c0 < n; c0 += NTHREADS) {
            const int s = c0 + tid; const bool act = s < n; const unsigned k = act ? SK[s] : 0u;
            const bool gt = act && k > T, eq = act && k == T;
            const unsigned long long beq = __ballot(eq);
            if (lane == 0) WC[wid] = (unsigned)__popcll(beq);
            __syncthreads();
            int pe = run_eq, tot_e = 0;
#pragma unroll
            for (int w = 0; w < 8; ++w) { const int c = (int)WC[w]; if (w < wid) pe += c; tot_e += c; }
            pe += __popcll(beq & ((1ull << lane) - 1ull));
            const bool sel = gt || (eq && pe < need_eq);
            run_eq += tot_e;
            const unsigned long long bs = __ballot(sel);
            if (lane == 0) WC[8 + wid] = (unsigned)__popcll(bs);
            __syncthreads();
            int ps = run_sel, tot_s = 0;
#pragma unroll
            for (int w = 0; w < 8; ++w) { const int c = (int)WC[8 + w]; if (w < wid) ps += c; tot_s += c; }
            ps += __popcll(bs & ((1ull << lane) - 1ull));
            if (sel && ps < TOPK) SEL[ps] = s;
            run_sel += tot_s;
        }
        n_sel = run_sel < TOPK ? run_sel : TOPK;
    } else {
        if (tid < n) SEL[tid] = tid;
        n_sel = n;
    }
    __syncthreads();
    {
        const int k = tid & 255, hg = tid >> 8;
        if (k < n_sel) {
            const u32x4* kp = (const u32x4*)(KA + (brow + SEL[k]) * 512 + hg * 256);
#pragma unroll
            for (int hh = 0; hh < 4; ++hh) { float d = 0.f;
#pragma unroll
                for (int i = 0; i < 8; ++i) d = dot2x4(QA4[(hg * 4 + hh) * 8 + i], kp[hh * 8 + i], d);
                LG[(hg * 4 + hh) * 256 + k] = d; }
        }
    }
    __syncthreads();
    {
        float v[4]; float mx = -INFINITY;
#pragma unroll
        for (int j = 0; j < 4; ++j) { const int k = lane + 64 * j; v[j] = (k < n_sel) ? LG[wid * 256 + k] : -INFINITY; mx = fmaxf(mx, v[j]); }
        mx = wave_max(mx);
        float sum = 0.f;
#pragma unroll
        for (int j = 0; j < 4; ++j) { const int k = lane + 64 * j; v[j] = (k < n_sel) ? expf(v[j] - mx) : 0.f; sum += v[j]; }
        sum = wave_sum(sum);
        const float inv = 1.f / sum;
#pragma unroll
        for (int j = 0; j < 4; ++j) LG[wid * 256 + lane + 64 * j] = v[j] * inv;
    }
    __syncthreads();
    {
        float o = 0.f; const f16* vp = VA + brow * 512 + wid * 64 + lane;
#pragma unroll 8
        for (int k = 0; k < n_sel; ++k) o += LG[wid * 256 + k] * (float)vp[(size_t)SEL[k] * 512];
        ((f16*)(C.ws + WS_OA))[row * 512 + wid * 64 + lane] = (f16)o;
    }
    __syncthreads();
}

__device__ __forceinline__ void stick_item(const Ctx& C, LAS float* attw, int b, int t, int h, int lane) {
    f16* QB = (f16*)(C.ws + WS_QB); const f16* KB = (const f16*)(C.ws + WS_KB); const f16* VB = (const f16*)(C.ws + WS_VB);
    const size_t brow = (size_t)b * SEQ, row = brow + t;
    u32x4 q[8];
#pragma unroll
    for (int i = 0; i < 8; ++i) q[i] = ((const u32x4*)(QB + row * 512 + h * 64))[i];
    float o = 0.f, carry = 0.f;
    for (int base = 0; base < t; base += 64) {
        const int s = t - 1 - base - lane; const bool valid = s >= 0;
        float z = 0.f;
        if (valid) { const u32x4* kp = (const u32x4*)(KB + (brow + s) * 512 + h * 64);
#pragma unroll
            for (int i = 0; i < 8; ++i) z = dot2x4(q[i], kp[i], z); }
        const float L = log1pf(expf(-fabsf(z)));
        const float l1m = valid ? -(fmaxf(z, 0.f) + L) : 0.f;
        const float lsg = fminf(z, 0.f) - L;
        float incl = l1m;
#pragma unroll
        for (int ofs = 1; ofs < 64; ofs <<= 1) { const float u = __shfl_up(incl, ofs); if (lane >= ofs) incl += u; }
        const float after = carry + (incl - l1m);
        const float att = valid ? expf(lsg + after) : 0.f;
        carry += __shfl(incl, 63);
        attw[lane] = att;
        asm volatile("s_waitcnt lgkmcnt(0)" ::: "memory");
        const int cnt = (t - base) < 64 ? (t - base) : 64;
        const f16* vp = VB + (brow + (t - 1 - base)) * 512 + h * 64 + lane;
#pragma unroll 8
        for (int l = 0; l < cnt; ++l) o += attw[l] * (float)vp[-(ptrdiff_t)l * 512];
        asm volatile("s_waitcnt lgkmcnt(0)" ::: "memory");
        if (carry < -105.f) break;
    }
    ((f16*)(C.ws + WS_OB))[row * 512 + h * 64 + lane] = (f16)o;
}

struct Args { const float* in[14]; float* out; unsigned char* ws; int ph_lo, ph_hi; };
constexpr int NPHASES = 11;

__global__ void __launch_bounds__(NTHREADS, 2) hyb_fwd(Args args) {
    extern __shared__ __attribute__((aligned(16))) unsigned char lds_raw[];
    LAS unsigned char* lds = (LAS unsigned char*)lds_raw;
    cg::grid_group grid = cg::this_grid();
    Ctx C;
    C.x = args.in[0]; C.c = args.in[1]; C.w_ada = args.in[2]; C.b_ada = args.in[3]; C.g_pre_mix = args.in[4]; C.w_in = args.in[5]; C.w_up_a = args.in[6]; C.w_up_b = args.in[7];
    C.w_out = args.in[8]; C.g_post_mix = args.in[9]; C.g_pre_ffn = args.in[10]; C.w_ff1 = args.in[11]; C.w_ff2 = args.in[12]; C.g_post_ffn = args.in[13];
    C.out = args.out; C.ws = args.ws; C.G = gridDim.x;
    { const int bx = blockIdx.x; C.vcu = (C.G % 8 == 0) ? (bx % 8) * (C.G / 8) + bx / 8 : bx; }
    const int lo = args.ph_lo, hi = args.ph_hi;
    const int tid = threadIdx.x, lane = tid & 63, wave = tid >> 6;
#define IN(k) (lo <= (k) && (k) < hi)
#define SEAM(k) do { if (IN(k) && IN((k) + 1)) grid.sync(); } while (0)
    unsigned char* ws = C.ws;

    if (IN(0)) { p0_prologue(C, lds); } SEAM(0);
    if (IN(1)) { p1_norm_rows(C); } SEAM(1);
    if (IN(2)) {
        pg8::Gemm g{(const f16*)(ws + WS_H), (const f16*)(ws + WS_WIN), M, NPROJ, DM}; pg8::StaticOrder S; S.init(M, NPROJ, C.G, (int)blockIdx.x);
        EpiProj E{ws}; pg8::gemm_phase<EpiProj>(lds, g, S, E);
    } SEAM(2);
    if (IN(3)) {
        for (int r = C.vcu; r < M; r += C.G) row_unit(C, lds, r / SEQ, r % SEQ);
        __syncthreads();
        LAS float* attw = (LAS float*)(lds + wave * 256);
        const int gw = C.vcu * 8 + wave, NGW = C.G * 8;
        for (int it = gw; it < M * 8; it += NGW) { const int h = it & 7, r = it >> 3; stick_item(C, attw, r / SEQ, r % SEQ, h, lane); }
    } SEAM(3);
    if (IN(4)) {
        pg8::Gemm g{(const f16*)(ws + WS_OA), (const f16*)(ws + WS_WUPA), M, DM, 512}; pg8::StaticOrder S; S.init(M, DM, C.G, (int)blockIdx.x);
        EpiGate<0> E{(const f16*)(ws + WS_GA), nullptr, (f16*)(ws + WS_T1)}; pg8::gemm_phase<EpiGate<0>>(lds, g, S, E);
    } SEAM(4);
    if (IN(5)) {
        pg8::Gemm g{(const f16*)(ws + WS_OB), (const f16*)(ws + WS_WUPB), M, DM, 512}; pg8::StaticOrder S; S.init(M, DM, C.G, (int)blockIdx.x);
        EpiGate<1> E{(const f16*)(ws + WS_GB), (const f16*)(ws + WS_T1), (f16*)(ws + WS_MG)}; pg8::gemm_phase<EpiGate<1>>(lds, g, S, E);
    } SEAM(5);
    if (IN(6)) {
        pg8::Gemm g{(const f16*)(ws + WS_MG), (const f16*)(ws + WS_WOUT), M, DM, DM}; pg8::StaticOrder S; S.init(M, DM, C.G, (int)blockIdx.x);
        EpiF32 E{(float*)(ws + WS_Y), DM}; pg8::gemm_phase<EpiF32>(lds, g, S, E);
    } SEAM(6);
    if (IN(7)) { p7_rows(C); } SEAM(7);
    if (IN(8)) {
        pg8::Gemm g{(const f16*)(ws + WS_H), (const f16*)(ws + WS_WFF1), M, DFF, DM}; pg8::StaticOrder S; S.init(M, DFF, C.G, (int)blockIdx.x);
        EpiSqRelu E{(f16*)(ws + WS_U), DFF}; pg8::gemm_phase<EpiSqRelu>(lds, g, S, E);
    } SEAM(8);
    if (IN(9)) {
        pg8::Gemm g{(const f16*)(ws + WS_U), (const f16*)(ws + WS_WFF2), M, DM, DFF}; pg8::StaticOrder S; S.init(M, DM, C.G, (int)blockIdx.x);
        EpiF32 E{(float*)(ws + WS_Y2), DM}; pg8::gemm_phase<EpiF32>(lds, g, S, E);
    } SEAM(9);
    if (IN(10)) { p10_rows(C); }
#undef IN
#undef SEAM
}


#ifndef DIAG
#define DIAG 0
#endif
#if DIAG
constexpr size_t WS_DIAG = 488 * MiB;
__device__ __forceinline__ unsigned hash_u(unsigned x) { x ^= x >> 16; x *= 0x7feb352dU; x ^= x >> 15; x *= 0x846ca68bU; x ^= x >> 16; return x; }
__device__ __forceinline__ bool close_(float got, float ref) { return fabsf(got - ref) <= 0.02f * fabsf(ref) + 0.01f; }
__device__ __forceinline__ float projdot(const Args& a, int row, int n) {
    const f16* H = (const f16*)(a.ws + WS_H); const float* w = a.in[5]; const int sc = win_src(n); float s = 0.f;
    for (int k = 0; k < DM; ++k) s += (float)H[(size_t)row * DM + k] * w[(size_t)k * 5704 + sc];
    return s;
}
__global__ void diag_kernel(Args a, int test, int nsamp) {
    const int i = blockIdx.x * blockDim.x + threadIdx.x; if (i >= nsamp) return;
    unsigned char* ws = a.ws; unsigned* cnt = (unsigned*)(ws + WS_DIAG);
    const float* MOD = (const float*)(ws + WS_MOD);
    int bad = 0;
    const int row = (int)(hash_u(i * 2654435761u + 17u) % (unsigned)M), b = row / SEQ, pos = row % SEQ;
    if (test == 0) {
        const int bb = i & 3, n = (int)(hash_u(i + 99u) % 6144u); float s = a.in[3][n];
        for (int k = 0; k < DM; ++k) { const float v = a.in[1][bb * DM + k]; s += (v / (1.f + expf(-v))) * a.in[2][(size_t)k * 6144 + n]; }
        bad = !close_(MOD[bb * 6144 + n], s);
    } else if (test == 1) {
        float ss = 0.f; for (int k = 0; k < DM; ++k) { const float v = a.in[0][(size_t)row * DM + k]; ss += v * v; }
        const float r = 1.f / sqrtf(ss / DM + EPS); const f16* H = (const f16*)(ws + WS_H);
        for (int j = 0; j < 4; ++j) { const int col = (int)(hash_u(i * 4 + j + 5u) % 1024u);
            const float ref = a.in[0][(size_t)row * DM + col] * r * a.in[4][col] * (1.f + MOD[b * 6144 + 1024 + col]) + MOD[b * 6144 + col];
            bad |= !close_((float)H[(size_t)row * DM + col], ref); }
    } else if (test == 2) {
        const int n = (int)(hash_u(i * 7u + 1u) % 5704u);
        float ref = projdot(a, row, n), got;
        const float invf[8] = {1.0f, 0.1939227432012558f, 0.03760603070259094f, 0.007292664609849453f, 0.0014142135623842478f, 0.00027424818836152554f, 5.3182957344688475e-05f, 1.0313385246263351e-05f};
        if (n < 3584) {
            const int t = n / 512, cl = n % 512, d = cl & 63;
            if ((t == 0 || t == 1 || t == 6) && d < 16) { const float rp = projdot(a, row, d < 8 ? n + 8 : n - 8);
                float f = 1.f; for (int q = 0; q < 8; ++q) if ((d & 7) == q) f = invf[q];
                const float ang = (float)pos * f, cs = cosf(ang), sn = sinf(ang); ref = d < 8 ? ref * cs - rp * sn : ref * cs + rp * sn; }
            if (t == 0 || t == 3) ref *= 0.125f;
            const size_t off = (t == 0) ? WS_QA : (t == 1) ? WS_KA : (t == 2) ? WS_VA : (t == 3) ? WS_QB : (t == 4) ? WS_KB : (t == 5) ? WS_VB : WS_QI;
            got = (float)((const f16*)(ws + off))[(size_t)row * 512 + cl];
        } else if (n < 5632) { const int g = n - 3584; got = (g < 1024) ? (float)((const f16*)(ws + WS_GA))[(size_t)row * 1024 + g] : (float)((const f16*)(ws + WS_GB))[(size_t)row * 1024 + g - 1024]; }
        else { const int k = n - 5632;
            if (k < 64) { if (k < 16) { const float rp = projdot(a, row, k < 8 ? n + 8 : n - 8); float f = 1.f; for (int q = 0; q < 8; ++q) if ((k & 7) == q) f = invf[q];
                    const float ang = (float)pos * f, cs = cosf(ang), sn = sinf(ang); ref = k < 8 ? ref * cs - rp * sn : ref * cs + rp * sn; }
                got = (float)((const f16*)(ws + WS_KI))[(size_t)row * 64 + k]; }
            else got = ((const float*)(ws + WS_WI))[(size_t)row * 8 + (k - 64)]; }
        bad = !close_(got, ref);
    } else if (test == 3) {
        const int h = i & 7; const f16* QB = (const f16*)(ws + WS_QB); const f16* KB = (const f16*)(ws + WS_KB); const f16* VB = (const f16*)(ws + WS_VB); const f16* OB = (const f16*)(ws + WS_OB);
        const int d0 = (int)(hash_u(i + 1234u) % 16u) * 4;
        double o0 = 0, o1 = 0, o2 = 0, o3 = 0, after = 0;
        for (int s = pos - 1; s >= 0 && after > -200.0; --s) {
            const f16* kp = KB + ((size_t)b * SEQ + s) * 512 + h * 64; const f16* qp = QB + (size_t)row * 512 + h * 64; double z = 0;
            for (int d = 0; d < 64; ++d) z += (double)(float)qp[d] * (double)(float)kp[d];
            const double L = log1p(exp(-fabs(z))), lsg = fmin(z, 0.0) - L, l1m = -(fmax(z, 0.0) + L), att = exp(lsg + after);
            const f16* vp = VB + ((size_t)b * SEQ + s) * 512 + h * 64 + d0;
            o0 += att * (double)(float)vp[0]; o1 += att * (double)(float)vp[1]; o2 += att * (double)(float)vp[2]; o3 += att * (double)(float)vp[3];
            after += l1m; }
        const f16* op = OB + (size_t)row * 512 + h * 64 + d0;
        bad = !close_((float)op[0], (float)o0) || !close_((float)op[1], (float)o1) || !close_((float)op[2], (float)o2) || !close_((float)op[3], (float)o3);
    } else if (test == 4) {
        const int col = (int)(hash_u(i * 3u + 7u) % 1024u); const f16* OA = (const f16*)(ws + WS_OA); const f16* OB = (const f16*)(ws + WS_OB);
        float ya = 0.f, yb = 0.f; for (int k = 0; k < 512; ++k) { ya += (float)OA[(size_t)row * 512 + k] * a.in[6][(size_t)k * 1024 + col]; yb += (float)OB[(size_t)row * 512 + k] * a.in[7][(size_t)k * 1024 + col]; }
        const float ga = (float)((const f16*)(ws + WS_GA))[(size_t)row * 1024 + col], gb = (float)((const f16*)(ws + WS_GB))[(size_t)row * 1024 + col];
        const float ref = ya / (1.f + expf(-ga)) + yb / (1.f + expf(-gb));
        bad = !close_((float)((const f16*)(ws + WS_MG))[(size_t)row * 1024 + col], ref);
    } else if (test == 5) {
        const int col = (int)(hash_u(i * 3u + 11u) % 1024u); const f16* MG = (const f16*)(ws + WS_MG);
        float y = 0.f; for (int k = 0; k < 1024; ++k) y += (float)MG[(size_t)row * 1024 + k] * a.in[8][(size_t)k * 1024 + col];
        bad = !close_(((const float*)(ws + WS_Y))[(size_t)row * 1024 + col], y);
    } else if (test == 6) {
        const float* Y = (const float*)(ws + WS_Y); float ss = 0.f; for (int k = 0; k < DM; ++k) { const float v = Y[(size_t)row * DM + k]; ss += v * v; }
        const float r = 1.f / sqrtf(ss / DM + EPS); float s2 = 0.f;
        for (int k = 0; k < DM; ++k) { const float x1 = a.in[0][(size_t)row * DM + k] + MOD[b * 6144 + 2048 + k] * (Y[(size_t)row * DM + k] * r * a.in[9][k]); s2 += x1 * x1; }
        const float r2 = 1.f / sqrtf(s2 / DM + EPS); const f16* H = (const f16*)(ws + WS_H);
        for (int j = 0; j < 4; ++j) { const int k = (int)(hash_u(i * 4 + j + 55u) % 1024u);
            const float x1 = a.in[0][(size_t)row * DM + k] + MOD[b * 6144 + 2048 + k] * (Y[(size_t)row * DM + k] * r * a.in[9][k]);
            bad |= !close_(a.out[(size_t)row * DM + k], x1);
            const float h2 = x1 * r2 * a.in[10][k] * (1.f + MOD[b * 6144 + 4096 + k]) + MOD[b * 6144 + 3072 + k];
            bad |= !close_((float)H[(size_t)row * DM + k], h2); }
    }
    if (bad) atomicAdd(&cnt[test], 1u);
}
__global__ void diag_final(Args a, int ntests) {
    unsigned* cnt = (unsigned*)(a.ws + WS_DIAG); unsigned code = 0;
    for (int t = 0; t < ntests; ++t) if (cnt[t] > 4u) code |= 1u << t;
    a.out[0] += 1.0e5f * (float)code;
}
#endif

extern "C" void kernel_launch(void* const* d_in, const int* in_sizes, int n_in, void* d_out, int out_size, void* d_ws, size_t ws_size, hipStream_t stream) {
    static int grid = 0;
    if (grid == 0) {
        if (n_in != 14 || out_size != M * DM || ws_size < WS_END) { fprintf(stderr, "kernel_launch: unexpected shapes n_in %d out %d ws %zu\n", n_in, out_size, ws_size); grid = -1; return; }
        int dev = 0, cus = 0, per_cu = 0;
        (void)hipGetDevice(&dev); (void)hipDeviceGetAttribute(&cus, hipDeviceAttributeMultiprocessorCount, dev);
        (void)hipFuncSetAttribute((const void*)hyb_fwd, hipFuncAttributeMaxDynamicSharedMemorySize, LDS_BYTES);
        (void)hipOccupancyMaxActiveBlocksPerMultiprocessor(&per_cu, (const void*)hyb_fwd, NTHREADS, LDS_BYTES);
        if (per_cu < 1) { fprintf(stderr, "kernel_launch: occupancy query says %d blocks/CU\n", per_cu); per_cu = 1; }
        (void)hipGetLastError();
        grid = cus * 1;
        fprintf(stderr, "kernel_launch: cus %d per_cu %d grid %d\n", cus, per_cu, grid);
    }
    if (grid < 0) return;
    Args a{};
    for (int i = 0; i < 14; ++i) a.in[i] = (const float*)d_in[i];
    a.out = (float*)d_out; a.ws = (unsigned char*)d_ws;
#if MK_SINGLE
    a.ph_lo = 0; a.ph_hi = NPHASES;
    { void* kargs[] = {&a}; hipError_t e = hipLaunchCooperativeKernel((const void*)hyb_fwd, dim3(grid), dim3(NTHREADS), kargs, LDS_BYTES, stream);
      if (e != hipSuccess) fprintf(stderr, "cooperative launch failed: %s\n", hipGetErrorString(e)); }
#else
#if DIAG
    (void)hipMemsetAsync((unsigned char*)d_ws + WS_DIAG, 0, 256, stream);
#endif
    for (int p = 0; p < NPHASES; ++p) {
        a.ph_lo = p; a.ph_hi = p + 1;
        void* kargs[] = {&a}; hipError_t e = hipLaunchCooperativeKernel((const void*)hyb_fwd, dim3(grid), dim3(NTHREADS), kargs, LDS_BYTES, stream);
        if (e != hipSuccess) { fprintf(stderr, "launch %d failed: %s\n", p, hipGetErrorString(e)); break; }
#if DIAG
        if (p == 0) hipLaunchKernelGGL(diag_kernel, dim3(8), dim3(64), 0, stream, a, 0, 512);
        if (p == 1) hipLaunchKernelGGL(diag_kernel, dim3(4), dim3(64), 0, stream, a, 1, 256);
        if (p == 2) hipLaunchKernelGGL(diag_kernel, dim3(64), dim3(64), 0, stream, a, 2, 4096);
        if (p == 3) hipLaunchKernelGGL(diag_kernel, dim3(8), dim3(64), 0, stream, a, 3, 512);
        if (p == 5) hipLaunchKernelGGL(diag_kernel, dim3(32), dim3(64), 0, stream, a, 4, 2048);
        if (p == 6) hipLaunchKernelGGL(diag_kernel, dim3(32), dim3(64), 0, stream, a, 5, 2048);
        if (p == 7) hipLaunchKernelGGL(diag_kernel, dim3(4), dim3(64), 0, stream, a, 6, 256);
#endif
    }
#if DIAG
    hipLaunchKernelGGL(diag_final, dim3(1), dim3(1), 0, stream, a, 7);
#endif
#endif
}
```

```cpp
#include <hip/hip_runtime.h>
#include <hip/hip_cooperative_groups.h>
#include <cstdio>
#include <cstdint>
namespace cg = cooperative_groups;

#ifndef MK_SINGLE
#define MK_SINGLE 1
#endif
#define DIAG 0

#define LAS __attribute__((address_space(3)))
typedef _Float16 f16;
typedef _Float16 f16x2 __attribute__((ext_vector_type(2)));
typedef _Float16 f16x8 __attribute__((ext_vector_type(8)));
typedef float f32x2 __attribute__((ext_vector_type(2)));
typedef float f32x4 __attribute__((ext_vector_type(4)));
typedef unsigned u32x4 __attribute__((ext_vector_type(4)));
typedef unsigned u32x2 __attribute__((ext_vector_type(2)));

constexpr int BATCH = 4, SEQ = 8192, DM = 1024, M = BATCH * SEQ, DFF = 4096;
constexpr int NPROJ = 5888;
constexpr float EPS = 1e-6f;
constexpr int TOPK = 256;

constexpr size_t MiB = 1u << 20;
constexpr size_t WS_WIN = 0, WS_WUPA = 12 * MiB, WS_WUPB = 13 * MiB, WS_WOUT = 14 * MiB, WS_WFF1 = 16 * MiB, WS_WFF2 = 24 * MiB;
constexpr size_t WS_MOD = 32 * MiB, WS_ROPE = 33 * MiB;
constexpr size_t WS_H = 40 * MiB;
constexpr size_t WS_KA = 104 * MiB, WS_VA = 136 * MiB, WS_KB = 168 * MiB, WS_VB = 200 * MiB, WS_QI = 232 * MiB, WS_QA = 264 * MiB, WS_QB = 296 * MiB;
constexpr size_t WS_GA = 328 * MiB, WS_GB = 392 * MiB, WS_KI = 456 * MiB, WS_WI = 460 * MiB;
constexpr size_t WS_OA = 40 * MiB, WS_OB = 72 * MiB;
constexpr size_t WS_T1 = 104 * MiB, WS_MG = 168 * MiB, WS_Y = 232 * MiB, WS_U = 104 * MiB, WS_Y2 = 360 * MiB;
constexpr size_t WS_BM = 461 * MiB;
constexpr size_t WS_END = 512 * MiB;

constexpr int LDS_BYTES = 151552;
constexpr int NTHREADS = 512;

namespace pg8 {
constexpr int BM = 256, BK = 64, HALF = 128, HTB = HALF * BK * 2, STAGE_BYTES = 8 * HTB, NXCD = 8, WGM = 8;
__host__ __device__ __forceinline__ int lds_byte(int r, int c) { const int st = (r >> 4) * 2 + (c >> 5), rr = r & 15, cc = c & 31, ob = rr * 64 + cc * 2; return st * 1024 + (ob ^ (((ob >> 9) & 1) << 5)); }
__host__ __device__ __forceinline__ void stage_rc(int b, int& R, int& C) { const int st = b / 1024, sb = b % 1024, swz = sb ^ (((sb >> 9) & 1) << 5); R = (st >> 1) * 16 + swz / 64; C = (st & 1) * 32 + (swz % 64) / 2; }
__host__ __device__ __forceinline__ int perm32(int rho) { const int n = rho >> 4, i = rho & 15; return 8 * (i >> 2) + 4 * n + (i & 3); }

struct Unit { int pm, pn; };
struct Gemm { const f16* A; const f16* Bt; int M, N, K; };

struct StaticOrder {
    int nM, nN, nwg, G, c;
    __host__ __device__ void init(int M_, int N_, int G_, int c_) { nM = M_ / BM; nN = N_ / BM; nwg = nM * nN; G = G_; c = c_; }
    __host__ __device__ bool next(int i, Unit& u) const {
        const long L = (long)i * G + c; if (L >= nwg) return false;
        int wgid = (int)L; { const int q = nwg / NXCD, r = nwg % NXCD, xcd = wgid % NXCD, off = wgid / NXCD; wgid = (xcd < r ? xcd * (q + 1) : r * (q + 1) + (xcd - r) * q) + off; }
        const int nig = WGM * nN, gid = wgid / nig, fm = gid * WGM, gsz = (nM - fm) < WGM ? (nM - fm) : WGM;
        u.pm = fm + ((wgid % nig) % gsz); u.pn = (wgid % nig) / gsz; return true;
    }
};

template <class Epi>
__device__ __forceinline__ void gemm_phase(LAS unsigned char* lds, const Gemm g, const StaticOrder& S, const Epi& E) {
    const int tid = threadIdx.x, wid = __builtin_amdgcn_readfirstlane(tid >> 6), lane = tid & 63, wr = wid >> 2, wc = wid & 3, fr = lane & 15, fq = lane >> 4;
    const int K = g.K, nt = K / BK;
    unsigned voffA[2], voffB[2];
#pragma unroll
    for (int i = 0; i < 2; ++i) { int R, C; stage_rc(tid * 16 + i * 8192, R, C); const int Rb = Epi::PERM ? ((R & ~31) + perm32(R & 31)) : R;
        voffA[i] = (unsigned)(R * K + C) * 2u; voffB[i] = (unsigned)(Rb * K + C) * 2u; }
    const size_t kstep = (size_t)(BK * 2);
    const size_t hstep = (size_t)HALF * K * 2;
    const size_t tstep = 2 * hstep;
    const unsigned ldsw = (unsigned)wid * 1024u;
    const int aoff = lds_byte(wr * 64 + fr, fq * 8), boff = lds_byte(wc * 32 + fr, fq * 8);
#define PG8_SA(b, h) (((b) * 2 + (h)) * HTB)
#define PG8_SB(b, h) ((4 + (b) * 2 + (h)) * HTB)
#define PG8_STAGE(bufoff, gbase, voff) do { _Pragma("unroll") for (int _i = 0; _i < 2; ++_i) \
        __builtin_amdgcn_global_load_lds((const unsigned*)((const char*)(gbase) + (voff)[_i]), (LAS unsigned*)(lds + (bufoff) + ldsw + _i * 8192), 16, 0, 0); } while (0)
#define PG8_LDA(dst, b, h) do { _Pragma("unroll") for (int m = 0; m < 4; ++m) _Pragma("unroll") for (int k = 0; k < 2; ++k) dst[m][k] = *(const LAS f16x8*)(lds + PG8_SA(b, h) + aoff + m * 2048 + k * 1024); } while (0)
#define PG8_LDB(dst, b, h) do { _Pragma("unroll") for (int n = 0; n < 2; ++n) _Pragma("unroll") for (int k = 0; k < 2; ++k) dst[n][k] = *(const LAS f16x8*)(lds + PG8_SB(b, h) + boff + n * 2048 + k * 1024); } while (0)
#define PG8_MMA(ai, bj, At, Bt) do { __builtin_amdgcn_s_setprio(1); _Pragma("unroll") for (int m = 0; m < 4; ++m) _Pragma("unroll") for (int n = 0; n < 2; ++n) _Pragma("unroll") for (int k = 0; k < 2; ++k) \
        acc[ai][bj][m][n] = __builtin_amdgcn_mfma_f32_16x16x32_f16(Bt[n][k], At[m][k], acc[ai][bj][m][n], 0, 0, 0); __builtin_amdgcn_s_setprio(0); } while (0)
#define PG8_WAIT_V(n) asm volatile("s_waitcnt vmcnt(" #n ")" ::: "memory")
#define PG8_WAIT_L(n) asm volatile("s_waitcnt lgkmcnt(" #n ")" ::: "memory")
#define PG8_BAR __builtin_amdgcn_s_barrier()
#define PG8_SCHED __builtin_amdgcn_sched_barrier(0)
    Unit cur, nxt; int ui = 0;
    if (!S.next(0, cur)) return;
    f32x4 acc[2][2][4][2];
#pragma unroll
    for (int a = 0; a < 2; ++a)
#pragma unroll
        for (int b = 0; b < 2; ++b)
#pragma unroll
            for (int m = 0; m < 4; ++m)
#pragma unroll
                for (int n = 0; n < 2; ++n) acc[a][b][m][n] = (f32x4){0.f, 0.f, 0.f, 0.f};
    f16x8 At[4][2], B0[2][2], B1[2][2];
    const char* cA = (const char*)g.A + (size_t)cur.pm * tstep; const char* cB = (const char*)g.Bt + (size_t)cur.pn * tstep;
    {
        PG8_STAGE(PG8_SB(0, 0), cB, voffB); PG8_STAGE(PG8_SB(0, 1), cB + hstep, voffB); PG8_STAGE(PG8_SA(0, 0), cA, voffA); PG8_STAGE(PG8_SA(0, 1), cA + hstep, voffA);
        if (wr == 1) PG8_BAR;
        PG8_WAIT_V(2); PG8_BAR;
        PG8_STAGE(PG8_SB(1, 0), cB + kstep, voffB); PG8_STAGE(PG8_SA(1, 0), cA + kstep, voffA); PG8_STAGE(PG8_SB(1, 1), cB + hstep + kstep, voffB);
        PG8_WAIT_V(6); PG8_BAR;
    }
    for (;;) {
        const bool has_next = S.next(ui + 1, nxt);
        const char* nA = has_next ? (const char*)g.A + (size_t)nxt.pm * tstep : cA; const char* nB = has_next ? (const char*)g.Bt + (size_t)nxt.pn * tstep : cB;
        for (int t = 0; t < nt; t += 2) {
            const bool last = (t == nt - 2);
            const char* a1 = cA + (size_t)(t + 1) * kstep;
            const char* a2 = last ? nA : cA + (size_t)(t + 2) * kstep; const char* b2 = last ? nB : cB + (size_t)(t + 2) * kstep;
            const char* a3 = a2 + kstep; const char* b3 = b2 + kstep;
            PG8_LDB(B0, 0, 0); PG8_LDB(B1, 0, 1); PG8_SCHED; PG8_LDA(At, 0, 0); PG8_STAGE(PG8_SA(1, 1), a1 + hstep, voffA);
            PG8_WAIT_V(8); PG8_WAIT_L(0); PG8_BAR; PG8_MMA(0, 0, At, B0); PG8_MMA(0, 1, At, B1); PG8_BAR; PG8_SCHED;
            PG8_LDA(At, 0, 1); PG8_STAGE(PG8_SB(0, 0), b2, voffB); PG8_STAGE(PG8_SB(0, 1), b2 + hstep, voffB); PG8_STAGE(PG8_SA(0, 0), a2, voffA);
            PG8_WAIT_V(8); PG8_WAIT_L(0); PG8_BAR; PG8_MMA(1, 0, At, B0); PG8_MMA(1, 1, At, B1); PG8_BAR; PG8_SCHED;
            PG8_LDB(B0, 1, 0); PG8_LDB(B1, 1, 1); PG8_SCHED; PG8_LDA(At, 1, 0); PG8_STAGE(PG8_SA(0, 1), a2 + hstep, voffA);
            PG8_WAIT_V(8); PG8_WAIT_L(0); PG8_BAR; PG8_MMA(0, 0, At, B0); PG8_MMA(0, 1, At, B1); PG8_BAR; PG8_SCHED;
            PG8_LDA(At, 1, 1); PG8_STAGE(PG8_SB(1, 0), b3, voffB); PG8_STAGE(PG8_SB(1, 1), b3 + hstep, voffB); PG8_STAGE(PG8_SA(1, 0), a3, voffA);
            PG8_WAIT_V(8); PG8_WAIT_L(0); PG8_BAR; PG8_MMA(1, 0, At, B0); PG8_MMA(1, 1, At, B1); PG8_BAR; PG8_SCHED;
        }
        if (wr == 0) PG8_BAR;
        E(acc, cur, wr, wc, fr, fq);
        if (!has_next) break;
#pragma unroll
        for (int a = 0; a < 2; ++a)
#pragma unroll
            for (int b = 0; b < 2; ++b)
#pragma unroll
                for (int m = 0; m < 4; ++m)
#pragma unroll
                    for (int n = 0; n < 2; ++n) acc[a][b][m][n] = (f32x4){0.f, 0.f, 0.f, 0.f};
        cur = nxt; cA = nA; cB = nB; ++ui;
        if (wr == 1) PG8_BAR;
    }
    PG8_WAIT_V(0);
    PG8_BAR;
#undef PG8_SA
#undef PG8_SB
#undef PG8_STAGE
#undef PG8_LDA
#undef PG8_LDB
#undef PG8_MMA
#undef PG8_WAIT_V
#undef PG8_WAIT_L
#undef PG8_BAR
#undef PG8_SCHED
}
}

__device__ __forceinline__ unsigned pkh(float lo, float hi) { f32x2 v = {lo, hi}; f16x2 h = __builtin_convertvector(v, f16x2); return __builtin_bit_cast(unsigned, h); }
__device__ __forceinline__ f32x2 unpkh(unsigned u) { f16x2 h = __builtin_bit_cast(f16x2, u); return __builtin_convertvector(h, f32x2); }
__device__ __forceinline__ float sigmoidf_(float x) { return 1.f / (1.f + __expf(-x)); }
__device__ __forceinline__ f16x2 ash2(unsigned u) { return __builtin_bit_cast(f16x2, u); }
__device__ __forceinline__ float dot2x4(u32x4 a, u32x4 b, float d) {
    const unsigned a0 = a.x, a1 = a.y, a2 = a.z, a3 = a.w, b0 = b.x, b1 = b.y, b2 = b.z, b3 = b.w;
    d = __builtin_amdgcn_fdot2(ash2(a0), ash2(b0), d, false);
    d = __builtin_amdgcn_fdot2(ash2(a1), ash2(b1), d, false);
    d = __builtin_amdgcn_fdot2(ash2(a2), ash2(b2), d, false);
    d = __builtin_amdgcn_fdot2(ash2(a3), ash2(b3), d, false);
    return d;
}
__device__ __forceinline__ float wave_sum(float v) {
#pragma unroll
    for (int o = 1; o < 64; o <<= 1) v += __shfl_xor(v, o);
    return v;
}
__device__ __forceinline__ float wave_max(float v) {
#pragma unroll
    for (int o = 1; o < 64; o <<= 1) v = fmaxf(v, __shfl_xor(v, o));
    return v;
}
__device__ __forceinline__ unsigned fkey(float f) { const unsigned u = __float_as_uint(f); return (u & 0x80000000u) ? ~u : (u | 0x80000000u); }

struct Ctx {
    const float *x, *c, *w_ada, *b_ada, *g_pre_mix, *w_in, *w_up_a, *w_up_b, *w_out, *g_post_mix, *g_pre_ffn, *w_ff1, *w_ff2, *g_post_ffn;
    float* out; unsigned char* ws;
    int G, vcu;
};

struct EpiProj {
    static constexpr bool PERM = true;
    unsigned char* ws;
    __device__ __forceinline__ void operator()(const f32x4 (&acc)[2][2][4][2], const pg8::Unit& u, int wr, int wc, int fr, int fq) const {
        const int pn = u.pn, rowb = u.pm * 256 + wr * 64 + fr;
        const float* RC = (const float*)(ws + WS_ROPE); const float* RS = RC + SEQ * 8;
        f16* base; int ld, colb; bool rope = false; float sc = 1.f; int nbj = 2;
        if (pn < 14) {
            const int t = pn >> 1;
            const size_t off = (t == 0) ? WS_QA : (t == 1) ? WS_KA : (t == 2) ? WS_VA : (t == 3) ? WS_QB : (t == 4) ? WS_KB : (t == 5) ? WS_VB : WS_QI;
            base = (f16*)(ws + off); ld = 512; colb = (pn & 1) * 256 + wc * 32 + 8 * fq;
            rope = (t == 0 || t == 1 || t == 6) && ((wc & 1) == 0);
            sc = (t == 0) ? 0.125f * 1.4426950408889634f : (t == 3) ? 0.125f : 1.f;
        } else if (pn < 22) {
            base = (f16*)(ws + (pn < 18 ? WS_GA : WS_GB)); ld = 1024; colb = ((pn - 14) & 3) * 256 + wc * 32 + 8 * fq;
        } else {
            nbj = 1;
            if (wc >= 2) {
                if (wc == 2 && fq == 0) {
                    float* WI = (float*)(ws + WS_WI);
#pragma unroll
                    for (int ai = 0; ai < 2; ++ai)
#pragma unroll
                        for (int m = 0; m < 4; ++m) { const int row = rowb + ai * 128 + m * 16;
                            *(f32x4*)(WI + (size_t)row * 8) = acc[ai][0][m][0]; *(f32x4*)(WI + (size_t)row * 8 + 4) = acc[ai][0][m][1]; }
                }
                return;
            }
            base = (f16*)(ws + WS_KI); ld = 64; colb = wc * 32 + 8 * fq; rope = (wc == 0);
        }
        const float sgn = (fq == 0) ? -1.f : 1.f;
#pragma unroll
        for (int ai = 0; ai < 2; ++ai)
#pragma unroll
            for (int m = 0; m < 4; ++m) {
                const int row = rowb + ai * 128 + m * 16, pos = row & (SEQ - 1);
                f32x4 c0 = {1.f, 1.f, 1.f, 1.f}, c1 = c0, s0 = {0.f, 0.f, 0.f, 0.f}, s1 = s0;
                if (rope) { c0 = *(const f32x4*)(RC + pos * 8); c1 = *(const f32x4*)(RC + pos * 8 + 4); s0 = *(const f32x4*)(RS + pos * 8); s1 = *(const f32x4*)(RS + pos * 8 + 4); }
#pragma unroll
                for (int bj = 0; bj < 2; ++bj) { if (bj < nbj) {
                    f32x4 v0 = acc[ai][bj][m][0], v1 = acc[ai][bj][m][1];
                    if (rope) {
                        f32x4 p0, p1;
#pragma unroll
                        for (int i = 0; i < 4; ++i) { p0[i] = __shfl_xor(v0[i], 16); p1[i] = __shfl_xor(v1[i], 16); }
                        if (fq < 2) { v0 = v0 * c0 + (p0 * s0) * sgn; v1 = v1 * c1 + (p1 * s1) * sgn; }
                    }
                    v0 = v0 * sc; v1 = v1 * sc;
                    u32x4 w; w.x = pkh(v0[0], v0[1]); w.y = pkh(v0[2], v0[3]); w.z = pkh(v1[0], v1[1]); w.w = pkh(v1[2], v1[3]);
                    *(u32x4*)(base + (size_t)row * ld + colb + bj * 128) = w; } }
            }
    }
};

template <int MODE>
struct EpiGate {
    static constexpr bool PERM = true;
    const f16* G; const f16* T1; f16* O;
    __device__ __forceinline__ void operator()(const f32x4 (&acc)[2][2][4][2], const pg8::Unit& u, int wr, int wc, int fr, int fq) const {
        const int rowb = u.pm * 256 + wr * 64 + fr, colb = u.pn * 256 + wc * 32 + 8 * fq;
#pragma unroll
        for (int ai = 0; ai < 2; ++ai)
#pragma unroll
            for (int m = 0; m < 4; ++m) { const size_t ro = (size_t)(rowb + ai * 128 + m * 16) * 1024 + colb;
#pragma unroll
                for (int bj = 0; bj < 2; ++bj) {
                    const u32x4 gw = *(const u32x4*)(G + ro + bj * 128);
                    f32x2 g0 = unpkh(gw.x), g1 = unpkh(gw.y), g2 = unpkh(gw.z), g3 = unpkh(gw.w);
                    const f32x4 a0 = acc[ai][bj][m][0], a1 = acc[ai][bj][m][1];
                    float r[8] = {sigmoidf_(g0.x) * a0[0], sigmoidf_(g0.y) * a0[1], sigmoidf_(g1.x) * a0[2], sigmoidf_(g1.y) * a0[3],
                                  sigmoidf_(g2.x) * a1[0], sigmoidf_(g2.y) * a1[1], sigmoidf_(g3.x) * a1[2], sigmoidf_(g3.y) * a1[3]};
                    if (MODE == 1) { const u32x4 tw = *(const u32x4*)(T1 + ro + bj * 128);
                        f32x2 t0 = unpkh(tw.x), t1 = unpkh(tw.y), t2 = unpkh(tw.z), t3 = unpkh(tw.w);
                        r[0] += t0.x; r[1] += t0.y; r[2] += t1.x; r[3] += t1.y; r[4] += t2.x; r[5] += t2.y; r[6] += t3.x; r[7] += t3.y; }
                    u32x4 w; w.x = pkh(r[0], r[1]); w.y = pkh(r[2], r[3]); w.z = pkh(r[4], r[5]); w.w = pkh(r[6], r[7]);
                    *(u32x4*)(O + ro + bj * 128) = w; } }
    }
};

struct EpiSqRelu {
    static constexpr bool PERM = true;
    f16* O; int ldc;
    __device__ __forceinline__ void operator()(const f32x4 (&acc)[2][2][4][2], const pg8::Unit& u, int wr, int wc, int fr, int fq) const {
        const int rowb = u.pm * 256 + wr * 64 + fr, colb = u.pn * 256 + wc * 32 + 8 * fq;
#pragma unroll
        for (int ai = 0; ai < 2; ++ai)
#pragma unroll
            for (int m = 0; m < 4; ++m) { const size_t ro = (size_t)(rowb + ai * 128 + m * 16) * ldc + colb;
#pragma unroll
                for (int bj = 0; bj < 2; ++bj) {
                    f32x4 a0 = acc[ai][bj][m][0], a1 = acc[ai][bj][m][1];
#pragma unroll
                    for (int i = 0; i < 4; ++i) { a0[i] = fmaxf(a0[i], 0.f); a1[i] = fmaxf(a1[i], 0.f); }
                    a0 = a0 * a0; a1 = a1 * a1;
                    u32x4 w; w.x = pkh(a0[0], a0[1]); w.y = pkh(a0[2], a0[3]); w.z = pkh(a1[0], a1[1]); w.w = pkh(a1[2], a1[3]);
                    *(u32x4*)(O + ro + bj * 128) = w; } }
    }
};

struct EpiF32 {
    static constexpr bool PERM = false;
    float* C; int ldc;
    __device__ __forceinline__ void operator()(const f32x4 (&acc)[2][2][4][2], const pg8::Unit& u, int wr, int wc, int fr, int fq) const {
        const int row0 = u.pm * 256 + wr * 64 + fr, col0 = u.pn * 256 + wc * 32 + 4 * fq;
#pragma unroll
        for (int ai = 0; ai < 2; ++ai)
#pragma unroll
            for (int m = 0; m < 4; ++m) { float* rowp = C + (size_t)(row0 + ai * 128 + m * 16) * ldc + col0;
#pragma unroll
                for (int bj = 0; bj < 2; ++bj)
#pragma unroll
                    for (int n = 0; n < 2; ++n) *(f32x4*)(rowp + bj * 128 + n * 16) = acc[ai][bj][m][n]; }
    }
};

__device__ __forceinline__ int win_src(int n) {
    if (n < 3584) return n;
    if (n < 5632) return n + 72;
    if (n < 5704) return n - 5632 + 3584;
    return -1;
}
template <bool MAP>
__device__ __forceinline__ void p0_transpose_item(const float* W, int K, int N, f16* WT, LAS float* scr, int nblk, int item, int lane) {
    const int kb = item / nblk, nb = item % nblk, k0 = 64 * kb, n0 = 32 * nb;
    const int nd = n0 + (lane & 31); const int sc = MAP ? win_src(nd) : nd;
#pragma unroll 8
    for (int i = 0; i < 32; ++i) { const int kk = 2 * i + (lane >> 5); scr[kk * 33 + (lane & 31)] = (sc >= 0) ? W[(size_t)(k0 + kk) * N + sc] : 0.f; }
    asm volatile("s_waitcnt lgkmcnt(0)" ::: "memory");
    const int c = lane & 7;
#pragma unroll
    for (int j = 0; j < 4; ++j) { const int n = (lane >> 3) + 8 * j; const LAS float* s = scr + (8 * c) * 33 + n;
        u32x4 o; o.x = pkh(s[0 * 33], s[1 * 33]); o.y = pkh(s[2 * 33], s[3 * 33]); o.z = pkh(s[4 * 33], s[5 * 33]); o.w = pkh(s[6 * 33], s[7 * 33]);
        *(u32x4*)(WT + (size_t)(n0 + n) * K + k0 + 8 * c) = o; }
    asm volatile("s_waitcnt lgkmcnt(0)" ::: "memory");
}

__device__ __forceinline__ void p0_prologue(const Ctx& C, LAS unsigned char* lds) {
    const int tid = threadIdx.x, lane = tid & 63, wave = tid >> 6;
    {
        LAS float* SL = (LAS float*)lds;
        LAS float* RED = (LAS float*)(lds + 16384);
        for (int i = tid; i < 4096; i += NTHREADS) { const float v = C.c[i]; SL[i] = v / (1.f + expf(-v)); }
        __syncthreads();
        float* MOD = (float*)(C.ws + WS_MOD);
        for (int it = C.vcu; it < 192; it += C.G) {
            const int n0 = it * 32, col = n0 + (lane & 31), ks = lane >> 5;
            float a0 = 0.f, a1 = 0.f, a2 = 0.f, a3 = 0.f;
#pragma unroll 16
            for (int i = 0; i < 64; ++i) { const int k = wave * 128 + 2 * i + ks; const float w = C.w_ada[(size_t)k * 6144 + col];
                a0 += SL[k] * w; a1 += SL[1024 + k] * w; a2 += SL[2048 + k] * w; a3 += SL[3072 + k] * w; }
            a0 += __shfl_xor(a0, 32); a1 += __shfl_xor(a1, 32); a2 += __shfl_xor(a2, 32); a3 += __shfl_xor(a3, 32);
            if (lane < 32) { RED[wave * 128 + lane] = a0; RED[wave * 128 + 32 + lane] = a1; RED[wave * 128 + 64 + lane] = a2; RED[wave * 128 + 96 + lane] = a3; }
            __syncthreads();
            if (tid < 128) { float s = 0.f;
#pragma unroll
                for (int w = 0; w < 8; ++w) s += RED[w * 128 + tid];
                const int b = tid >> 5, cc = n0 + (tid & 31); MOD[b * 6144 + cc] = s + C.b_ada[cc]; }
            __syncthreads();
        }
    }
    {
        float* RC = (float*)(C.ws + WS_ROPE); float* RS = RC + SEQ * 8;
        const float invf[8] = {1.0f, 0.1939227432012558f, 0.03760603070259094f, 0.007292664609849453f, 0.0014142135623842478f, 0.00027424818836152554f, 5.3182957344688475e-05f, 1.0313385246263351e-05f};
        for (int i = C.vcu * NTHREADS + tid; i < SEQ * 8; i += C.G * NTHREADS) { const int pos = i >> 3, j = i & 7;
            float f = invf[0];
#pragma unroll
            for (int q = 1; q < 8; ++q) f = (j == q) ? invf[q] : f;
            const float ang = (float)pos * f; RC[i] = cosf(ang); RS[i] = sinf(ang); }
    }
    {
        __syncthreads();
        LAS float* scr = (LAS float*)(lds + wave * 16384);
        const int gw = C.vcu * 8 + wave, NGW = C.G * 8;
        constexpr int I_IN = (DM / 64) * (NPROJ / 32), I_UP = (512 / 64) * (DM / 32), I_OUT = (DM / 64) * (DM / 32), I_F1 = (DM / 64) * (DFF / 32), I_F2 = (DFF / 64) * (DM / 32);
        constexpr int NITEMS = I_IN + 2 * I_UP + I_OUT + I_F1 + I_F2;
        for (int it = gw; it < NITEMS; it += NGW) {
            int r = it;
            if (r < I_IN) { p0_transpose_item<true>(C.w_in, DM, 5704, (f16*)(C.ws + WS_WIN), scr, NPROJ / 32, r, lane); continue; } r -= I_IN;
            if (r < I_UP) { p0_transpose_item<false>(C.w_up_a, 512, DM, (f16*)(C.ws + WS_WUPA), scr, DM / 32, r, lane); continue; } r -= I_UP;
            if (r < I_UP) { p0_transpose_item<false>(C.w_up_b, 512, DM, (f16*)(C.ws + WS_WUPB), scr, DM / 32, r, lane); continue; } r -= I_UP;
            if (r < I_OUT) { p0_transpose_item<false>(C.w_out, DM, DM, (f16*)(C.ws + WS_WOUT), scr, DM / 32, r, lane); continue; } r -= I_OUT;
            if (r < I_F1) { p0_transpose_item<false>(C.w_ff1, DM, DFF, (f16*)(C.ws + WS_WFF1), scr, DFF / 32, r, lane); continue; } r -= I_F1;
            p0_transpose_item<false>(C.w_ff2, DFF, DM, (f16*)(C.ws + WS_WFF2), scr, DM / 32, r, lane);
        }
    }
}

__device__ __forceinline__ void p1_norm_rows(const Ctx& C) {
    const int tid = threadIdx.x, lane = tid & 63, wave = tid >> 6;
    const int gw = C.vcu * 8 + wave, NGW = C.G * 8;
    const float* MOD = (const float*)(C.ws + WS_MOD);
    f16* H = (f16*)(C.ws + WS_H);
    for (int m = gw; m < M; m += NGW) {
        const int b = m / SEQ;
        const f32x4* xr = (const f32x4*)(C.x + (size_t)m * DM) + lane;
        f32x4 v[4]; float s = 0.f;
#pragma unroll
        for (int j = 0; j < 4; ++j) { v[j] = xr[64 * j]; s += (v[j].x * v[j].x + v[j].y * v[j].y) + (v[j].z * v[j].z + v[j].w * v[j].w); }
        const float r = 1.0f / sqrtf(wave_sum(s) * (1.f / DM) + EPS);
        u32x2* o8 = (u32x2*)(H + (size_t)m * DM) + lane;
#pragma unroll
        for (int j = 0; j < 4; ++j) {
            const f32x4 g = ((const f32x4*)C.g_pre_mix)[lane + 64 * j];
            const f32x4 sh = ((const f32x4*)(MOD + b * 6144))[lane + 64 * j];
            const f32x4 sc = ((const f32x4*)(MOD + b * 6144 + 1024))[lane + 64 * j];
            const f32x4 y = (v[j] * r) * g * (sc + 1.0f) + sh;
            u32x2 w; w.x = pkh(y.x, y.y); w.y = pkh(y.z, y.w); o8[64 * j] = w;
        }
    }
}
__device__ __forceinline__ void p7_rows(const Ctx& C) {
    const int tid = threadIdx.x, lane = tid & 63, wave = tid >> 6;
    const int gw = C.vcu * 8 + wave, NGW = C.G * 8;
    const float* MOD = (const float*)(C.ws + WS_MOD);
    const float* Y = (const float*)(C.ws + WS_Y);
    f16* H = (f16*)(C.ws + WS_H);
    for (int m = gw; m < M; m += NGW) {
        const int b = m / SEQ;
        const f32x4* yr = (const f32x4*)(Y + (size_t)m * DM) + lane;
        const f32x4* xr = (const f32x4*)(C.x + (size_t)m * DM) + lane;
        f32x4 y[4], xv[4]; float s = 0.f;
#pragma unroll
        for (int j = 0; j < 4; ++j) { y[j] = yr[64 * j]; xv[j] = xr[64 * j]; s += (y[j].x * y[j].x + y[j].y * y[j].y) + (y[j].z * y[j].z + y[j].w * y[j].w); }
        const float r = 1.0f / sqrtf(wave_sum(s) * (1.f / DM) + EPS);
        float s2 = 0.f;
        f32x4* orow = (f32x4*)(C.out + (size_t)m * DM) + lane;
#pragma unroll
        for (int j = 0; j < 4; ++j) {
            const f32x4 g = ((const f32x4*)C.g_post_mix)[lane + 64 * j];
            const f32x4 ga = ((const f32x4*)(MOD + b * 6144 + 2048))[lane + 64 * j];
            xv[j] = xv[j] + ga * ((y[j] * r) * g);
            orow[64 * j] = xv[j];
            s2 += (xv[j].x * xv[j].x + xv[j].y * xv[j].y) + (xv[j].z * xv[j].z + xv[j].w * xv[j].w);
        }
        const float r2 = 1.0f / sqrtf(wave_sum(s2) * (1.f / DM) + EPS);
        u32x2* o8 = (u32x2*)(H + (size_t)m * DM) + lane;
#pragma unroll
        for (int j = 0; j < 4; ++j) {
            const f32x4 g = ((const f32x4*)C.g_pre_ffn)[lane + 64 * j];
            const f32x4 sh = ((const f32x4*)(MOD + b * 6144 + 3072))[lane + 64 * j];
            const f32x4 sc = ((const f32x4*)(MOD + b * 6144 + 4096))[lane + 64 * j];
            const f32x4 h = (xv[j] * r2) * g * (sc + 1.0f) + sh;
            u32x2 w; w.x = pkh(h.x, h.y); w.y = pkh(h.z, h.w); o8[64 * j] = w;
        }
    }
}
__device__ __forceinline__ void p10_rows(const Ctx& C) {
    const int tid = threadIdx.x, lane = tid & 63, wave = tid >> 6;
    const int gw = C.vcu * 8 + wave, NGW = C.G * 8;
    const float* MOD = (const float*)(C.ws + WS_MOD);
    const float* Y = (const float*)(C.ws + WS_Y2);
    for (int m = gw; m < M; m += NGW) {
        const int b = m / SEQ;
        const f32x4* yr = (const f32x4*)(Y + (size_t)m * DM) + lane;
        f32x4* orow = (f32x4*)(C.out + (size_t)m * DM) + lane;
        f32x4 y[4], xv[4]; float s = 0.f;
#pragma unroll
        for (int j = 0; j < 4; ++j) { y[j] = yr[64 * j]; xv[j] = orow[64 * j]; s += (y[j].x * y[j].x + y[j].y * y[j].y) + (y[j].z * y[j].z + y[j].w * y[j].w); }
        const float r = 1.0f / sqrtf(wave_sum(s) * (1.f / DM) + EPS);
#pragma unroll
        for (int j = 0; j < 4; ++j) {
            const f32x4 g = ((const f32x4*)C.g_post_ffn)[lane + 64 * j];
            const f32x4 ga = ((const f32x4*)(MOD + b * 6144 + 5120))[lane + 64 * j];
            orow[64 * j] = xv[j] + ga * ((y[j] * r) * g);
        }
    }
}

constexpr int RL_SK = 0, RL_QI = 32768, RL_QA = 33792, RL_HIST = 34816, RL_SEL = 35840, RL_LG = 36864, RL_WC = 45056, RL_MISC = 45184, RL_W = 45248;
__device__ __forceinline__ void row_unit(const Ctx& C, LAS unsigned char* lds, int b, int t, f16* OAdst, const unsigned* bmrow) {
    const int tid = threadIdx.x, lane = tid & 63, wid = tid >> 6;
    LAS unsigned* SK = (LAS unsigned*)(lds + RL_SK);
    LAS u32x4* QI4 = (LAS u32x4*)(lds + RL_QI);
    LAS u32x4* QA4 = (LAS u32x4*)(lds + RL_QA);
    LAS unsigned* HIST = (LAS unsigned*)(lds + RL_HIST);
    LAS int* SEL = (LAS int*)(lds + RL_SEL);
    LAS float* LG = (LAS float*)(lds + RL_LG);
    LAS unsigned* WC = (LAS unsigned*)(lds + RL_WC);
    LAS unsigned* MISC = (LAS unsigned*)(lds + RL_MISC);
    LAS float* WL = (LAS float*)(lds + RL_W);
    const f16* QI = (const f16*)(C.ws + WS_QI); const f16* KI = (const f16*)(C.ws + WS_KI); const float* WI = (const float*)(C.ws + WS_WI);
    f16* QA = (f16*)(C.ws + WS_QA); const f16* KA = (const f16*)(C.ws + WS_KA); const f16* VA = (const f16*)(C.ws + WS_VA);
    const size_t row = (size_t)b * SEQ + t, brow = (size_t)b * SEQ;
    if (tid < 64) QI4[tid] = ((const u32x4*)(QI + row * 512))[tid];
    else if (tid < 128) QA4[tid - 64] = ((const u32x4*)(QA + row * 512))[tid - 64];
    else if (tid < 136) WL[tid - 128] = WI[row * 8 + (tid - 128)];
    __syncthreads();
    const int n = t + 1;
    int n_sel;
    if (bmrow != nullptr) {
        int run_sel = 0;
        for (int c0 = 0; c0 < n; c0 += NTHREADS) {
            const int s = c0 + tid; const bool sel = (s < n) && ((bmrow[s >> 5] >> (s & 31)) & 1u);
            const unsigned long long bs = __ballot(sel);
            if (lane == 0) WC[8 + wid] = (unsigned)__popcll(bs);
            __syncthreads();
            int ps = run_sel, tot_s = 0;
#pragma unroll
            for (int w = 0; w < 8; ++w) { const int c = (int)WC[8 + w]; if (w < wid) ps += c; tot_s += c; }
            ps += __popcll(bs & ((1ull << lane) - 1ull));
            if (sel && ps < TOPK) SEL[ps] = s;
            run_sel += tot_s;
            __syncthreads();
        }
        n_sel = run_sel < TOPK ? run_sel : TOPK;
    } else if (n > TOPK) {
        float w[8];
#pragma unroll
        for (int h = 0; h < 8; ++h) w[h] = WL[h];
        for (int s = tid; s < n; s += NTHREADS) {
            const u32x4* kp = (const u32x4*)(KI + (brow + s) * 64);
            u32x4 k[8];
#pragma unroll
            for (int i = 0; i < 8; ++i) k[i] = kp[i];
            float sc = 0.f;
#pragma unroll
            for (int h = 0; h < 8; ++h) { float d = 0.f;
#pragma unroll
                for (int i = 0; i < 8; ++i) d = dot2x4(QI4[h * 8 + i], k[i], d);
                sc += w[h] * fmaxf(d, 0.f); }
            SK[s] = fkey(sc);
        }
        unsigned prefix = 0; int need = TOPK;
#pragma unroll 1
        for (int pass = 0; pass < 4; ++pass) {
            const int shift = 24 - 8 * pass;
            if (tid < 256) HIST[tid] = 0;
            __syncthreads();
            for (int s = tid; s < n; s += NTHREADS) { const unsigned key = SK[s];
                const bool match = (pass == 0) ? true : ((key >> (shift + 8)) == prefix);
                if (match) atomicAdd((unsigned*)&HIST[(key >> shift) & 255u], 1u); }
            __syncthreads();
            if (wid == 0) {
                const int c0 = (int)HIST[4 * lane], c1 = (int)HIST[4 * lane + 1], c2 = (int)HIST[4 * lane + 2], c3 = (int)HIST[4 * lane + 3];
                const int tot = c0 + c1 + c2 + c3;
                int S = tot;
#pragma unroll
                for (int o = 1; o < 64; o <<= 1) { const int u = __shfl_down(S, o); if (lane + o < 64) S += u; }
                const int above = S - tot;
                if (above < need && need <= S) {
                    int a = above, d, cnt;
                    if (a + c3 >= need) { d = 3; cnt = c3; }
                    else { a += c3; if (a + c2 >= need) { d = 2; cnt = c2; }
                    else { a += c2; if (a + c1 >= need) { d = 1; cnt = c1; }
                    else { a += c1; d = 0; cnt = c0; } } }
                    MISC[0] = (unsigned)(4 * lane + d); MISC[1] = (unsigned)(need - a); MISC[2] = (unsigned)cnt;
                }
            }
            __syncthreads();
            prefix = (prefix << 8) | MISC[0]; need = (int)MISC[1];
        }
        const unsigned T = prefix; const int need_eq = need;
        int run_eq = 0, run_sel = 0;
        for (int c0 = 0; c0 < n; c0 += NTHREADS) {
            const int s = c0 + tid; const bool act = s < n; const unsigned k = act ? SK[s] : 0u;
            const bool gt = act && k > T, eq = act && k == T;
            const unsigned long long beq = __ballot(eq);
            if (lane == 0) WC[wid] = (unsigned)__popcll(beq);
            __syncthreads();
            int pe = run_eq, tot_e = 0;
#pragma unroll
            for (int w = 0; w < 8; ++w) { const int c = (int)WC[w]; if (w < wid) pe += c; tot_e += c; }
            pe += __popcll(beq & ((1ull << lane) - 1ull));
            const bool sel = gt || (eq && pe < need_eq);
            run_eq += tot_e;
            const unsigned long long bs = __ballot(sel);
            if (lane == 0) WC[8 + wid] = (unsigned)__popcll(bs);
            __syncthreads();
            int ps = run_sel, tot_s = 0;
#pragma unroll
            for (int w = 0; w < 8; ++w) { const int c = (int)WC[8 + w]; if (w < wid) ps += c; tot_s += c; }
            ps += __popcll(bs & ((1ull << lane) - 1ull));
            if (sel && ps < TOPK) SEL[ps] = s;
            run_sel += tot_s;
        }
        n_sel = run_sel < TOPK ? run_sel : TOPK;
    } else {
        if (tid < n) SEL[tid] = tid;
        n_sel = n;
    }
    __syncthreads();
    {
        const int k = tid & 255, hg = tid >> 8;
        if (k < n_sel) {
            const u32x4* kp = (const u32x4*)(KA + (brow + SEL[k]) * 512 + hg * 256);
#pragma unroll
            for (int hh = 0; hh < 4; ++hh) { float d = 0.f;
#pragma unroll
                for (int i = 0; i < 8; ++i) d = dot2x4(QA4[(hg * 4 + hh) * 8 + i], kp[hh * 8 + i], d);
                LG[(hg * 4 + hh) * 256 + k] = d; }
        }
    }
    __syncthreads();
    {
        float v[4]; float mx = -INFINITY;
#pragma unroll
        for (int j = 0; j < 4; ++j) { const int k = lane + 64 * j; v[j] = (k < n_sel) ? LG[wid * 256 + k] : -INFINITY; mx = fmaxf(mx, v[j]); }
        mx = wave_max(mx);
        float sum = 0.f;
#pragma unroll
        for (int j = 0; j < 4; ++j) { const int k = lane + 64 * j; v[j] = (k < n_sel) ? exp2f(v[j] - mx) : 0.f; sum += v[j]; }
        sum = wave_sum(sum);
        const float inv = 1.f / sum;
#pragma unroll
        for (int j = 0; j < 4; ++j) LG[wid * 256 + lane + 64 * j] = v[j] * inv;
    }
    __syncthreads();
    {
        float o = 0.f; const f16* vp = VA + brow * 512 + wid * 64 + lane;
#pragma unroll 8
        for (int k = 0; k < n_sel; ++k) o += LG[wid * 256 + k] * (float)vp[(size_t)SEL[k] * 512];
        OAdst[wid * 64 + lane] = (f16)o;
    }
    __syncthreads();
}

__device__ __forceinline__ void row_select_slow(const Ctx& C, LAS unsigned char* lds, int b, int t, unsigned* dst, int nwords) {
    const int tid = threadIdx.x, lane = tid & 63, wid = tid >> 6;
    LAS unsigned* SK = (LAS unsigned*)(lds + RL_SK);
    LAS u32x4* QI4 = (LAS u32x4*)(lds + RL_QI);
    LAS unsigned* HIST = (LAS unsigned*)(lds + RL_HIST);
    LAS unsigned* WC = (LAS unsigned*)(lds + RL_WC);
    LAS unsigned* MISC = (LAS unsigned*)(lds + RL_MISC);
    LAS float* WL = (LAS float*)(lds + RL_W);
    const f16* QI = (const f16*)(C.ws + WS_QI); const f16* KI = (const f16*)(C.ws + WS_KI); const float* WI = (const float*)(C.ws + WS_WI);
    const size_t row = (size_t)b * SEQ + t, brow = (size_t)b * SEQ;
    __syncthreads();
    if (tid < 64) QI4[tid] = ((const u32x4*)(QI + row * 512))[tid];
    else if (tid >= 128 && tid < 136) WL[tid - 128] = WI[row * 8 + (tid - 128)];
    __syncthreads();
    const int n = t + 1;
    unsigned T = 0u; int need_eq = 0x7fffffff;
    {
        float w[8];
#pragma unroll
        for (int h = 0; h < 8; ++h) w[h] = WL[h];
        for (int s = tid; s < n; s += NTHREADS) {
            const u32x4* kp = (const u32x4*)(KI + (brow + s) * 64);
            u32x4 k[8];
#pragma unroll
            for (int i = 0; i < 8; ++i) k[i] = kp[i];
            float sc = 0.f;
#pragma unroll
            for (int h = 0; h < 8; ++h) { float d = 0.f;
#pragma unroll
                for (int i = 0; i < 8; ++i) d = dot2x4(QI4[h * 8 + i], k[i], d);
                sc = fmaf(w[h], fmaxf(d, 0.f), sc); }
            SK[s] = fkey(sc);
        }
    }
    if (n > TOPK) {
        unsigned prefix = 0; int need = TOPK;
#pragma unroll 1
        for (int pass = 0; pass < 4; ++pass) {
            const int shift = 24 - 8 * pass;
            if (tid < 256) HIST[tid] = 0;
            __syncthreads();
            for (int s = tid; s < n; s += NTHREADS) { const unsigned key = SK[s];
                const bool match = (pass == 0) ? true : ((key >> (shift + 8)) == prefix);
                if (match) atomicAdd((unsigned*)&HIST[(key >> shift) & 255u], 1u); }
            __syncthreads();
            if (wid == 0) {
                const int c0 = (int)HIST[4 * lane], c1 = (int)HIST[4 * lane + 1], c2 = (int)HIST[4 * lane + 2], c3 = (int)HIST[4 * lane + 3];
                const int tot = c0 + c1 + c2 + c3;
                int S = tot;
#pragma unroll
                for (int o = 1; o < 64; o <<= 1) { const int u = __shfl_down(S, o); if (lane + o < 64) S += u; }
                const int above = S - tot;
                if (above < need && need <= S) {
                    int a = above, d;
                    if (a + c3 >= need) { d = 3; }
                    else { a += c3; if (a + c2 >= need) { d = 2; }
                    else { a += c2; if (a + c1 >= need) { d = 1; }
                    else { a += c1; d = 0; } } }
                    MISC[0] = (unsigned)(4 * lane + d); MISC[1] = (unsigned)(need - a);
                }
            }
            __syncthreads();
            prefix = (prefix << 8) | MISC[0]; need = (int)MISC[1];
        }
        T = prefix; need_eq = need;
    }
    __syncthreads();
    int run_eq = 0;
    for (int c0 = 0; c0 < nwords * 32; c0 += NTHREADS) {
        const int s = c0 + tid; const bool act = s < n; const unsigned k = act ? SK[s] : 0u;
        const bool gt = act && k > T, eq = act && k == T;
        const unsigned long long beq = __ballot(eq);
        if (lane == 0) WC[wid] = (unsigned)__popcll(beq);
        __syncthreads();
        int pe = run_eq, tot_e = 0;
#pragma unroll
        for (int w = 0; w < 8; ++w) { const int c = (int)WC[w]; if (w < wid) pe += c; tot_e += c; }
        pe += __popcll(beq & ((1ull << lane) - 1ull));
        const bool sel = gt || (eq && pe < need_eq);
        run_eq += tot_e;
        const unsigned long long bs = __ballot(sel);
        const int w0 = (c0 >> 5) + 2 * wid;
        if (lane == 0) { if (w0 < nwords) dst[w0] = (unsigned)bs; if (w0 + 1 < nwords) dst[w0 + 1] = (unsigned)(bs >> 32); }
        __syncthreads();
    }
}

typedef float f32x16 __attribute__((ext_vector_type(16)));
#ifndef IX_CAP
#define IX_CAP 512
#endif
constexpr int IXL_HIST = 0, IXL_KT = 131072, IXL_CNT = 147456, IXL_B1 = 147456 + 128, IXL_NEED = 147456 + 256, IXL_FLAG = 147456 + 384;
struct IxWave { f16x8 a[4]; float wA[8], wB[8]; };
__device__ __forceinline__ void ix_scores(const IxWave& W, const LAS unsigned char* kt, int sub, int lane, float& sA, float& sB) {
    const int c = lane & 31, hk = lane >> 5, key = 32 * sub + c;
    f32x16 acc = {0.f, 0.f, 0.f, 0.f, 0.f, 0.f, 0.f, 0.f, 0.f, 0.f, 0.f, 0.f, 0.f, 0.f, 0.f, 0.f};
#pragma unroll
    for (int ks = 0; ks < 4; ++ks) { const int chunk = 2 * ks + hk;
        const f16x8 bfr = *(const LAS f16x8*)(kt + key * 128 + ((chunk ^ (key & 7)) << 4));
        acc = __builtin_amdgcn_mfma_f32_32x32x16_f16(W.a[ks], bfr, acc, 0, 0, 0); }
    float s0 = 0.f, s1 = 0.f;
#pragma unroll
    for (int h = 0; h < 8; ++h) { s0 = fmaf(W.wA[h], fmaxf(acc[h], 0.f), s0); s1 = fmaf(W.wB[h], fmaxf(acc[8 + h], 0.f), s1); }
    sA = s0; sB = s1;
}
__device__ __forceinline__ void ix_stage_load(const f16* KI, size_t brow, int tile, int tid, u32x4& v) { v = *(const u32x4*)(KI + (brow + (size_t)tile * 64 + (tid >> 3)) * 64 + (tid & 7) * 8); }
__device__ __forceinline__ void ix_stage_write(LAS unsigned char* lds, int buf, int tid, const u32x4& v) { const int key = tid >> 3, chunk = tid & 7; *(LAS u32x4*)(lds + IXL_KT + buf * 8192 + key * 128 + ((chunk ^ (key & 7)) << 4)) = v; }

__device__ __forceinline__ void ix_unit(const Ctx& C, LAS unsigned char* lds, int b, int t0) {
    const int tid = threadIdx.x, lane = tid & 63, wave = __builtin_amdgcn_readfirstlane(tid >> 6), hi = lane >> 5, c = lane & 31;
    const f16* QI = (const f16*)(C.ws + WS_QI); const f16* KI = (const f16*)(C.ws + WS_KI); const float* WI = (const float*)(C.ws + WS_WI);
    unsigned* BM = (unsigned*)(C.ws + WS_BM);
    const size_t brow = (size_t)b * SEQ;
    LAS unsigned* HIST = (LAS unsigned*)(lds + IXL_HIST);
    LAS u32x2* LIST = (LAS u32x2*)(lds + IXL_HIST);
    LAS unsigned* CNT = (LAS unsigned*)(lds + IXL_CNT);
    LAS int* B1 = (LAS int*)(lds + IXL_B1);
    LAS int* NEED = (LAS int*)(lds + IXL_NEED);
    LAS unsigned* FLAG = (LAS unsigned*)(lds + IXL_FLAG);
    const int ntile = (t0 + 32 + 63) >> 6;
    const int tA = t0 + 4 * wave + 2 * hi, rA = 4 * wave + 2 * hi;
    IxWave W;
    {
        const int a_ = c >> 3, b_ = (c >> 2) & 1, c_ = c & 3, tok = 2 * b_ + (a_ >> 1), head = 4 * (a_ & 1) + c_;
        const f16* qp = QI + (brow + t0 + 4 * wave + tok) * 512 + head * 64 + 8 * hi;
#pragma unroll
        for (int ks = 0; ks < 4; ++ks) W.a[ks] = *(const f16x8*)(qp + 16 * ks);
        const float* wp = WI + (brow + tA) * 8;
        const f32x4 w0 = *(const f32x4*)(wp), w1 = *(const f32x4*)(wp + 4), w2 = *(const f32x4*)(wp + 8), w3 = *(const f32x4*)(wp + 12);
#pragma unroll
        for (int i = 0; i < 4; ++i) { W.wA[i] = w0[i]; W.wA[4 + i] = w1[i]; W.wB[i] = w2[i]; W.wB[4 + i] = w3[i]; }
    }
    __syncthreads();
    for (int i = tid; i < 8192; i += NTHREADS) ((LAS u32x4*)HIST)[i] = (u32x4){0u, 0u, 0u, 0u};
    if (tid < 32) CNT[tid] = 0u;
    if (tid == 32) FLAG[0] = 0u;
    { u32x4 v; ix_stage_load(KI, brow, 0, tid, v); ix_stage_write(lds, 0, tid, v); }
    __syncthreads();
    for (int tile = 0; tile < ntile; ++tile) {
        u32x4 nx = {0u, 0u, 0u, 0u}; const bool more = tile + 1 < ntile;
        if (more) ix_stage_load(KI, brow, tile + 1, tid, nx);
        const LAS unsigned char* kt = lds + IXL_KT + (tile & 1) * 8192;
#pragma unroll
        for (int sub = 0; sub < 2; ++sub) {
            float sA, sB; ix_scores(W, kt, sub, lane, sA, sB);
            const int s = tile * 64 + sub * 32 + c;
            if (s <= tA) { const unsigned bin = fkey(sA) >> 21; atomicAdd((unsigned*)&HIST[rA * 1024 + (bin >> 1)], 1u << ((bin & 1u) * 16u)); }
            if (s <= tA + 1) { const unsigned bin = fkey(sB) >> 21; atomicAdd((unsigned*)&HIST[(rA + 1) * 1024 + (bin >> 1)], 1u << ((bin & 1u) * 16u)); }
        }
        if (more) ix_stage_write(lds, (tile + 1) & 1, tid, nx);
        __syncthreads();
    }
#pragma unroll 1
    for (int rr = 0; rr < 4; ++rr) {
        const int row = 4 * wave + rr, n = t0 + row + 1;
        int b1 = -1, need1 = 0;
        if (n > TOPK) {
            const LAS u32x4* hp = (const LAS u32x4*)(HIST + row * 1024 + 16 * lane);
            const u32x4 q0 = hp[0], q1 = hp[1], q2 = hp[2], q3 = hp[3];
            const unsigned wv[16] = {q0.x, q0.y, q0.z, q0.w, q1.x, q1.y, q1.z, q1.w, q2.x, q2.y, q2.z, q2.w, q3.x, q3.y, q3.z, q3.w};
            int tot = 0;
#pragma unroll
            for (int i = 0; i < 16; ++i) tot += (int)(wv[i] & 0xffffu) + (int)(wv[i] >> 16);
            int S = tot;
#pragma unroll
            for (int o = 1; o < 64; o <<= 1) { const int u = __shfl_down(S, o); if (lane + o < 64) S += u; }
            const int above = S - tot; const bool hit = above < TOPK && TOPK <= S;
            int a = above, d = 0, na = 0; bool found = false;
#pragma unroll
            for (int i = 31; i >= 0; --i) { const int cnt = (i & 1) ? (int)(wv[i >> 1] >> 16) : (int)(wv[i >> 1] & 0xffffu);
                if (!found && a + cnt >= TOPK) { found = true; d = i; na = a; } a += cnt; }
            const unsigned long long bm = __ballot(hit); const int src = __ffsll((long long)bm) - 1;
            b1 = __shfl(32 * lane + d, src); need1 = TOPK - __shfl(na, src);
        }
        if (lane == 0) { B1[row] = b1; NEED[row] = need1; }
    }
    __syncthreads();
    const int b1A = B1[rA], b1B = B1[rA + 1];
    unsigned* bmA = BM + (brow + tA) * 256; unsigned* bmB = bmA + 256;
    { u32x4 v; ix_stage_load(KI, brow, 0, tid, v); ix_stage_write(lds, 0, tid, v); }
    __syncthreads();
    for (int tile = 0; tile < ntile; ++tile) {
        u32x4 nx = {0u, 0u, 0u, 0u}; const bool more = tile + 1 < ntile;
        if (more) ix_stage_load(KI, brow, tile + 1, tid, nx);
        const LAS unsigned char* kt = lds + IXL_KT + (tile & 1) * 8192;
#pragma unroll
        for (int sub = 0; sub < 2; ++sub) {
            float sA, sB; ix_scores(W, kt, sub, lane, sA, sB);
            const int s = tile * 64 + sub * 32 + c;
            const unsigned kA = fkey(sA), kB = fkey(sB); const int binA = (int)(kA >> 21), binB = (int)(kB >> 21);
            const bool vA = s <= tA, vB = s <= tA + 1;
            const bool gA = vA && binA > b1A, gB = vB && binB > b1B, eA = vA && binA == b1A, eB = vB && binB == b1B;
            const unsigned long long bgA = __ballot(gA), bgB = __ballot(gB);
            if (c == 0) { bmA[tile * 2 + sub] = hi ? (unsigned)(bgA >> 32) : (unsigned)bgA; bmB[tile * 2 + sub] = hi ? (unsigned)(bgB >> 32) : (unsigned)bgB; }
            if (eA) { const unsigned idx = atomicAdd((unsigned*)&CNT[rA], 1u); if (idx < (unsigned)IX_CAP) LIST[rA * IX_CAP + idx] = (u32x2){kA, (unsigned)s}; }
            if (eB) { const unsigned idx = atomicAdd((unsigned*)&CNT[rA + 1], 1u); if (idx < (unsigned)IX_CAP) LIST[(rA + 1) * IX_CAP + idx] = (u32x2){kB, (unsigned)s}; }
        }
        if (more) ix_stage_write(lds, (tile + 1) & 1, tid, nx);
        __syncthreads();
    }
    { const int wend = ((t0 >> 8) + 1) * 8;
#pragma unroll 1
      for (int rr = 0; rr < 4; ++rr) { unsigned* bmr = BM + (brow + t0 + 4 * wave + rr) * 256;
          for (int w = 2 * ntile + lane; w < wend; w += 64) bmr[w] = 0u; } }
    asm volatile("s_waitcnt vmcnt(0)" ::: "memory");
#pragma unroll 1
    for (int rr = 0; rr < 4; ++rr) {
        const int row = 4 * wave + rr; const int cnt = (int)CNT[row], need = NEED[row];
        if (need == 0) continue;
        if (cnt > IX_CAP) { if (lane == 0) atomicOr((unsigned*)FLAG, 1u << row); continue; }
        const LAS u32x2* L = LIST + row * IX_CAP; unsigned* bmr = BM + (brow + t0 + row) * 256;
        if (need >= cnt) { for (int i = lane; i < cnt; i += 64) { const u32x2 e = L[i]; atomicOr(&bmr[e.y >> 5], 1u << (e.y & 31u)); } continue; }
        unsigned ck[8], cs[8]; int rank[8];
#pragma unroll
        for (int ch = 0; ch < 8; ++ch) { const int i = ch * 64 + lane; u32x2 e = {0u, 0xffffffffu}; if (i < cnt) e = L[i]; ck[ch] = e.x; cs[ch] = e.y; rank[ch] = 0; }
        const int nch = (cnt + 63) >> 6;
        for (int j = 0; j < cnt; ++j) { const u32x2 e = L[j];
#pragma unroll
            for (int ch = 0; ch < 8; ++ch) if (ch < nch) rank[ch] += (e.x > ck[ch] || (e.x == ck[ch] && e.y < cs[ch])) ? 1 : 0; }
#pragma unroll
        for (int ch = 0; ch < 8; ++ch) { const int i = ch * 64 + lane; if (i < cnt && rank[ch] < need) atomicOr(&bmr[cs[ch] >> 5], 1u << (cs[ch] & 31u)); }
    }
    __syncthreads();
    const unsigned flags = FLAG[0];
    if (flags) {
#pragma unroll 1
        for (int row = 0; row < 32; ++row) if ((flags >> row) & 1u) row_select_slow(C, lds, b, t0 + row, BM + (brow + t0 + row) * 256, ((t0 >> 8) + 1) * 8);
    }
}

namespace attn_body {
typedef _Float16 bf16;
using bf16x8=__attribute__((ext_vector_type(8)))short;
using s16x4=__attribute__((ext_vector_type(4)))short;
using f32x16=__attribute__((ext_vector_type(16)))float;
using u32x4=__attribute__((ext_vector_type(4)))unsigned;
constexpr int BATCH=4,NHEAD=8,SEQ=8192,D=64,DM=NHEAD*D;
constexpr int NW=8,QBLK=32,QB=QBLK*NW,KVBLK=64,NQB=SEQ/QB;
constexpr int ATTN_PITCH=DM, ATTN_UNIT_ROWS=QB;
__device__ __forceinline__ int crow(int r,int hi){return (r&3)+8*(r>>2)+4*hi;}
#define SBAR() __builtin_amdgcn_sched_barrier(0)
#define MFMA16(a,b,c,z0,z1,z2) __builtin_amdgcn_mfma_f32_32x32x16_f16(__builtin_bit_cast(f16x8,(a)),__builtin_bit_cast(f16x8,(b)),(c),0,0,0)
__device__ __forceinline__ void cmask(f32x16&p0,f32x16&p1,int jb,int qrel,int hi){
  const float NEG=-INFINITY; int kb=64*jb+4*hi;
  #pragma unroll
  for(int r=0;r<16;++r){int kv=kb+(r&3)+8*(r>>2); if(kv>qrel)p0[r]=NEG; if(kv+32>qrel)p1[r]=NEG;}
}

constexpr int NSLOT=3, SLOTB=8192;
constexpr int LDS_K=0, LDS_V=NSLOT*SLOTB, LDS_WS=2*NSLOT*SLOTB, LDS_OST=LDS_WS+NW*64*4, LDS_BYTES=LDS_OST+NW*4096;
constexpr float C2=0.125f*1.4426950408889634f;
__device__ __forceinline__ void glds16(const void*gsrc,unsigned lds_dst){unsigned keep;
  asm volatile("s_mov_b32 %0, m0\n\ts_mov_b32 m0, %2\n\ts_nop 0\n\tglobal_load_lds_dwordx4 %1, off\n\ts_mov_b32 m0, %0":"=&s"(keep):"v"(gsrc),"s"(lds_dst):"memory");}
__device__ __forceinline__ float max3f(float a,float b,float c){float r;asm("v_max3_f32 %0, %1, %2, %3":"=v"(r):"v"(a),"v"(b),"v"(c));return r;}
__device__ __forceinline__ float max2f(float a,float b){float r;asm("v_max_f32_e32 %0, %1, %2":"=v"(r):"v"(a),"v"(b));return r;}
__device__ __forceinline__ float fadd_s(float a,float b){float r;asm("v_add_f32_e32 %0, %1, %2":"=v"(r):"v"(a),"v"(b));return r;}
__device__ __forceinline__ float fsub_s(float a,float b){float r;asm("v_sub_f32_e32 %0, %1, %2":"=v"(r):"v"(a),"v"(b));return r;}
typedef float f32x2_t __attribute__((ext_vector_type(2))); typedef _Float16 bf16x2_t __attribute__((ext_vector_type(2)));
__device__ __forceinline__ unsigned cvtpk_s(float lo,float hi){f32x2_t v={lo,hi};bf16x2_t b=__builtin_convertvector(v,bf16x2_t);return __builtin_bit_cast(unsigned,b);}
#define WAIT_BAR(N) asm volatile("s_waitcnt vmcnt(" #N ") lgkmcnt(0)\n\ts_barrier":::"memory")

__device__ __forceinline__ void qkt(f32x16&p0,f32x16&p1,const char*Kslot,const bf16x8*qr,const f32x16&negm,int r32,int hi){
  const char*kb=Kslot+hi*1024+r32*16;
  #pragma unroll
  for(int d0=0;d0<4;++d0){
    const bf16x8 b0=*reinterpret_cast<const bf16x8*>(kb+d0*2048);
    const bf16x8 b1=*reinterpret_cast<const bf16x8*>(kb+d0*2048+512);
    if(d0==0){p0=MFMA16(b0,qr[0],negm,0,0,0);p1=MFMA16(b1,qr[0],negm,0,0,0);}
    else{p0=MFMA16(b0,qr[d0],p0,0,0,0);p1=MFMA16(b1,qr[d0],p1,0,0,0);}}
}
typedef __attribute__((address_space(3))) const char* lds_cptr;
typedef short v4i16_t __attribute__((ext_vector_type(4)));
__device__ __forceinline__ void kload8(bf16x8*kf,lds_cptr kp){
  kf[0]=*(const __attribute__((address_space(3))) bf16x8*)(kp);      kf[1]=*(const __attribute__((address_space(3))) bf16x8*)(kp+512);
  kf[2]=*(const __attribute__((address_space(3))) bf16x8*)(kp+2048); kf[3]=*(const __attribute__((address_space(3))) bf16x8*)(kp+2560);
  kf[4]=*(const __attribute__((address_space(3))) bf16x8*)(kp+4096); kf[5]=*(const __attribute__((address_space(3))) bf16x8*)(kp+4608);
  kf[6]=*(const __attribute__((address_space(3))) bf16x8*)(kp+6144); kf[7]=*(const __attribute__((address_space(3))) bf16x8*)(kp+6656);
}
__device__ __forceinline__ void kload2(bf16x8*kf,lds_cptr kp,int j){ kf[2*j]=*(const __attribute__((address_space(3))) bf16x8*)(kp+j*2048); kf[2*j+1]=*(const __attribute__((address_space(3))) bf16x8*)(kp+j*2048+512); }
__device__ __forceinline__ s16x4 vtr(lds_cptr p){ return __builtin_bit_cast(s16x4,__builtin_amdgcn_ds_read_tr16_b64_v4i16((__attribute__((address_space(3))) v4i16_t*)p)); }
__device__ __forceinline__ float rowmax(const f32x16&p0,const f32x16&p1){
  float a=max3f(p0[0],p0[1],p1[0]),b=max3f(p0[2],p0[3],p1[1]);a=max3f(a,p1[2],p1[3]);
  #pragma unroll
  for(int r=4;r<16;r+=4){a=max3f(a,p0[r],p0[r+1]);b=max3f(b,p0[r+2],p0[r+3]);a=max3f(a,p1[r],p1[r+1]);b=max3f(b,p1[r+2],p1[r+3]);}
  const float m=max2f(a,b);
  auto rr=__builtin_amdgcn_permlane32_swap(__float_as_uint(m),__float_as_uint(m),false,false);
  return max2f(__uint_as_float(rr[0]),__uint_as_float(rr[1]));
}
__device__ __forceinline__ void pv(f32x16*o,int vb,bf16x8 pa0,bf16x8 pa1,bf16x8 pa2,bf16x8 pa3){
  #pragma unroll
  for(int d0=0;d0<2;++d0){s16x4 lo[4],hi[4];
    #pragma unroll
    for(int ks=0;ks<4;++ks){
      asm volatile("ds_read_b64_tr_b16 %0,%1 offset:%c2":"=&v"(lo[ks]):"v"(vb),"i"(d0*4096+ks*1024):"memory");
      asm volatile("ds_read_b64_tr_b16 %0,%1 offset:%c2":"=&v"(hi[ks]):"v"(vb),"i"(d0*4096+ks*1024+512):"memory");}
    asm volatile("s_waitcnt lgkmcnt(0)":::"memory");SBAR();
    #define PK(k) (bf16x8){lo[k][0],lo[k][1],lo[k][2],lo[k][3],hi[k][0],hi[k][1],hi[k][2],hi[k][3]}
    o[d0]=MFMA16(pa0,PK(0),o[d0],0,0,0);
    o[d0]=MFMA16(pa1,PK(1),o[d0],0,0,0);
    o[d0]=MFMA16(pa2,PK(2),o[d0],0,0,0);
    o[d0]=MFMA16(pa3,PK(3),o[d0],0,0,0);
    #undef PK
  }
}

#ifndef ATTN_STORE16
#define ATTN_STORE16(p,v) (*(u32x4*)(p)=(v))
#endif
template<int THRL> __device__ __forceinline__ void attn_unit(int b,int h,int qb,const bf16*Q,const bf16*__restrict__ K,const bf16*__restrict__ V,bf16*O,const unsigned*BM,char*shm){
  const int tid=threadIdx.x,lane=tid&63,r32=lane&31,hi=lane>>5; const int wid=__builtin_amdgcn_readfirstlane(tid>>6);
  const long rowbase=(long)b*SEQ; const int q0=qb*QB;
  const bf16*Qw=Q+(rowbase+q0+wid*QBLK)*DM+h*D;
  const bf16*Kh=K+rowbase*DM+h*D,*Vh=V+rowbase*DM+h*D;
  const unsigned lds0=(unsigned)(uintptr_t)shm;
  float*wsf=(float*)(shm+LDS_WS)+wid*64;
  const bf16*ksrc=Kh+(long)lane*DM+wid*8;
  const bf16*vsrc=Vh+(long)(16*(wid&3)+(lane>>2))*DM+(wid>>2)*32+(lane&3)*8;
  const unsigned kdst=lds0+LDS_K+wid*1024, vdst=lds0+LDS_V+wid*1024;
  #define DMA_K(t,slot) glds16(ksrc+(long)(t)*KVBLK*DM,(unsigned)__builtin_amdgcn_readfirstlane(kdst+(slot)))
  #define DMA_V(t,slot) glds16(vsrc+(long)(t)*KVBLK*DM,(unsigned)__builtin_amdgcn_readfirstlane(vdst+(slot)))
  const int vb0=(int)(lds0+LDS_V)+((lane>>4)&1)*32+(lane&3)*8+(4*hi+((lane&15)>>2))*64;
  const char*Kbase=shm+LDS_K; bf16x8 kf[8];
  const lds_cptr shm3=(lds_cptr)shm; const lds_cptr kp0=shm3+LDS_K+hi*1024+r32*16; const lds_cptr vp0=shm3+LDS_V+((lane>>4)&1)*32+(lane&3)*8+(4*hi+((lane&15)>>2))*64;
  const int NT=(q0+QB)/KVBLK;
  unsigned moff=(unsigned)(rowbase+q0+wid*QBLK+r32)*1024u;
  const int sh4=4*hi;
  u32x2 mkE,mkO;
  #define LDMASK(dst,t) do{ asm volatile("global_load_dwordx2 %0, %1, %2":"=v"(dst):"v"(moff),"s"(BM):"memory"); moff+=8u; }while(0)
  #define MKPIN(V_) do{ asm volatile("":"+v"(V_)); V_[0]>>=sh4; V_[1]>>=sh4; }while(0)
  #define MAND(X,r,mw) X[r]=__uint_as_float(__float_as_uint(X[r])&(unsigned)__builtin_amdgcn_sbfe((int)(mw),((r)&3)+8*((r)>>2),1))
  LDMASK(mkE,0);LDMASK(mkO,1);
  DMA_K(0,0);DMA_V(0,0);DMA_K(1,SLOTB);
  bf16x8 qr[4];
  #pragma unroll
  for(int d0=0;d0<4;++d0)qr[d0]=*reinterpret_cast<const bf16x8*>(&Qw[(long)r32*DM+d0*16+hi*8]);
  float mhat=0.f,l_reg=0.f;f32x16 o[2];o[0]=f32x16{};o[1]=f32x16{};f32x16 negm=f32x16{};asm volatile("":"+v"(negm));
  const int qrel=wid*QBLK+r32;
  #define CMASK(P0,P1,t) do{}while(0)
  bool resc=false;
  #define START(P0,P1) do{ const float rm=rowmax(P0,P1); resc=false; \
    { const float dl=rm; mhat=fadd_s(mhat,dl); \
      _Pragma("unroll") for(int r=0;r<16;++r){P0[r]=fsub_s(P0[r],dl);P1[r]=fsub_s(P1[r],dl);} \
      _Pragma("unroll") for(int r=0;r<16;++r)negm[r]=-mhat; asm volatile("":"+v"(negm)); } \
    _Pragma("unroll") for(int r=0;r<16;++r)P0[r]=__builtin_amdgcn_exp2f(P0[r]); }while(0)
  #define RESC() do{ if(resc){ asm volatile("s_waitcnt lgkmcnt(0)":::"memory"); \
      _Pragma("unroll") for(int d_=0;d_<2;++d_) _Pragma("unroll") for(int r=0;r<16;++r)o[d_][r]*=wsf[crow(r,hi)]; } }while(0)
  f32x16 pA0,pA1,pB0,pB1;
  int sl_prev=0,sl_cur=0,sl_next=SLOTB;
  #define ROT() do{sl_prev=sl_cur;sl_cur=sl_next;sl_next=(sl_next==(NSLOT-1)*SLOTB)?0:sl_next+SLOTB;}while(0)
  DMA_K(2,2*SLOTB);
  WAIT_BAR(3); MKPIN(mkE); MKPIN(mkO);
  qkt(pA0,pA1,Kbase,qr,negm,r32,hi);asm volatile("s_nop 15\n\ts_nop 7":"+v"(pA0),"+v"(pA1));CMASK(pA0,pA1,0);
  START(pA0,pA1);
  _Pragma("unroll") for(int r=0;r<16;++r)pA1[r]=__builtin_amdgcn_exp2f(pA1[r]);
  { _Pragma("unroll") for(int r=0;r<16;++r){MAND(pA0,r,mkE[0]);MAND(pA1,r,mkE[1]);} }
  WAIT_BAR(0);
  DMA_K(3,0);DMA_V(1,SLOTB);
  ROT();
  kload8(kf,kp0+sl_cur);
  WAIT_BAR(2);
  s16x4 vlo[8],vhi[8]; u32x4 pw0,pw1,pw2,pw3;
  #define PKW(P,B) cvtpk_s(P[B],P[B+1])
  #define PAF(k) __builtin_bit_cast(bf16x8,pw##k)
  #define VFR(i) (bf16x8){vlo[i][0],vlo[i][1],vlo[i][2],vlo[i][3],vhi[i][0],vhi[i][1],vhi[i][2],vhi[i][3]}
  #define PIN(x) asm volatile("":"+v"(x))
  #define MX3(a,b,c) __builtin_fmaxf(__builtin_fmaxf((a),(b)),(c))
  #define GAPA(MF,A0,A1,A2,A3,W0,W1,PW) do{ MF; sacc+=A0; sacc+=A1; sacc+=A2; sacc+=A3; PIN(sacc); W0; W1; PIN(PW); SBAR(); }while(0)
  #define EX(v) __builtin_amdgcn_exp2f(v)
  #define GAPB(MF,X,B,MW) do{ MF; X[B]=EX(X[B]); X[B+1]=EX(X[B+1]); X[B+2]=EX(X[B+2]); X[B+3]=EX(X[B+3]); MAND(X,B,MW); MAND(X,B+1,MW); MAND(X,B+2,MW); MAND(X,B+3,MW); PIN(X); SBAR(); }while(0)
  #define VRD(i) do{ vlo[i]=vtr(vp_+(((i)>>2)*4096+((i)&3)*1024)); vhi[i]=vtr(vp_+(((i)>>2)*4096+((i)&3)*1024+512)); }while(0)
  #define KRD(G,j) do{ if(G){ kload2(kf,kp0+sl_next,j); SBAR(); } }while(0)
  #define STEP(C0,C1,P0,P1,t,GK,GV,GL,GM,MK,MKN) do{ SBAR(); \
    if(GM){LDMASK(MKN,(t)+1);} \
    const lds_cptr vp_=vp0+sl_prev; \
    VRD(0); SBAR(); float sacc=(P0[0]+P0[1]); \
    GAPA(C0=MFMA16(kf[0],qr[0],negm,0,0,0), P0[2],P0[3],P0[4],P0[5],     pw0[0]=PKW(P0,0), pw0[1]=PKW(P0,2), pw0); \
    VRD(4); SBAR(); GAPA(C1=MFMA16(kf[1],qr[0],negm,0,0,0), P0[6],P0[7],P0[8],P0[9],     pw0[2]=PKW(P0,4), pw0[3]=PKW(P0,6), pw0); \
    VRD(1); SBAR(); GAPA(C0=MFMA16(kf[2],qr[1],C0,0,0,0),   P0[10],P0[11],P0[12],P0[13], pw1[0]=PKW(P0,8), pw1[1]=PKW(P0,10), pw1); \
    VRD(5); SBAR(); GAPA(C1=MFMA16(kf[3],qr[1],C1,0,0,0),   P0[14],P0[15],P1[0],P1[1],   pw1[2]=PKW(P0,12),pw1[3]=PKW(P0,14), pw1); \
    VRD(2); SBAR(); GAPA(C0=MFMA16(kf[4],qr[2],C0,0,0,0),   P1[2],P1[3],P1[4],P1[5],     pw2[0]=PKW(P1,0), pw2[1]=PKW(P1,2), pw2); \
    VRD(6); SBAR(); GAPA(C1=MFMA16(kf[5],qr[2],C1,0,0,0),   P1[6],P1[7],P1[8],P1[9],     pw2[2]=PKW(P1,4), pw2[3]=PKW(P1,6), pw2); \
    VRD(3); SBAR(); GAPA(C0=MFMA16(kf[6],qr[3],C0,0,0,0),   P1[10],P1[11],P1[12],P1[13], pw3[0]=PKW(P1,8), pw3[1]=PKW(P1,10), pw3); \
    VRD(7); SBAR(); GAPA(C1=MFMA16(kf[7],qr[3],C1,0,0,0),   P1[14],P1[15],0.f,0.f,       pw3[2]=PKW(P1,12),pw3[3]=PKW(P1,14), pw3); \
    l_reg+=sacc; \
    if(GK){DMA_K((t)+3,sl_cur);} if(GV){DMA_V((t)+1,sl_next);} \
    CMASK(C0,C1,t); \
    { float a=MX3(C0[0],C0[1],C1[0]),b=MX3(C0[2],C0[3],C1[1]); a=MX3(a,C1[2],C1[3]); \
      _Pragma("unroll") for(int r=4;r<16;r+=4){a=MX3(a,C0[r],C0[r+1]);b=MX3(b,C0[r+2],C0[r+3]);a=MX3(a,C1[r],C1[r+1]);b=MX3(b,C1[r+2],C1[r+3]);} \
      float rm=__builtin_fmaxf(a,b); { auto rr=__builtin_amdgcn_permlane32_swap(__float_as_uint(rm),__float_as_uint(rm),false,false); rm=__builtin_fmaxf(__uint_as_float(rr[0]),__uint_as_float(rr[1])); } \
      resc=false; \
      if(__builtin_expect(__any(rm>(float)THRL),0)){ const float dl=__builtin_fmaxf(rm,0.f); mhat+=dl; \
        _Pragma("unroll") for(int r=0;r<16;++r){C0[r]-=dl;C1[r]-=dl;} \
        _Pragma("unroll") for(int r=0;r<16;++r)negm[r]=-mhat; asm volatile("":"+v"(negm)); \
        const float f=__builtin_amdgcn_exp2f(-dl); l_reg*=f; if(hi==0)wsf[r32]=f; resc=true; } } \
    SBAR(); \
    GAPB(o[0]=MFMA16(PAF(0),VFR(0),o[0],0,0,0), C0,0,(MK)[0]); \
    GAPB(o[1]=MFMA16(PAF(0),VFR(4),o[1],0,0,0), C0,4,(MK)[0]); \
    KRD(GL,0); GAPB(o[0]=MFMA16(PAF(1),VFR(1),o[0],0,0,0), C0,8,(MK)[0]); \
    KRD(GL,1); GAPB(o[1]=MFMA16(PAF(1),VFR(5),o[1],0,0,0), C0,12,(MK)[0]); \
    KRD(GL,2); GAPB(o[0]=MFMA16(PAF(2),VFR(2),o[0],0,0,0), C1,0,(MK)[1]); \
    KRD(GL,3); GAPB(o[1]=MFMA16(PAF(2),VFR(6),o[1],0,0,0), C1,4,(MK)[1]); \
    GAPB(o[0]=MFMA16(PAF(3),VFR(3),o[0],0,0,0), C1,8,(MK)[1]); \
    GAPB(o[1]=MFMA16(PAF(3),VFR(7),o[1],0,0,0), C1,12,(MK)[1]); \
    }while(0)
  int t=1;
  #undef CMASK
  #define CMASK(P0,P1,t) do{}while(0)
  for(;t+5<NT;t+=2){
    STEP(pB0,pB1,pA0,pA1,t,true,true,true,true,mkO,mkE);     WAIT_BAR(2); MKPIN(mkE); RESC(); ROT();
    STEP(pA0,pA1,pB0,pB1,t+1,true,true,true,true,mkE,mkO);   WAIT_BAR(2); MKPIN(mkO); RESC(); ROT();
  }
  #define ENDW(tt) do{ if((tt)+3<NT){WAIT_BAR(2);} else if((tt)+2<NT){WAIT_BAR(1);} else {WAIT_BAR(0);} }while(0)
  for(;t+1<NT;t+=2){
    STEP(pB0,pB1,pA0,pA1,t,(t+3<NT),(t+1<NT),(t+1<NT),true,mkO,mkE);           ENDW(t);   MKPIN(mkE); RESC(); ROT();
    STEP(pA0,pA1,pB0,pB1,t+1,(t+4<NT),(t+2<NT),(t+2<NT),(t+2<NT),mkE,mkO);     ENDW(t+1); MKPIN(mkO); RESC(); ROT();
  }
  STEP(pB0,pB1,pA0,pA1,NT-1,false,false,false,false,mkO,mkE); RESC();
  { float sacc=pB0[0]+pB0[1]; _Pragma("unroll") for(int r=2;r<16;++r)sacc+=pB0[r]; _Pragma("unroll") for(int r=0;r<16;++r)sacc+=pB1[r]; l_reg+=sacc;
    pw0=(u32x4){PKW(pB0,0),PKW(pB0,2),PKW(pB0,4),PKW(pB0,6)};pw1=(u32x4){PKW(pB0,8),PKW(pB0,10),PKW(pB0,12),PKW(pB0,14)};pw2=(u32x4){PKW(pB1,0),PKW(pB1,2),PKW(pB1,4),PKW(pB1,6)};pw3=(u32x4){PKW(pB1,8),PKW(pB1,10),PKW(pB1,12),PKW(pB1,14)};
    SBAR(); pv(o,vb0+sl_cur,PAF(0),PAF(1),PAF(2),PAF(3)); }
  #undef PKW
  #undef PAF
  #undef VFR
  #undef PIN
  #undef MX3
  #undef GAPA
  #undef GAPB
  #undef EX
  #undef VRD
  #undef KRD
  #undef STEP
  #undef ENDW
  {auto rr=__builtin_amdgcn_permlane32_swap(__float_as_uint(l_reg),__float_as_uint(l_reg),false,false);l_reg=__uint_as_float(rr[0])+__uint_as_float(rr[1]);}
  if(hi==0)wsf[32+r32]=l_reg;asm volatile("s_waitcnt lgkmcnt(0)":::"memory");
  float rli[16];
  #pragma unroll
  for(int r=0;r<16;++r)rli[r]=__builtin_amdgcn_rcpf(wsf[32+crow(r,hi)]);
  bf16*Ow=O+(rowbase+q0+wid*QBLK)*DM+h*D;
  { bf16*stg=(bf16*)(shm+LDS_OST)+wid*2048;
    #pragma unroll
    for(int r=0;r<16;++r){const int orow=crow(r,hi);
      #pragma unroll
      for(int d0=0;d0<2;++d0)stg[orow*64+d0*32+r32]=(bf16)(o[d0][r]*rli[r]);}
    asm volatile("s_waitcnt lgkmcnt(0)":::"memory");
    #pragma unroll
    for(int i=0;i<4;++i){const int row=i*8+(lane>>3),ch=lane&7; const u32x4 v=*(const u32x4*)(stg+row*64+ch*8); ATTN_STORE16(Ow+(long)row*DM+ch*8,v);} }
  asm volatile("s_waitcnt lgkmcnt(0)\n\ts_barrier":::"memory");
  #undef LDMASK
  #undef MKPIN
  #undef MAND
  #undef DMA_K
  #undef DMA_V
  #undef CMASK
  #undef START
  #undef RESC
  #undef ROT
}
constexpr int ATTN_LDS_BYTES=LDS_BYTES;
struct AttnTensors { const bf16* Q; const bf16* K; const bf16* V; bf16* O; const unsigned* BM; };
struct AttnUnit { int bh; int qb; };
struct StaticOrder {
  int vcu;
  __device__ __forceinline__ explicit StaticOrder(int grid,int block):vcu((block%8)*(grid/8)+block/8){}
  __device__ __forceinline__ bool next(int i,AttnUnit&u)const{ if(i>=4)return false; const int s=vcu&7; u.bh=vcu>>3; u.qb=(i==0)?s:(i==1)?15-s:(i==2)?16+s:31-s; return true; }
  __device__ __forceinline__ void a_ready(const AttnUnit&)const{}
  __device__ __forceinline__ void done(const AttnUnit&)const{}
};
template<class Sched,int THRL=8> __device__ __forceinline__ void attn_phase(char*lds,const AttnTensors&T,const Sched&S){
  AttnUnit u;
  for(int i=0;S.next(i,u);++i){ S.a_ready(u); attn_unit<THRL>(u.bh/NHEAD,u.bh%NHEAD,u.qb,T.Q,T.K,T.V,T.O,T.BM,lds); S.done(u); }
}
#undef SBAR
#undef WAIT_BAR
#undef MFMA16
}

__device__ __forceinline__ void stick_item(const Ctx& C, LAS float* attw, int b, int t, int h, int lane) {
    f16* QB = (f16*)(C.ws + WS_QB); const f16* KB = (const f16*)(C.ws + WS_KB); const f16* VB = (const f16*)(C.ws + WS_VB);
    const size_t brow = (size_t)b * SEQ, row = brow + t;
    u32x4 q[8];
#pragma unroll
    for (int i = 0; i < 8; ++i) q[i] = ((const u32x4*)(QB + row * 512 + h * 64))[i];
    float o = 0.f, carry = 0.f;
    for (int base = 0; base < t; base += 64) {
        const int s = t - 1 - base - lane; const bool valid = s >= 0;
        float z = 0.f;
        if (valid) { const u32x4* kp = (const u32x4*)(KB + (brow + s) * 512 + h * 64);
#pragma unroll
            for (int i = 0; i < 8; ++i) z = dot2x4(q[i], kp[i], z); }
        const float L = log1pf(expf(-fabsf(z)));
        const float l1m = valid ? -(fmaxf(z, 0.f) + L) : 0.f;
        const float lsg = fminf(z, 0.f) - L;
        float incl = l1m;
#pragma unroll
        for (int ofs = 1; ofs < 64; ofs <<= 1) { const float u = __shfl_up(incl, ofs); if (lane >= ofs) incl += u; }
        const float after = carry + (incl - l1m);
        const float att = valid ? expf(lsg + after) : 0.f;
        carry += __shfl(incl, 63);
        attw[lane] = att;
        asm volatile("s_waitcnt lgkmcnt(0)" ::: "memory");
        const int cnt = (t - base) < 64 ? (t - base) : 64;
        const f16* vp = VB + (brow + (t - 1 - base)) * 512 + h * 64 + lane;
#pragma unroll 8
        for (int l = 0; l < cnt; ++l) o += attw[l] * (float)vp[-(ptrdiff_t)l * 512];
        asm volatile("s_waitcnt lgkmcnt(0)" ::: "memory");
        if (carry < -105.f) break;
    }
    ((f16*)(C.ws + WS_OB))[row * 512 + h * 64 + lane] = (f16)o;
}

#ifndef DIAG
#define DIAG 0
#endif
#if DIAG
constexpr size_t WS_DIAG = 500 * MiB;
__device__ __forceinline__ unsigned hash_u(unsigned x) { x ^= x >> 16; x *= 0x7feb352dU; x ^= x >> 15; x *= 0x846ca68bU; x ^= x >> 16; return x; }
__device__ __forceinline__ bool close_(float got, float ref) { return fabsf(got - ref) <= 0.02f * fabsf(ref) + 0.01f; }
#endif
struct Args { const float* in[14]; float* out; unsigned char* ws; int ph_lo, ph_hi; };
constexpr int NPHASES = 12;

__global__ void __launch_bounds__(NTHREADS, 2) hyb_fwd(Args args) {
    extern __shared__ __attribute__((aligned(16))) unsigned char lds_raw[];
    LAS unsigned char* lds = (LAS unsigned char*)lds_raw;
    cg::grid_group grid = cg::this_grid();
    Ctx C;
    C.x = args.in[0]; C.c = args.in[1]; C.w_ada = args.in[2]; C.b_ada = args.in[3]; C.g_pre_mix = args.in[4]; C.w_in = args.in[5]; C.w_up_a = args.in[6]; C.w_up_b = args.in[7];
    C.w_out = args.in[8]; C.g_post_mix = args.in[9]; C.g_pre_ffn = args.in[10]; C.w_ff1 = args.in[11]; C.w_ff2 = args.in[12]; C.g_post_ffn = args.in[13];
    C.out = args.out; C.ws = args.ws; C.G = gridDim.x;
    { const int bx = blockIdx.x; C.vcu = (C.G % 8 == 0) ? (bx % 8) * (C.G / 8) + bx / 8 : bx; }
    const int lo = args.ph_lo, hi = args.ph_hi;
    const int tid = threadIdx.x, lane = tid & 63, wave = tid >> 6;
#define IN(k) (lo <= (k) && (k) < hi)
#define SEAM(k) do { if (IN(k) && IN((k) + 1)) grid.sync(); } while (0)
    unsigned char* ws = C.ws;

    if (IN(0)) { p0_prologue(C, lds); } SEAM(0);
    if (IN(1)) { p1_norm_rows(C); } SEAM(1);
    if (IN(2)) {
        pg8::Gemm g{(const f16*)(ws + WS_H), (const f16*)(ws + WS_WIN), M, NPROJ, DM}; pg8::StaticOrder S; S.init(M, NPROJ, C.G, (int)blockIdx.x);
        EpiProj E{ws}; pg8::gemm_phase<EpiProj>(lds, g, S, E);
    } SEAM(2);
    if (IN(3)) {
        for (int i = C.vcu; i < 1024; i += C.G) { const int b = i >> 8, j = i & 255, blk = (b & 1) ? 255 - j : j; ix_unit(C, lds, b, 32 * blk); }
#if DIAG
        __syncthreads();
        for (int i = C.vcu; i < 256; i += C.G) { const int row = (int)(hash_u(i * 2654435761u + 17u) % (unsigned)M); row_select_slow(C, lds, row / SEQ, row % SEQ, (unsigned*)(ws + WS_DIAG + MiB) + i * 256, 256); }
#endif
    } SEAM(3);
    if (IN(4)) {
        __syncthreads();
        {
            const attn_body::AttnTensors AT{(const attn_body::bf16*)(ws + WS_QA), (const attn_body::bf16*)(ws + WS_KA), (const attn_body::bf16*)(ws + WS_VA), (attn_body::bf16*)(ws + WS_OA), (const unsigned*)(ws + WS_BM)};
            if (C.G == 256) { const attn_body::StaticOrder S((int)C.G, (int)blockIdx.x); attn_body::attn_phase<attn_body::StaticOrder>((char*)lds_raw, AT, S); }
            else { for (int i = C.vcu; i < 1024; i += C.G) attn_body::attn_unit<8>((i >> 5) / 8, (i >> 5) % 8, i & 31, AT.Q, AT.K, AT.V, AT.O, AT.BM, (char*)lds_raw); }
        }
        __syncthreads();
        LAS float* attw = (LAS float*)(lds + wave * 256);
        const int gw = C.vcu * 8 + wave, NGW = C.G * 8;
        for (int it = gw; it < M * 8; it += NGW) { const int h = it & 7, r = it >> 3; stick_item(C, attw, r / SEQ, r % SEQ, h, lane); }
#if DIAG
        __syncthreads();
        for (int i = C.vcu; i < 256; i += C.G) { const int row = (int)(hash_u(i * 2654435761u + 17u) % (unsigned)M); row_unit(C, lds, row / SEQ, row % SEQ, (f16*)(ws + WS_DIAG + 2 * MiB) + i * 512, (const unsigned*)(ws + WS_BM) + (size_t)row * 256); }
#endif
    } SEAM(4);
    if (IN(5)) {
        pg8::Gemm g{(const f16*)(ws + WS_OA), (const f16*)(ws + WS_WUPA), M, DM, 512}; pg8::StaticOrder S; S.init(M, DM, C.G, (int)blockIdx.x);
        EpiGate<0> E{(const f16*)(ws + WS_GA), nullptr, (f16*)(ws + WS_T1)}; pg8::gemm_phase<EpiGate<0>>(lds, g, S, E);
    } SEAM(5);
    if (IN(6)) {
        pg8::Gemm g{(const f16*)(ws + WS_OB), (const f16*)(ws + WS_WUPB), M, DM, 512}; pg8::StaticOrder S; S.init(M, DM, C.G, (int)blockIdx.x);
        EpiGate<1> E{(const f16*)(ws + WS_GB), (const f16*)(ws + WS_T1), (f16*)(ws + WS_MG)}; pg8::gemm_phase<EpiGate<1>>(lds, g, S, E);
    } SEAM(6);
    if (IN(7)) {
        pg8::Gemm g{(const f16*)(ws + WS_MG), (const f16*)(ws + WS_WOUT), M, DM, DM}; pg8::StaticOrder S; S.init(M, DM, C.G, (int)blockIdx.x);
        EpiF32 E{(float*)(ws + WS_Y), DM}; pg8::gemm_phase<EpiF32>(lds, g, S, E);
    } SEAM(7);
    if (IN(8)) { p7_rows(C); } SEAM(8);
    if (IN(9)) {
        pg8::Gemm g{(const f16*)(ws + WS_H), (const f16*)(ws + WS_WFF1), M, DFF, DM}; pg8::StaticOrder S; S.init(M, DFF, C.G, (int)blockIdx.x);
        EpiSqRelu E{(f16*)(ws + WS_U), DFF}; pg8::gemm_phase<EpiSqRelu>(lds, g, S, E);
    } SEAM(9);
    if (IN(10)) {
        pg8::Gemm g{(const f16*)(ws + WS_U), (const f16*)(ws + WS_WFF2), M, DM, DFF}; pg8::StaticOrder S; S.init(M, DM, C.G, (int)blockIdx.x);
        EpiF32 E{(float*)(ws + WS_Y2), DM}; pg8::gemm_phase<EpiF32>(lds, g, S, E);
    } SEAM(10);
    if (IN(11)) { p10_rows(C); }
#undef IN
#undef SEAM
}


#if DIAG
__device__ __forceinline__ float projdot(const Args& a, int row, int n) {
    const f16* H = (const f16*)(a.ws + WS_H); const float* w = a.in[5]; const int sc = win_src(n); float s = 0.f;
    for (int k = 0; k < DM; ++k) s += (float)H[(size_t)row * DM + k] * w[(size_t)k * 5704 + sc];
    return s;
}
__global__ void diag_kernel(Args a, int test, int nsamp) {
    const int i = blockIdx.x * blockDim.x + threadIdx.x; if (i >= nsamp) return;
    unsigned char* ws = a.ws; unsigned* cnt = (unsigned*)(ws + WS_DIAG);
    const float* MOD = (const float*)(ws + WS_MOD);
    int bad = 0;
    const int row = (int)(hash_u(i * 2654435761u + 17u) % (unsigned)M), b = row / SEQ, pos = row % SEQ;
    if (test == 0) {
        const int bb = i & 3, n = (int)(hash_u(i + 99u) % 6144u); float s = a.in[3][n];
        for (int k = 0; k < DM; ++k) { const float v = a.in[1][bb * DM + k]; s += (v / (1.f + expf(-v))) * a.in[2][(size_t)k * 6144 + n]; }
        bad = !close_(MOD[bb * 6144 + n], s);
    } else if (test == 1) {
        float ss = 0.f; for (int k = 0; k < DM; ++k) { const float v = a.in[0][(size_t)row * DM + k]; ss += v * v; }
        const float r = 1.f / sqrtf(ss / DM + EPS); const f16* H = (const f16*)(ws + WS_H);
        for (int j = 0; j < 4; ++j) { const int col = (int)(hash_u(i * 4 + j + 5u) % 1024u);
            const float ref = a.in[0][(size_t)row * DM + col] * r * a.in[4][col] * (1.f + MOD[b * 6144 + 1024 + col]) + MOD[b * 6144 + col];
            bad |= !close_((float)H[(size_t)row * DM + col], ref); }
    } else if (test == 2) {
        const int n = (int)(hash_u(i * 7u + 1u) % 5704u);
        float ref = projdot(a, row, n), got;
        const float invf[8] = {1.0f, 0.1939227432012558f, 0.03760603070259094f, 0.007292664609849453f, 0.0014142135623842478f, 0.00027424818836152554f, 5.3182957344688475e-05f, 1.0313385246263351e-05f};
        if (n < 3584) {
            const int t = n / 512, cl = n % 512, d = cl & 63;
            if ((t == 0 || t == 1 || t == 6) && d < 16) { const float rp = projdot(a, row, d < 8 ? n + 8 : n - 8);
                float f = 1.f; for (int q = 0; q < 8; ++q) if ((d & 7) == q) f = invf[q];
                const float ang = (float)pos * f, cs = cosf(ang), sn = sinf(ang); ref = d < 8 ? ref * cs - rp * sn : ref * cs + rp * sn; }
            if (t == 0) ref *= 0.125f * 1.4426950408889634f; if (t == 3) ref *= 0.125f;
            const size_t off = (t == 0) ? WS_QA : (t == 1) ? WS_KA : (t == 2) ? WS_VA : (t == 3) ? WS_QB : (t == 4) ? WS_KB : (t == 5) ? WS_VB : WS_QI;
            got = (float)((const f16*)(ws + off))[(size_t)row * 512 + cl];
        } else if (n < 5632) { const int g = n - 3584; got = (g < 1024) ? (float)((const f16*)(ws + WS_GA))[(size_t)row * 1024 + g] : (float)((const f16*)(ws + WS_GB))[(size_t)row * 1024 + g - 1024]; }
        else { const int k = n - 5632;
            if (k < 64) { if (k < 16) { const float rp = projdot(a, row, k < 8 ? n + 8 : n - 8); float f = 1.f; for (int q = 0; q < 8; ++q) if ((k & 7) == q) f = invf[q];
                    const float ang = (float)pos * f, cs = cosf(ang), sn = sinf(ang); ref = k < 8 ? ref * cs - rp * sn : ref * cs + rp * sn; }
                got = (float)((const f16*)(ws + WS_KI))[(size_t)row * 64 + k]; }
            else got = ((const float*)(ws + WS_WI))[(size_t)row * 8 + (k - 64)]; }
        bad = !close_(got, ref);
    } else if (test == 3) {
        const int h = i & 7; const f16* QB = (const f16*)(ws + WS_QB); const f16* KB = (const f16*)(ws + WS_KB); const f16* VB = (const f16*)(ws + WS_VB); const f16* OB = (const f16*)(ws + WS_OB);
        const int d0 = (int)(hash_u(i + 1234u) % 16u) * 4;
        double o0 = 0, o1 = 0, o2 = 0, o3 = 0, after = 0;
        for (int s = pos - 1; s >= 0 && after > -200.0; --s) {
            const f16* kp = KB + ((size_t)b * SEQ + s) * 512 + h * 64; const f16* qp = QB + (size_t)row * 512 + h * 64; double z = 0;
            for (int d = 0; d < 64; ++d) z += (double)(float)qp[d] * (double)(float)kp[d];
            const double L = log1p(exp(-fabs(z))), lsg = fmin(z, 0.0) - L, l1m = -(fmax(z, 0.0) + L), att = exp(lsg + after);
            const f16* vp = VB + ((size_t)b * SEQ + s) * 512 + h * 64 + d0;
            o0 += att * (double)(float)vp[0]; o1 += att * (double)(float)vp[1]; o2 += att * (double)(float)vp[2]; o3 += att * (double)(float)vp[3];
            after += l1m; }
        const f16* op = OB + (size_t)row * 512 + h * 64 + d0;
        bad = !close_((float)op[0], (float)o0) || !close_((float)op[1], (float)o1) || !close_((float)op[2], (float)o2) || !close_((float)op[3], (float)o3);
    } else if (test == 4) {
        const int col = (int)(hash_u(i * 3u + 7u) % 1024u); const f16* OA = (const f16*)(ws + WS_OA); const f16* OB = (const f16*)(ws + WS_OB);
        float ya = 0.f, yb = 0.f; for (int k = 0; k < 512; ++k) { ya += (float)OA[(size_t)row * 512 + k] * a.in[6][(size_t)k * 1024 + col]; yb += (float)OB[(size_t)row * 512 + k] * a.in[7][(size_t)k * 1024 + col]; }
        const float ga = (float)((const f16*)(ws + WS_GA))[(size_t)row * 1024 + col], gb = (float)((const f16*)(ws + WS_GB))[(size_t)row * 1024 + col];
        const float ref = ya / (1.f + expf(-ga)) + yb / (1.f + expf(-gb));
        bad = !close_((float)((const f16*)(ws + WS_MG))[(size_t)row * 1024 + col], ref);
    } else if (test == 5) {
        const int col = (int)(hash_u(i * 3u + 11u) % 1024u); const f16* MG = (const f16*)(ws + WS_MG);
        float y = 0.f; for (int k = 0; k < 1024; ++k) y += (float)MG[(size_t)row * 1024 + k] * a.in[8][(size_t)k * 1024 + col];
        bad = !close_(((const float*)(ws + WS_Y))[(size_t)row * 1024 + col], y);
    } else if (test == 6) {
        const float* Y = (const float*)(ws + WS_Y); float ss = 0.f; for (int k = 0; k < DM; ++k) { const float v = Y[(size_t)row * DM + k]; ss += v * v; }
        const float r = 1.f / sqrtf(ss / DM + EPS); float s2 = 0.f;
        for (int k = 0; k < DM; ++k) { const float x1 = a.in[0][(size_t)row * DM + k] + MOD[b * 6144 + 2048 + k] * (Y[(size_t)row * DM + k] * r * a.in[9][k]); s2 += x1 * x1; }
        const float r2 = 1.f / sqrtf(s2 / DM + EPS); const f16* H = (const f16*)(ws + WS_H);
        for (int j = 0; j < 4; ++j) { const int k = (int)(hash_u(i * 4 + j + 55u) % 1024u);
            const float x1 = a.in[0][(size_t)row * DM + k] + MOD[b * 6144 + 2048 + k] * (Y[(size_t)row * DM + k] * r * a.in[9][k]);
            bad |= !close_(a.out[(size_t)row * DM + k], x1);
            const float h2 = x1 * r2 * a.in[10][k] * (1.f + MOD[b * 6144 + 4096 + k]) + MOD[b * 6144 + 3072 + k];
            bad |= !close_((float)H[(size_t)row * DM + k], h2); }
    }
    else if (test == 7) {
        const unsigned* BMr = (const unsigned*)(ws + WS_BM) + (size_t)row * 256; const unsigned* BS = (const unsigned*)(ws + WS_DIAG + MiB) + (size_t)i * 256;
        int d = 0, pc = 0; for (int w = 0; w <= (pos >> 5); ++w) { d += __popc(BMr[w] ^ BS[w]); pc += __popc(BMr[w]); }
        const int want = (pos + 1) < TOPK ? (pos + 1) : TOPK;
        if (d > 0) atomicAdd(&cnt[7], 1u); if (d > 4) atomicAdd(&cnt[8], 1u); if (pc != want) atomicAdd(&cnt[9], 1u);
        return;
    } else if (test == 10) {
        const f16* OA = (const f16*)(ws + WS_OA) + (size_t)row * 512; const f16* OR = (const f16*)(ws + WS_DIAG + 2 * MiB) + (size_t)i * 512;
        for (int k = 0; k < 512; ++k) bad |= !close_((float)OA[k], (float)OR[k]);
    }
    if (bad) atomicAdd(&cnt[test], 1u);
}
__global__ void diag_final(Args a, int ntests) {
    unsigned* cnt = (unsigned*)(a.ws + WS_DIAG);
    __shared__ unsigned AB[2];
    if (threadIdx.x == 0 && blockIdx.x == 0) { }
    unsigned A = cnt[10]; if (cnt[8] > 0u) A += 1000u; if (cnt[9] > 0u) A += 2000u;
    for (int t = 0; t < 7; ++t) if (cnt[t] > 4u) { A += 4000u; break; }
    const unsigned B = cnt[7];
    const int i = blockIdx.x * blockDim.x + threadIdx.x;
    if (i == 0) a.out[0] += 1.0e5f * (float)A;
    else if (i < (1 << 20)) a.out[i] += 30.0f * (float)B;
    (void)AB; (void)ntests;
}
#endif

extern "C" void kernel_launch(void* const* d_in, const int* in_sizes, int n_in, void* d_out, int out_size, void* d_ws, size_t ws_size, hipStream_t stream) {
    static int grid = 0;
    if (grid == 0) {
        if (n_in != 14 || out_size != M * DM || ws_size < WS_END) { fprintf(stderr, "kernel_launch: unexpected shapes n_in %d out %d ws %zu\n", n_in, out_size, ws_size); grid = -1; return; }
        int dev = 0, cus = 0, per_cu = 0;
        (void)hipGetDevice(&dev); (void)hipDeviceGetAttribute(&cus, hipDeviceAttributeMultiprocessorCount, dev);
        (void)hipFuncSetAttribute((const void*)hyb_fwd, hipFuncAttributeMaxDynamicSharedMemorySize, LDS_BYTES);
        (void)hipOccupancyMaxActiveBlocksPerMultiprocessor(&per_cu, (const void*)hyb_fwd, NTHREADS, LDS_BYTES);
        if (per_cu < 1) { fprintf(stderr, "kernel_launch: occupancy query says %d blocks/CU\n", per_cu); per_cu = 1; }
        (void)hipGetLastError();
        grid = cus * 1;
        fprintf(stderr, "kernel_launch: cus %d per_cu %d grid %d\n", cus, per_cu, grid);
    }
    if (grid < 0) return;
    Args a{};
    for (int i = 0; i < 14; ++i) a.in[i] = (const float*)d_in[i];
    a.out = (float*)d_out; a.ws = (unsigned char*)d_ws;
#if MK_SINGLE
    a.ph_lo = 0; a.ph_hi = NPHASES;
    { void* kargs[] = {&a}; hipError_t e = hipLaunchCooperativeKernel((const void*)hyb_fwd, dim3(grid), dim3(NTHREADS), kargs, LDS_BYTES, stream);
      if (e != hipSuccess) fprintf(stderr, "cooperative launch failed: %s\n", hipGetErrorString(e)); }
#else
#if DIAG
    (void)hipMemsetAsync((unsigned char*)d_ws + WS_DIAG, 0, 256, stream);
#endif
    for (int p = 0; p < NPHASES; ++p) {
        a.ph_lo = p; a.ph_hi = p + 1;
        void* kargs[] = {&a}; hipError_t e = hipLaunchCooperativeKernel((const void*)hyb_fwd, dim3(grid), dim3(NTHREADS), kargs, LDS_BYTES, stream);
        if (e != hipSuccess) { fprintf(stderr, "launch %d failed: %s\n", p, hipGetErrorString(e)); break; }
#if DIAG
        if (p == 0) hipLaunchKernelGGL(diag_kernel, dim3(8), dim3(64), 0, stream, a, 0, 512);
        if (p == 1) hipLaunchKernelGGL(diag_kernel, dim3(4), dim3(64), 0, stream, a, 1, 256);
        if (p == 2) hipLaunchKernelGGL(diag_kernel, dim3(64), dim3(64), 0, stream, a, 2, 4096);
        if (p == 3) hipLaunchKernelGGL(diag_kernel, dim3(4), dim3(64), 0, stream, a, 7, 256);
        if (p == 4) { hipLaunchKernelGGL(diag_kernel, dim3(8), dim3(64), 0, stream, a, 3, 512); hipLaunchKernelGGL(diag_kernel, dim3(4), dim3(64), 0, stream, a, 10, 256); }
        if (p == 6) hipLaunchKernelGGL(diag_kernel, dim3(32), dim3(64), 0, stream, a, 4, 2048);
        if (p == 7) hipLaunchKernelGGL(diag_kernel, dim3(32), dim3(64), 0, stream, a, 5, 2048);
        if (p == 8) hipLaunchKernelGGL(diag_kernel, dim3(4), dim3(64), 0, stream, a, 6, 256);
#endif
    }
#if DIAG
    hipLaunchKernelGGL(diag_final, dim3(4096), dim3(256), 0, stream, a, 7);
#endif
#endif
}
```

```cpp
#include <hip/hip_runtime.h>
#include <hip/hip_cooperative_groups.h>
#include <cstdio>
#include <cstdint>
namespace cg = cooperative_groups;

#ifndef MK_SINGLE
#define MK_SINGLE 1
#endif
#define DIAG 0

#define LAS __attribute__((address_space(3)))
typedef _Float16 f16;
typedef _Float16 f16x2 __attribute__((ext_vector_type(2)));
typedef _Float16 f16x8 __attribute__((ext_vector_type(8)));
typedef float f32x2 __attribute__((ext_vector_type(2)));
typedef float f32x4 __attribute__((ext_vector_type(4)));
typedef unsigned u32x4 __attribute__((ext_vector_type(4)));
typedef unsigned u32x2 __attribute__((ext_vector_type(2)));

constexpr int BATCH = 4, SEQ = 8192, DM = 1024, M = BATCH * SEQ, DFF = 4096;
constexpr int NPROJ = 5888;
constexpr float EPS = 1e-6f;
constexpr int TOPK = 256;

constexpr size_t MiB = 1u << 20;
constexpr size_t WS_WIN = 0, WS_WUPA = 12 * MiB, WS_WUPB = 13 * MiB, WS_WOUT = 14 * MiB, WS_WFF1 = 16 * MiB, WS_WFF2 = 24 * MiB;
constexpr size_t WS_MOD = 32 * MiB, WS_ROPE = 33 * MiB;
constexpr size_t WS_H = 40 * MiB;
constexpr size_t WS_KA = 104 * MiB, WS_VA = 136 * MiB, WS_KB = 168 * MiB, WS_VB = 200 * MiB, WS_QI = 232 * MiB, WS_QA = 264 * MiB, WS_QB = 296 * MiB;
constexpr size_t WS_GA = 328 * MiB, WS_GB = 392 * MiB, WS_KI = 456 * MiB, WS_WI = 460 * MiB;
constexpr size_t WS_OA = 40 * MiB, WS_OB = 72 * MiB;
constexpr size_t WS_T1 = 104 * MiB, WS_MG = 168 * MiB, WS_Y = 232 * MiB, WS_U = 104 * MiB, WS_Y2 = 360 * MiB;
constexpr size_t WS_BM = 461 * MiB;
constexpr size_t WS_END = 512 * MiB;

constexpr int LDS_BYTES = 151552;
constexpr int NTHREADS = 512;

namespace pg8 {
constexpr int BM = 256, BK = 64, HALF = 128, HTB = HALF * BK * 2, STAGE_BYTES = 8 * HTB, NXCD = 8, WGM = 8;
__host__ __device__ __forceinline__ int lds_byte(int r, int c) { const int st = (r >> 4) * 2 + (c >> 5), rr = r & 15, cc = c & 31, ob = rr * 64 + cc * 2; return st * 1024 + (ob ^ (((ob >> 9) & 1) << 5)); }
__host__ __device__ __forceinline__ void stage_rc(int b, int& R, int& C) { const int st = b / 1024, sb = b % 1024, swz = sb ^ (((sb >> 9) & 1) << 5); R = (st >> 1) * 16 + swz / 64; C = (st & 1) * 32 + (swz % 64) / 2; }
__host__ __device__ __forceinline__ int perm32(int rho) { const int n = rho >> 4, i = rho & 15; return 8 * (i >> 2) + 4 * n + (i & 3); }

struct Unit { int pm, pn; };
struct Gemm { const f16* A; const f16* Bt; int M, N, K; };

struct StaticOrder {
    int nM, nN, nwg, G, c;
    __host__ __device__ void init(int M_, int N_, int G_, int c_) { nM = M_ / BM; nN = N_ / BM; nwg = nM * nN; G = G_; c = c_; }
    __host__ __device__ bool next(int i, Unit& u) const {
        const long L = (long)i * G + c; if (L >= nwg) return false;
        int wgid = (int)L; { const int q = nwg / NXCD, r = nwg % NXCD, xcd = wgid % NXCD, off = wgid / NXCD; wgid = (xcd < r ? xcd * (q + 1) : r * (q + 1) + (xcd - r) * q) + off; }
        const int nig = WGM * nN, gid = wgid / nig, fm = gid * WGM, gsz = (nM - fm) < WGM ? (nM - fm) : WGM;
        u.pm = fm + ((wgid % nig) % gsz); u.pn = (wgid % nig) / gsz; return true;
    }
};

template <class Epi>
__device__ __forceinline__ void gemm_phase(LAS unsigned char* lds, const Gemm g, const StaticOrder& S, const Epi& E) {
    const int tid = threadIdx.x, wid = __builtin_amdgcn_readfirstlane(tid >> 6), lane = tid & 63, wr = wid >> 2, wc = wid & 3, fr = lane & 15, fq = lane >> 4;
    const int K = g.K, nt = K / BK;
    unsigned voffA[2], voffB[2];
#pragma unroll
    for (int i = 0; i < 2; ++i) { int R, C; stage_rc(tid * 16 + i * 8192, R, C); const int Rb = Epi::PERM ? ((R & ~31) + perm32(R & 31)) : R;
        voffA[i] = (unsigned)(R * K + C) * 2u; voffB[i] = (unsigned)(Rb * K + C) * 2u; }
    const size_t kstep = (size_t)(BK * 2);
    const size_t hstep = (size_t)HALF * K * 2;
    const size_t tstep = 2 * hstep;
    const unsigned ldsw = (unsigned)wid * 1024u;
    const int aoff = lds_byte(wr * 64 + fr, fq * 8), boff = lds_byte(wc * 32 + fr, fq * 8);
#define PG8_SA(b, h) (((b) * 2 + (h)) * HTB)
#define PG8_SB(b, h) ((4 + (b) * 2 + (h)) * HTB)
#define PG8_STAGE(bufoff, gbase, voff) do { _Pragma("unroll") for (int _i = 0; _i < 2; ++_i) \
        __builtin_amdgcn_global_load_lds((const unsigned*)((const char*)(gbase) + (voff)[_i]), (LAS unsigned*)(lds + (bufoff) + ldsw + _i * 8192), 16, 0, 0); } while (0)
#define PG8_LDA(dst, b, h) do { _Pragma("unroll") for (int m = 0; m < 4; ++m) _Pragma("unroll") for (int k = 0; k < 2; ++k) dst[m][k] = *(const LAS f16x8*)(lds + PG8_SA(b, h) + aoff + m * 2048 + k * 1024); } while (0)
#define PG8_LDB(dst, b, h) do { _Pragma("unroll") for (int n = 0; n < 2; ++n) _Pragma("unroll") for (int k = 0; k < 2; ++k) dst[n][k] = *(const LAS f16x8*)(lds + PG8_SB(b, h) + boff + n * 2048 + k * 1024); } while (0)
#define PG8_MMA(ai, bj, At, Bt) do { __builtin_amdgcn_s_setprio(1); _Pragma("unroll") for (int m = 0; m < 4; ++m) _Pragma("unroll") for (int n = 0; n < 2; ++n) _Pragma("unroll") for (int k = 0; k < 2; ++k) \
        acc[ai][bj][m][n] = __builtin_amdgcn_mfma_f32_16x16x32_f16(Bt[n][k], At[m][k], acc[ai][bj][m][n], 0, 0, 0); __builtin_amdgcn_s_setprio(0); } while (0)
#define PG8_WAIT_V(n) asm volatile("s_waitcnt vmcnt(" #n ")" ::: "memory")
#define PG8_WAIT_L(n) asm volatile("s_waitcnt lgkmcnt(" #n ")" ::: "memory")
#define PG8_BAR __builtin_amdgcn_s_barrier()
#define PG8_SCHED __builtin_amdgcn_sched_barrier(0)
    Unit cur, nxt; int ui = 0;
    if (!S.next(0, cur)) return;
    f32x4 acc[2][2][4][2];
#pragma unroll
    for (int a = 0; a < 2; ++a)
#pragma unroll
        for (int b = 0; b < 2; ++b)
#pragma unroll
            for (int m = 0; m < 4; ++m)
#pragma unroll
                for (int n = 0; n < 2; ++n) acc[a][b][m][n] = (f32x4){0.f, 0.f, 0.f, 0.f};
    f16x8 At[4][2], B0[2][2], B1[2][2];
    const char* cA = (const char*)g.A + (size_t)cur.pm * tstep; const char* cB = (const char*)g.Bt + (size_t)cur.pn * tstep;
    {
        PG8_STAGE(PG8_SB(0, 0), cB, voffB); PG8_STAGE(PG8_SB(0, 1), cB + hstep, voffB); PG8_STAGE(PG8_SA(0, 0), cA, voffA); PG8_STAGE(PG8_SA(0, 1), cA + hstep, voffA);
        if (wr == 1) PG8_BAR;
        PG8_WAIT_V(2); PG8_BAR;
        PG8_STAGE(PG8_SB(1, 0), cB + kstep, voffB); PG8_STAGE(PG8_SA(1, 0), cA + kstep, voffA); PG8_STAGE(PG8_SB(1, 1), cB + hstep + kstep, voffB);
        PG8_WAIT_V(6); PG8_BAR;
    }
    for (;;) {
        const bool has_next = S.next(ui + 1, nxt);
        const char* nA = has_next ? (const char*)g.A + (size_t)nxt.pm * tstep : cA; const char* nB = has_next ? (const char*)g.Bt + (size_t)nxt.pn * tstep : cB;
        for (int t = 0; t < nt; t += 2) {
            const bool last = (t == nt - 2);
            const char* a1 = cA + (size_t)(t + 1) * kstep;
            const char* a2 = last ? nA : cA + (size_t)(t + 2) * kstep; const char* b2 = last ? nB : cB + (size_t)(t + 2) * kstep;
            const char* a3 = a2 + kstep; const char* b3 = b2 + kstep;
            PG8_LDB(B0, 0, 0); PG8_LDB(B1, 0, 1); PG8_SCHED; PG8_LDA(At, 0, 0); PG8_STAGE(PG8_SA(1, 1), a1 + hstep, voffA);
            PG8_WAIT_V(8); PG8_WAIT_L(0); PG8_BAR; PG8_MMA(0, 0, At, B0); PG8_MMA(0, 1, At, B1); PG8_BAR; PG8_SCHED;
            PG8_LDA(At, 0, 1); PG8_STAGE(PG8_SB(0, 0), b2, voffB); PG8_STAGE(PG8_SB(0, 1), b2 + hstep, voffB); PG8_STAGE(PG8_SA(0, 0), a2, voffA);
            PG8_WAIT_V(8); PG8_WAIT_L(0); PG8_BAR; PG8_MMA(1, 0, At, B0); PG8_MMA(1, 1, At, B1); PG8_BAR; PG8_SCHED;
            PG8_LDB(B0, 1, 0); PG8_LDB(B1, 1, 1); PG8_SCHED; PG8_LDA(At, 1, 0); PG8_STAGE(PG8_SA(0, 1), a2 + hstep, voffA);
            PG8_WAIT_V(8); PG8_WAIT_L(0); PG8_BAR; PG8_MMA(0, 0, At, B0); PG8_MMA(0, 1, At, B1); PG8_BAR; PG8_SCHED;
            PG8_LDA(At, 1, 1); PG8_STAGE(PG8_SB(1, 0), b3, voffB); PG8_STAGE(PG8_SB(1, 1), b3 + hstep, voffB); PG8_STAGE(PG8_SA(1, 0), a3, voffA);
            PG8_WAIT_V(8); PG8_WAIT_L(0); PG8_BAR; PG8_MMA(1, 0, At, B0); PG8_MMA(1, 1, At, B1); PG8_BAR; PG8_SCHED;
        }
        if (wr == 0) PG8_BAR;
        E(acc, cur, wr, wc, fr, fq);
        if (!has_next) break;
#pragma unroll
        for (int a = 0; a < 2; ++a)
#pragma unroll
            for (int b = 0; b < 2; ++b)
#pragma unroll
                for (int m = 0; m < 4; ++m)
#pragma unroll
                    for (int n = 0; n < 2; ++n) acc[a][b][m][n] = (f32x4){0.f, 0.f, 0.f, 0.f};
        cur = nxt; cA = nA; cB = nB; ++ui;
        if (wr == 1) PG8_BAR;
    }
    PG8_WAIT_V(0);
    PG8_BAR;
#undef PG8_SA
#undef PG8_SB
#undef PG8_STAGE
#undef PG8_LDA
#undef PG8_LDB
#undef PG8_MMA
#undef PG8_WAIT_V
#undef PG8_WAIT_L
#undef PG8_BAR
#undef PG8_SCHED
}
}

__device__ __forceinline__ unsigned pkh(float lo, float hi) { f32x2 v = {lo, hi}; f16x2 h = __builtin_convertvector(v, f16x2); return __builtin_bit_cast(unsigned, h); }
__device__ __forceinline__ f32x2 unpkh(unsigned u) { f16x2 h = __builtin_bit_cast(f16x2, u); return __builtin_convertvector(h, f32x2); }
__device__ __forceinline__ float sigmoidf_(float x) { return 1.f / (1.f + __expf(-x)); }
__device__ __forceinline__ f16x2 ash2(unsigned u) { return __builtin_bit_cast(f16x2, u); }
__device__ __forceinline__ float dot2x4(u32x4 a, u32x4 b, float d) {
    const unsigned a0 = a.x, a1 = a.y, a2 = a.z, a3 = a.w, b0 = b.x, b1 = b.y, b2 = b.z, b3 = b.w;
    d = __builtin_amdgcn_fdot2(ash2(a0), ash2(b0), d, false);
    d = __builtin_amdgcn_fdot2(ash2(a1), ash2(b1), d, false);
    d = __builtin_amdgcn_fdot2(ash2(a2), ash2(b2), d, false);
    d = __builtin_amdgcn_fdot2(ash2(a3), ash2(b3), d, false);
    return d;
}
__device__ __forceinline__ float wave_sum(float v) {
#pragma unroll
    for (int o = 1; o < 64; o <<= 1) v += __shfl_xor(v, o);
    return v;
}
__device__ __forceinline__ float wave_max(float v) {
#pragma unroll
    for (int o = 1; o < 64; o <<= 1) v = fmaxf(v, __shfl_xor(v, o));
    return v;
}
__device__ __forceinline__ unsigned fkey(float f) { const unsigned u = __float_as_uint(f); return (u & 0x80000000u) ? ~u : (u | 0x80000000u); }

struct Ctx {
    const float *x, *c, *w_ada, *b_ada, *g_pre_mix, *w_in, *w_up_a, *w_up_b, *w_out, *g_post_mix, *g_pre_ffn, *w_ff1, *w_ff2, *g_post_ffn;
    float* out; unsigned char* ws;
    int G, vcu;
};

struct EpiProj {
    static constexpr bool PERM = true;
    unsigned char* ws;
    __device__ __forceinline__ void operator()(const f32x4 (&acc)[2][2][4][2], const pg8::Unit& u, int wr, int wc, int fr, int fq) const {
        const int pn = u.pn, rowb = u.pm * 256 + wr * 64 + fr;
        const float* RC = (const float*)(ws + WS_ROPE); const float* RS = RC + SEQ * 8;
        f16* base; int ld, colb; bool rope = false; float sc = 1.f; int nbj = 2;
        if (pn < 14) {
            const int t = pn >> 1;
            const size_t off = (t == 0) ? WS_QA : (t == 1) ? WS_KA : (t == 2) ? WS_VA : (t == 3) ? WS_QB : (t == 4) ? WS_KB : (t == 5) ? WS_VB : WS_QI;
            base = (f16*)(ws + off); ld = 512; colb = (pn & 1) * 256 + wc * 32 + 8 * fq;
            rope = (t == 0 || t == 1 || t == 6) && ((wc & 1) == 0);
            sc = (t == 0 || t == 3) ? 0.125f * 1.4426950408889634f : 1.f;
        } else if (pn < 22) {
            base = (f16*)(ws + (pn < 18 ? WS_GA : WS_GB)); ld = 1024; colb = ((pn - 14) & 3) * 256 + wc * 32 + 8 * fq;
        } else {
            nbj = 1;
            if (wc >= 2) {
                if (wc == 2 && fq == 0) {
                    float* WI = (float*)(ws + WS_WI);
#pragma unroll
                    for (int ai = 0; ai < 2; ++ai)
#pragma unroll
                        for (int m = 0; m < 4; ++m) { const int row = rowb + ai * 128 + m * 16;
                            *(f32x4*)(WI + (size_t)row * 8) = acc[ai][0][m][0]; *(f32x4*)(WI + (size_t)row * 8 + 4) = acc[ai][0][m][1]; }
                }
                return;
            }
            base = (f16*)(ws + WS_KI); ld = 64; colb = wc * 32 + 8 * fq; rope = (wc == 0);
        }
        const float sgn = (fq == 0) ? -1.f : 1.f;
#pragma unroll
        for (int ai = 0; ai < 2; ++ai)
#pragma unroll
            for (int m = 0; m < 4; ++m) {
                const int row = rowb + ai * 128 + m * 16, pos = row & (SEQ - 1);
                f32x4 c0 = {1.f, 1.f, 1.f, 1.f}, c1 = c0, s0 = {0.f, 0.f, 0.f, 0.f}, s1 = s0;
                if (rope) { c0 = *(const f32x4*)(RC + pos * 8); c1 = *(const f32x4*)(RC + pos * 8 + 4); s0 = *(const f32x4*)(RS + pos * 8); s1 = *(const f32x4*)(RS + pos * 8 + 4); }
#pragma unroll
                for (int bj = 0; bj < 2; ++bj) { if (bj < nbj) {
                    f32x4 v0 = acc[ai][bj][m][0], v1 = acc[ai][bj][m][1];
                    if (rope) {
                        f32x4 p0, p1;
#pragma unroll
                        for (int i = 0; i < 4; ++i) { p0[i] = __shfl_xor(v0[i], 16); p1[i] = __shfl_xor(v1[i], 16); }
                        if (fq < 2) { v0 = v0 * c0 + (p0 * s0) * sgn; v1 = v1 * c1 + (p1 * s1) * sgn; }
                    }
                    v0 = v0 * sc; v1 = v1 * sc;
                    u32x4 w; w.x = pkh(v0[0], v0[1]); w.y = pkh(v0[2], v0[3]); w.z = pkh(v1[0], v1[1]); w.w = pkh(v1[2], v1[3]);
                    *(u32x4*)(base + (size_t)row * ld + colb + bj * 128) = w; } }
            }
    }
};

template <int MODE>
struct EpiGate {
    static constexpr bool PERM = true;
    const f16* G; const f16* T1; f16* O;
    __device__ __forceinline__ void operator()(const f32x4 (&acc)[2][2][4][2], const pg8::Unit& u, int wr, int wc, int fr, int fq) const {
        const int rowb = u.pm * 256 + wr * 64 + fr, colb = u.pn * 256 + wc * 32 + 8 * fq;
#pragma unroll
        for (int ai = 0; ai < 2; ++ai)
#pragma unroll
            for (int m = 0; m < 4; ++m) { const size_t ro = (size_t)(rowb + ai * 128 + m * 16) * 1024 + colb;
#pragma unroll
                for (int bj = 0; bj < 2; ++bj) {
                    const u32x4 gw = *(const u32x4*)(G + ro + bj * 128);
                    f32x2 g0 = unpkh(gw.x), g1 = unpkh(gw.y), g2 = unpkh(gw.z), g3 = unpkh(gw.w);
                    const f32x4 a0 = acc[ai][bj][m][0], a1 = acc[ai][bj][m][1];
                    float r[8] = {sigmoidf_(g0.x) * a0[0], sigmoidf_(g0.y) * a0[1], sigmoidf_(g1.x) * a0[2], sigmoidf_(g1.y) * a0[3],
                                  sigmoidf_(g2.x) * a1[0], sigmoidf_(g2.y) * a1[1], sigmoidf_(g3.x) * a1[2], sigmoidf_(g3.y) * a1[3]};
                    if (MODE == 1) { const u32x4 tw = *(const u32x4*)(T1 + ro + bj * 128);
                        f32x2 t0 = unpkh(tw.x), t1 = unpkh(tw.y), t2 = unpkh(tw.z), t3 = unpkh(tw.w);
                        r[0] += t0.x; r[1] += t0.y; r[2] += t1.x; r[3] += t1.y; r[4] += t2.x; r[5] += t2.y; r[6] += t3.x; r[7] += t3.y; }
                    u32x4 w; w.x = pkh(r[0], r[1]); w.y = pkh(r[2], r[3]); w.z = pkh(r[4], r[5]); w.w = pkh(r[6], r[7]);
                    *(u32x4*)(O + ro + bj * 128) = w; } }
    }
};

struct EpiSqRelu {
    static constexpr bool PERM = true;
    f16* O; int ldc;
    __device__ __forceinline__ void operator()(const f32x4 (&acc)[2][2][4][2], const pg8::Unit& u, int wr, int wc, int fr, int fq) const {
        const int rowb = u.pm * 256 + wr * 64 + fr, colb = u.pn * 256 + wc * 32 + 8 * fq;
#pragma unroll
        for (int ai = 0; ai < 2; ++ai)
#pragma unroll
            for (int m = 0; m < 4; ++m) { const size_t ro = (size_t)(rowb + ai * 128 + m * 16) * ldc + colb;
#pragma unroll
                for (int bj = 0; bj < 2; ++bj) {
                    f32x4 a0 = acc[ai][bj][m][0], a1 = acc[ai][bj][m][1];
#pragma unroll
                    for (int i = 0; i < 4; ++i) { a0[i] = fmaxf(a0[i], 0.f); a1[i] = fmaxf(a1[i], 0.f); }
                    a0 = a0 * a0; a1 = a1 * a1;
                    u32x4 w; w.x = pkh(a0[0], a0[1]); w.y = pkh(a0[2], a0[3]); w.z = pkh(a1[0], a1[1]); w.w = pkh(a1[2], a1[3]);
                    *(u32x4*)(O + ro + bj * 128) = w; } }
    }
};

struct EpiF32 {
    static constexpr bool PERM = false;
    float* C; int ldc;
    __device__ __forceinline__ void operator()(const f32x4 (&acc)[2][2][4][2], const pg8::Unit& u, int wr, int wc, int fr, int fq) const {
        const int row0 = u.pm * 256 + wr * 64 + fr, col0 = u.pn * 256 + wc * 32 + 4 * fq;
#pragma unroll
        for (int ai = 0; ai < 2; ++ai)
#pragma unroll
            for (int m = 0; m < 4; ++m) { float* rowp = C + (size_t)(row0 + ai * 128 + m * 16) * ldc + col0;
#pragma unroll
                for (int bj = 0; bj < 2; ++bj)
#pragma unroll
                    for (int n = 0; n < 2; ++n) *(f32x4*)(rowp + bj * 128 + n * 16) = acc[ai][bj][m][n]; }
    }
};

__device__ __forceinline__ int win_src(int n) {
    if (n < 3584) return n;
    if (n < 5632) return n + 72;
    if (n < 5704) return n - 5632 + 3584;
    return -1;
}
template <bool MAP>
__device__ __forceinline__ void p0_transpose_item(const float* W, int K, int N, f16* WT, LAS float* scr, int nblk, int item, int lane) {
    const int kb = item / nblk, nb = item % nblk, k0 = 64 * kb, n0 = 32 * nb;
    const int nd = n0 + (lane & 31); const int sc = MAP ? win_src(nd) : nd;
#pragma unroll 8
    for (int i = 0; i < 32; ++i) { const int kk = 2 * i + (lane >> 5); scr[kk * 33 + (lane & 31)] = (sc >= 0) ? W[(size_t)(k0 + kk) * N + sc] : 0.f; }
    asm volatile("s_waitcnt lgkmcnt(0)" ::: "memory");
    const int c = lane & 7;
#pragma unroll
    for (int j = 0; j < 4; ++j) { const int n = (lane >> 3) + 8 * j; const LAS float* s = scr + (8 * c) * 33 + n;
        u32x4 o; o.x = pkh(s[0 * 33], s[1 * 33]); o.y = pkh(s[2 * 33], s[3 * 33]); o.z = pkh(s[4 * 33], s[5 * 33]); o.w = pkh(s[6 * 33], s[7 * 33]);
        *(u32x4*)(WT + (size_t)(n0 + n) * K + k0 + 8 * c) = o; }
    asm volatile("s_waitcnt lgkmcnt(0)" ::: "memory");
}

__device__ __forceinline__ void p0_prologue(const Ctx& C, LAS unsigned char* lds) {
    const int tid = threadIdx.x, lane = tid & 63, wave = tid >> 6;
    {
        LAS float* SL = (LAS float*)lds;
        LAS float* RED = (LAS float*)(lds + 16384);
        for (int i = tid; i < 4096; i += NTHREADS) { const float v = C.c[i]; SL[i] = v / (1.f + expf(-v)); }
        __syncthreads();
        float* MOD = (float*)(C.ws + WS_MOD);
        for (int it = C.vcu; it < 192; it += C.G) {
            const int n0 = it * 32, col = n0 + (lane & 31), ks = lane >> 5;
            float a0 = 0.f, a1 = 0.f, a2 = 0.f, a3 = 0.f;
#pragma unroll 16
            for (int i = 0; i < 64; ++i) { const int k = wave * 128 + 2 * i + ks; const float w = C.w_ada[(size_t)k * 6144 + col];
                a0 += SL[k] * w; a1 += SL[1024 + k] * w; a2 += SL[2048 + k] * w; a3 += SL[3072 + k] * w; }
            a0 += __shfl_xor(a0, 32); a1 += __shfl_xor(a1, 32); a2 += __shfl_xor(a2, 32); a3 += __shfl_xor(a3, 32);
            if (lane < 32) { RED[wave * 128 + lane] = a0; RED[wave * 128 + 32 + lane] = a1; RED[wave * 128 + 64 + lane] = a2; RED[wave * 128 + 96 + lane] = a3; }
            __syncthreads();
            if (tid < 128) { float s = 0.f;
#pragma unroll
                for (int w = 0; w < 8; ++w) s += RED[w * 128 + tid];
                const int b = tid >> 5, cc = n0 + (tid & 31); MOD[b * 6144 + cc] = s + C.b_ada[cc]; }
            __syncthreads();
        }
    }
    {
        float* RC = (float*)(C.ws + WS_ROPE); float* RS = RC + SEQ * 8;
        const float invf[8] = {1.0f, 0.1939227432012558f, 0.03760603070259094f, 0.007292664609849453f, 0.0014142135623842478f, 0.00027424818836152554f, 5.3182957344688475e-05f, 1.0313385246263351e-05f};
        for (int i = C.vcu * NTHREADS + tid; i < SEQ * 8; i += C.G * NTHREADS) { const int pos = i >> 3, j = i & 7;
            float f = invf[0];
#pragma unroll
            for (int q = 1; q < 8; ++q) f = (j == q) ? invf[q] : f;
            const float ang = (float)pos * f; RC[i] = cosf(ang); RS[i] = sinf(ang); }
    }
    {
        __syncthreads();
        LAS float* scr = (LAS float*)(lds + wave * 16384);
        const int gw = C.vcu * 8 + wave, NGW = C.G * 8;
        constexpr int I_IN = (DM / 64) * (NPROJ / 32), I_UP = (512 / 64) * (DM / 32), I_OUT = (DM / 64) * (DM / 32), I_F1 = (DM / 64) * (DFF / 32), I_F2 = (DFF / 64) * (DM / 32);
        constexpr int NITEMS = I_IN + 2 * I_UP + I_OUT + I_F1 + I_F2;
        for (int it = gw; it < NITEMS; it += NGW) {
            int r = it;
            if (r < I_IN) { p0_transpose_item<true>(C.w_in, DM, 5704, (f16*)(C.ws + WS_WIN), scr, NPROJ / 32, r, lane); continue; } r -= I_IN;
            if (r < I_UP) { p0_transpose_item<false>(C.w_up_a, 512, DM, (f16*)(C.ws + WS_WUPA), scr, DM / 32, r, lane); continue; } r -= I_UP;
            if (r < I_UP) { p0_transpose_item<false>(C.w_up_b, 512, DM, (f16*)(C.ws + WS_WUPB), scr, DM / 32, r, lane); continue; } r -= I_UP;
            if (r < I_OUT) { p0_transpose_item<false>(C.w_out, DM, DM, (f16*)(C.ws + WS_WOUT), scr, DM / 32, r, lane); continue; } r -= I_OUT;
            if (r < I_F1) { p0_transpose_item<false>(C.w_ff1, DM, DFF, (f16*)(C.ws + WS_WFF1), scr, DFF / 32, r, lane); continue; } r -= I_F1;
            p0_transpose_item<false>(C.w_ff2, DFF, DM, (f16*)(C.ws + WS_WFF2), scr, DM / 32, r, lane);
        }
    }
}

__device__ __forceinline__ void p1_norm_rows(const Ctx& C) {
    const int tid = threadIdx.x, lane = tid & 63, wave = tid >> 6;
    const int gw = C.vcu * 8 + wave, NGW = C.G * 8;
    const float* MOD = (const float*)(C.ws + WS_MOD);
    f16* H = (f16*)(C.ws + WS_H);
    for (int m = gw; m < M; m += NGW) {
        const int b = m / SEQ;
        const f32x4* xr = (const f32x4*)(C.x + (size_t)m * DM) + lane;
        f32x4 v[4]; float s = 0.f;
#pragma unroll
        for (int j = 0; j < 4; ++j) { v[j] = xr[64 * j]; s += (v[j].x * v[j].x + v[j].y * v[j].y) + (v[j].z * v[j].z + v[j].w * v[j].w); }
        const float r = 1.0f / sqrtf(wave_sum(s) * (1.f / DM) + EPS);
        u32x2* o8 = (u32x2*)(H + (size_t)m * DM) + lane;
#pragma unroll
        for (int j = 0; j < 4; ++j) {
            const f32x4 g = ((const f32x4*)C.g_pre_mix)[lane + 64 * j];
            const f32x4 sh = ((const f32x4*)(MOD + b * 6144))[lane + 64 * j];
            const f32x4 sc = ((const f32x4*)(MOD + b * 6144 + 1024))[lane + 64 * j];
            const f32x4 y = (v[j] * r) * g * (sc + 1.0f) + sh;
            u32x2 w; w.x = pkh(y.x, y.y); w.y = pkh(y.z, y.w); o8[64 * j] = w;
        }
    }
}
__device__ __forceinline__ void p7_rows(const Ctx& C) {
    const int tid = threadIdx.x, lane = tid & 63, wave = tid >> 6;
    const int gw = C.vcu * 8 + wave, NGW = C.G * 8;
    const float* MOD = (const float*)(C.ws + WS_MOD);
    const float* Y = (const float*)(C.ws + WS_Y);
    f16* H = (f16*)(C.ws + WS_H);
    for (int m = gw; m < M; m += NGW) {
        const int b = m / SEQ;
        const f32x4* yr = (const f32x4*)(Y + (size_t)m * DM) + lane;
        const f32x4* xr = (const f32x4*)(C.x + (size_t)m * DM) + lane;
        f32x4 y[4], xv[4]; float s = 0.f;
#pragma unroll
        for (int j = 0; j < 4; ++j) { y[j] = yr[64 * j]; xv[j] = xr[64 * j]; s += (y[j].x * y[j].x + y[j].y * y[j].y) + (y[j].z * y[j].z + y[j].w * y[j].w); }
        const float r = 1.0f / sqrtf(wave_sum(s) * (1.f / DM) + EPS);
        float s2 = 0.f;
        f32x4* orow = (f32x4*)(C.out + (size_t)m * DM) + lane;
#pragma unroll
        for (int j = 0; j < 4; ++j) {
            const f32x4 g = ((const f32x4*)C.g_post_mix)[lane + 64 * j];
            const f32x4 ga = ((const f32x4*)(MOD + b * 6144 + 2048))[lane + 64 * j];
            xv[j] = xv[j] + ga * ((y[j] * r) * g);
            orow[64 * j] = xv[j];
            s2 += (xv[j].x * xv[j].x + xv[j].y * xv[j].y) + (xv[j].z * xv[j].z + xv[j].w * xv[j].w);
        }
        const float r2 = 1.0f / sqrtf(wave_sum(s2) * (1.f / DM) + EPS);
        u32x2* o8 = (u32x2*)(H + (size_t)m * DM) + lane;
#pragma unroll
        for (int j = 0; j < 4; ++j) {
            const f32x4 g = ((const f32x4*)C.g_pre_ffn)[lane + 64 * j];
            const f32x4 sh = ((const f32x4*)(MOD + b * 6144 + 3072))[lane + 64 * j];
            const f32x4 sc = ((const f32x4*)(MOD + b * 6144 + 4096))[lane + 64 * j];
            const f32x4 h = (xv[j] * r2) * g * (sc + 1.0f) + sh;
            u32x2 w; w.x = pkh(h.x, h.y); w.y = pkh(h.z, h.w); o8[64 * j] = w;
        }
    }
}
__device__ __forceinline__ void p10_rows(const Ctx& C) {
    const int tid = threadIdx.x, lane = tid & 63, wave = tid >> 6;
    const int gw = C.vcu * 8 + wave, NGW = C.G * 8;
    const float* MOD = (const float*)(C.ws + WS_MOD);
    const float* Y = (const float*)(C.ws + WS_Y2);
    for (int m = gw; m < M; m += NGW) {
        const int b = m / SEQ;
        const f32x4* yr = (const f32x4*)(Y + (size_t)m * DM) + lane;
        f32x4* orow = (f32x4*)(C.out + (size_t)m * DM) + lane;
        f32x4 y[4], xv[4]; float s = 0.f;
#pragma unroll
        for (int j = 0; j < 4; ++j) { y[j] = yr[64 * j]; xv[j] = orow[64 * j]; s += (y[j].x * y[j].x + y[j].y * y[j].y) + (y[j].z * y[j].z + y[j].w * y[j].w); }
        const float r = 1.0f / sqrtf(wave_sum(s) * (1.f / DM) + EPS);
#pragma unroll
        for (int j = 0; j < 4; ++j) {
            const f32x4 g = ((const f32x4*)C.g_post_ffn)[lane + 64 * j];
            const f32x4 ga = ((const f32x4*)(MOD + b * 6144 + 5120))[lane + 64 * j];
            orow[64 * j] = xv[j] + ga * ((y[j] * r) * g);
        }
    }
}

constexpr int RL_SK = 0, RL_QI = 32768, RL_QA = 33792, RL_HIST = 34816, RL_SEL = 35840, RL_LG = 36864, RL_WC = 45056, RL_MISC = 45184, RL_W = 45248;
__device__ __forceinline__ void row_unit(const Ctx& C, LAS unsigned char* lds, int b, int t, f16* OAdst, const unsigned* bmrow) {
    const int tid = threadIdx.x, lane = tid & 63, wid = tid >> 6;
    LAS unsigned* SK = (LAS unsigned*)(lds + RL_SK);
    LAS u32x4* QI4 = (LAS u32x4*)(lds + RL_QI);
    LAS u32x4* QA4 = (LAS u32x4*)(lds + RL_QA);
    LAS unsigned* HIST = (LAS unsigned*)(lds + RL_HIST);
    LAS int* SEL = (LAS int*)(lds + RL_SEL);
    LAS float* LG = (LAS float*)(lds + RL_LG);
    LAS unsigned* WC = (LAS unsigned*)(lds + RL_WC);
    LAS unsigned* MISC = (LAS unsigned*)(lds + RL_MISC);
    LAS float* WL = (LAS float*)(lds + RL_W);
    const f16* QI = (const f16*)(C.ws + WS_QI); const f16* KI = (const f16*)(C.ws + WS_KI); const float* WI = (const float*)(C.ws + WS_WI);
    f16* QA = (f16*)(C.ws + WS_QA); const f16* KA = (const f16*)(C.ws + WS_KA); const f16* VA = (const f16*)(C.ws + WS_VA);
    const size_t row = (size_t)b * SEQ + t, brow = (size_t)b * SEQ;
    if (tid < 64) QI4[tid] = ((const u32x4*)(QI + row * 512))[tid];
    else if (tid < 128) QA4[tid - 64] = ((const u32x4*)(QA + row * 512))[tid - 64];
    else if (tid < 136) WL[tid - 128] = WI[row * 8 + (tid - 128)];
    __syncthreads();
    const int n = t + 1;
    int n_sel;
    if (bmrow != nullptr) {
        int run_sel = 0;
        for (int c0 = 0; c0 < n; c0 += NTHREADS) {
            const int s = c0 + tid; const bool sel = (s < n) && ((bmrow[s >> 5] >> (s & 31)) & 1u);
            const unsigned long long bs = __ballot(sel);
            if (lane == 0) WC[8 + wid] = (unsigned)__popcll(bs);
            __syncthreads();
            int ps = run_sel, tot_s = 0;
#pragma unroll
            for (int w = 0; w < 8; ++w) { const int c = (int)WC[8 + w]; if (w < wid) ps += c; tot_s += c; }
            ps += __popcll(bs & ((1ull << lane) - 1ull));
            if (sel && ps < TOPK) SEL[ps] = s;
            run_sel += tot_s;
            __syncthreads();
        }
        n_sel = run_sel < TOPK ? run_sel : TOPK;
    } else if (n > TOPK) {
        float w[8];
#pragma unroll
        for (int h = 0; h < 8; ++h) w[h] = WL[h];
        for (int s = tid; s < n; s += NTHREADS) {
            const u32x4* kp = (const u32x4*)(KI + (brow + s) * 64);
            u32x4 k[8];
#pragma unroll
            for (int i = 0; i < 8; ++i) k[i] = kp[i];
            float sc = 0.f;
#pragma unroll
            for (int h = 0; h < 8; ++h) { float d = 0.f;
#pragma unroll
                for (int i = 0; i < 8; ++i) d = dot2x4(QI4[h * 8 + i], k[i], d);
                sc += w[h] * fmaxf(d, 0.f); }
            SK[s] = fkey(sc);
        }
        unsigned prefix = 0; int need = TOPK;
#pragma unroll 1
        for (int pass = 0; pass < 4; ++pass) {
            const int shift = 24 - 8 * pass;
            if (tid < 256) HIST[tid] = 0;
            __syncthreads();
            for (int s = tid; s < n; s += NTHREADS) { const unsigned key = SK[s];
                const bool match = (pass == 0) ? true : ((key >> (shift + 8)) == prefix);
                if (match) atomicAdd((unsigned*)&HIST[(key >> shift) & 255u], 1u); }
            __syncthreads();
            if (wid == 0) {
                const int c0 = (int)HIST[4 * lane], c1 = (int)HIST[4 * lane + 1], c2 = (int)HIST[4 * lane + 2], c3 = (int)HIST[4 * lane + 3];
                const int tot = c0 + c1 + c2 + c3;
                int S = tot;
#pragma unroll
                for (int o = 1; o < 64; o <<= 1) { const int u = __shfl_down(S, o); if (lane + o < 64) S += u; }
                const int above = S - tot;
                if (above < need && need <= S) {
                    int a = above, d, cnt;
                    if (a + c3 >= need) { d = 3; cnt = c3; }
                    else { a += c3; if (a + c2 >= need) { d = 2; cnt = c2; }
                    else { a += c2; if (a + c1 >= need) { d = 1; cnt = c1; }
                    else { a += c1; d = 0; cnt = c0; } } }
                    MISC[0] = (unsigned)(4 * lane + d); MISC[1] = (unsigned)(need - a); MISC[2] = (unsigned)cnt;
                }
            }
            __syncthreads();
            prefix = (prefix << 8) | MISC[0]; need = (int)MISC[1];
        }
        const unsigned T = prefix; const int need_eq = need;
        int run_eq = 0, run_sel = 0;
        for (int c0 = 0; c0 < n; c0 += NTHREADS) {
            const int s = c0 + tid; const bool act = s < n; const unsigned k = act ? SK[s] : 0u;
            const bool gt = act && k > T, eq = act && k == T;
            const unsigned long long beq = __ballot(eq);
            if (lane == 0) WC[wid] = (unsigned)__popcll(beq);
            __syncthreads();
            int pe = run_eq, tot_e = 0;
#pragma unroll
            for (int w = 0; w < 8; ++w) { const int c = (int)WC[w]; if (w < wid) pe += c; tot_e += c; }
            pe += __popcll(beq & ((1ull << lane) - 1ull));
            const bool sel = gt || (eq && pe < need_eq);
            run_eq += tot_e;
            const unsigned long long bs = __ballot(sel);
            if (lane == 0) WC[8 + wid] = (unsigned)__popcll(bs);
            __syncthreads();
            int ps = run_sel, tot_s = 0;
#pragma unroll
            for (int w = 0; w < 8; ++w) { const int c = (int)WC[8 + w]; if (w < wid) ps += c; tot_s += c; }
            ps += __popcll(bs & ((1ull << lane) - 1ull));
            if (sel && ps < TOPK) SEL[ps] = s;
            run_sel += tot_s;
        }
        n_sel = run_sel < TOPK ? run_sel : TOPK;
    } else {
        if (tid < n) SEL[tid] = tid;
        n_sel = n;
    }
    __syncthreads();
    {
        const int k = tid & 255, hg = tid >> 8;
        if (k < n_sel) {
            const u32x4* kp = (const u32x4*)(KA + (brow + SEL[k]) * 512 + hg * 256);
#pragma unroll
            for (int hh = 0; hh < 4; ++hh) { float d = 0.f;
#pragma unroll
                for (int i = 0; i < 8; ++i) d = dot2x4(QA4[(hg * 4 + hh) * 8 + i], kp[hh * 8 + i], d);
                LG[(hg * 4 + hh) * 256 + k] = d; }
        }
    }
    __syncthreads();
    {
        float v[4]; float mx = -INFINITY;
#pragma unroll
        for (int j = 0; j < 4; ++j) { const int k = lane + 64 * j; v[j] = (k < n_sel) ? LG[wid * 256 + k] : -INFINITY; mx = fmaxf(mx, v[j]); }
        mx = wave_max(mx);
        float sum = 0.f;
#pragma unroll
        for (int j = 0; j < 4; ++j) { const int k = lane + 64 * j; v[j] = (k < n_sel) ? exp2f(v[j] - mx) : 0.f; sum += v[j]; }
        sum = wave_sum(sum);
        const float inv = 1.f / sum;
#pragma unroll
        for (int j = 0; j < 4; ++j) LG[wid * 256 + lane + 64 * j] = v[j] * inv;
    }
    __syncthreads();
    {
        float o = 0.f; const f16* vp = VA + brow * 512 + wid * 64 + lane;
#pragma unroll 8
        for (int k = 0; k < n_sel; ++k) o += LG[wid * 256 + k] * (float)vp[(size_t)SEL[k] * 512];
        OAdst[wid * 64 + lane] = (f16)o;
    }
    __syncthreads();
}

__device__ __forceinline__ void row_select_slow(const Ctx& C, LAS unsigned char* lds, int b, int t, unsigned* dst, int nwords) {
    const int tid = threadIdx.x, lane = tid & 63, wid = tid >> 6;
    LAS unsigned* SK = (LAS unsigned*)(lds + RL_SK);
    LAS u32x4* QI4 = (LAS u32x4*)(lds + RL_QI);
    LAS unsigned* HIST = (LAS unsigned*)(lds + RL_HIST);
    LAS unsigned* WC = (LAS unsigned*)(lds + RL_WC);
    LAS unsigned* MISC = (LAS unsigned*)(lds + RL_MISC);
    LAS float* WL = (LAS float*)(lds + RL_W);
    const f16* QI = (const f16*)(C.ws + WS_QI); const f16* KI = (const f16*)(C.ws + WS_KI); const float* WI = (const float*)(C.ws + WS_WI);
    const size_t row = (size_t)b * SEQ + t, brow = (size_t)b * SEQ;
    __syncthreads();
    if (tid < 64) QI4[tid] = ((const u32x4*)(QI + row * 512))[tid];
    else if (tid >= 128 && tid < 136) WL[tid - 128] = WI[row * 8 + (tid - 128)];
    __syncthreads();
    const int n = t + 1;
    unsigned T = 0u; int need_eq = 0x7fffffff;
    {
        float w[8];
#pragma unroll
        for (int h = 0; h < 8; ++h) w[h] = WL[h];
        for (int s = tid; s < n; s += NTHREADS) {
            const u32x4* kp = (const u32x4*)(KI + (brow + s) * 64);
            u32x4 k[8];
#pragma unroll
            for (int i = 0; i < 8; ++i) k[i] = kp[i];
            float sc = 0.f;
#pragma unroll
            for (int h = 0; h < 8; ++h) { float d = 0.f;
#pragma unroll
                for (int i = 0; i < 8; ++i) d = dot2x4(QI4[h * 8 + i], k[i], d);
                sc = fmaf(w[h], fmaxf(d, 0.f), sc); }
            SK[s] = fkey(sc);
        }
    }
    if (n > TOPK) {
        unsigned prefix = 0; int need = TOPK;
#pragma unroll 1
        for (int pass = 0; pass < 4; ++pass) {
            const int shift = 24 - 8 * pass;
            if (tid < 256) HIST[tid] = 0;
            __syncthreads();
            for (int s = tid; s < n; s += NTHREADS) { const unsigned key = SK[s];
                const bool match = (pass == 0) ? true : ((key >> (shift + 8)) == prefix);
                if (match) atomicAdd((unsigned*)&HIST[(key >> shift) & 255u], 1u); }
            __syncthreads();
            if (wid == 0) {
                const int c0 = (int)HIST[4 * lane], c1 = (int)HIST[4 * lane + 1], c2 = (int)HIST[4 * lane + 2], c3 = (int)HIST[4 * lane + 3];
                const int tot = c0 + c1 + c2 + c3;
                int S = tot;
#pragma unroll
                for (int o = 1; o < 64; o <<= 1) { const int u = __shfl_down(S, o); if (lane + o < 64) S += u; }
                const int above = S - tot;
                if (above < need && need <= S) {
                    int a = above, d;
                    if (a + c3 >= need) { d = 3; }
                    else { a += c3; if (a + c2 >= need) { d = 2; }
                    else { a += c2; if (a + c1 >= need) { d = 1; }
                    else { a += c1; d = 0; } } }
                    MISC[0] = (unsigned)(4 * lane + d); MISC[1] = (unsigned)(need - a);
                }
            }
            __syncthreads();
            prefix = (prefix << 8) | MISC[0]; need = (int)MISC[1];
        }
        T = prefix; need_eq = need;
    }
    __syncthreads();
    int run_eq = 0;
    for (int c0 = 0; c0 < nwords * 32; c0 += NTHREADS) {
        const int s = c0 + tid; const bool act = s < n; const unsigned k = act ? SK[s] : 0u;
        const bool gt = act && k > T, eq = act && k == T;
        const unsigned long long beq = __ballot(eq);
        if (lane == 0) WC[wid] = (unsigned)__popcll(beq);
        __syncthreads();
        int pe = run_eq, tot_e = 0;
#pragma unroll
        for (int w = 0; w < 8; ++w) { const int c = (int)WC[w]; if (w < wid) pe += c; tot_e += c; }
        pe += __popcll(beq & ((1ull << lane) - 1ull));
        const bool sel = gt || (eq && pe < need_eq);
        run_eq += tot_e;
        const unsigned long long bs = __ballot(sel);
        const int w0 = (c0 >> 5) + 2 * wid;
        if (lane == 0) { if (w0 < nwords) dst[w0] = (unsigned)bs; if (w0 + 1 < nwords) dst[w0 + 1] = (unsigned)(bs >> 32); }
        __syncthreads();
    }
}

typedef float f32x16 __attribute__((ext_vector_type(16)));
#ifndef IX_CAP
#define IX_CAP 512
#endif
constexpr int IXL_HIST = 0, IXL_KT = 131072, IXL_CNT = 147456, IXL_B1 = 147456 + 128, IXL_NEED = 147456 + 256, IXL_FLAG = 147456 + 384;
struct IxWave { f16x8 a[4]; float wA[8], wB[8]; };
__device__ __forceinline__ void ix_scores(const IxWave& W, const LAS unsigned char* kt, int sub, int lane, float& sA, float& sB) {
    const int c = lane & 31, hk = lane >> 5, key = 32 * sub + c;
    f32x16 acc = {0.f, 0.f, 0.f, 0.f, 0.f, 0.f, 0.f, 0.f, 0.f, 0.f, 0.f, 0.f, 0.f, 0.f, 0.f, 0.f};
#pragma unroll
    for (int ks = 0; ks < 4; ++ks) { const int chunk = 2 * ks + hk;
        const f16x8 bfr = *(const LAS f16x8*)(kt + key * 128 + ((chunk ^ (key & 7)) << 4));
        acc = __builtin_amdgcn_mfma_f32_32x32x16_f16(W.a[ks], bfr, acc, 0, 0, 0); }
    float s0 = 0.f, s1 = 0.f;
#pragma unroll
    for (int h = 0; h < 8; ++h) { s0 = fmaf(W.wA[h], fmaxf(acc[h], 0.f), s0); s1 = fmaf(W.wB[h], fmaxf(acc[8 + h], 0.f), s1); }
    sA = s0; sB = s1;
}
__device__ __forceinline__ void ix_stage_load(const f16* KI, size_t brow, int tile, int tid, u32x4& v) { v = *(const u32x4*)(KI + (brow + (size_t)tile * 64 + (tid >> 3)) * 64 + (tid & 7) * 8); }
__device__ __forceinline__ void ix_stage_write(LAS unsigned char* lds, int buf, int tid, const u32x4& v) { const int key = tid >> 3, chunk = tid & 7; *(LAS u32x4*)(lds + IXL_KT + buf * 8192 + key * 128 + ((chunk ^ (key & 7)) << 4)) = v; }

__device__ __forceinline__ void ix_unit(const Ctx& C, LAS unsigned char* lds, int b, int t0) {
    const int tid = threadIdx.x, lane = tid & 63, wave = __builtin_amdgcn_readfirstlane(tid >> 6), hi = lane >> 5, c = lane & 31;
    const f16* QI = (const f16*)(C.ws + WS_QI); const f16* KI = (const f16*)(C.ws + WS_KI); const float* WI = (const float*)(C.ws + WS_WI);
    unsigned* BM = (unsigned*)(C.ws + WS_BM);
    const size_t brow = (size_t)b * SEQ;
    LAS unsigned* HIST = (LAS unsigned*)(lds + IXL_HIST);
    LAS u32x2* LIST = (LAS u32x2*)(lds + IXL_HIST);
    LAS unsigned* CNT = (LAS unsigned*)(lds + IXL_CNT);
    LAS int* B1 = (LAS int*)(lds + IXL_B1);
    LAS int* NEED = (LAS int*)(lds + IXL_NEED);
    LAS unsigned* FLAG = (LAS unsigned*)(lds + IXL_FLAG);
    const int ntile = (t0 + 32 + 63) >> 6;
    const int tA = t0 + 4 * wave + 2 * hi, rA = 4 * wave + 2 * hi;
    IxWave W;
    {
        const int a_ = c >> 3, b_ = (c >> 2) & 1, c_ = c & 3, tok = 2 * b_ + (a_ >> 1), head = 4 * (a_ & 1) + c_;
        const f16* qp = QI + (brow + t0 + 4 * wave + tok) * 512 + head * 64 + 8 * hi;
#pragma unroll
        for (int ks = 0; ks < 4; ++ks) W.a[ks] = *(const f16x8*)(qp + 16 * ks);
        const float* wp = WI + (brow + tA) * 8;
        const f32x4 w0 = *(const f32x4*)(wp), w1 = *(const f32x4*)(wp + 4), w2 = *(const f32x4*)(wp + 8), w3 = *(const f32x4*)(wp + 12);
#pragma unroll
        for (int i = 0; i < 4; ++i) { W.wA[i] = w0[i]; W.wA[4 + i] = w1[i]; W.wB[i] = w2[i]; W.wB[4 + i] = w3[i]; }
    }
    __syncthreads();
    for (int i = tid; i < 8192; i += NTHREADS) ((LAS u32x4*)HIST)[i] = (u32x4){0u, 0u, 0u, 0u};
    if (tid < 32) CNT[tid] = 0u;
    if (tid == 32) FLAG[0] = 0u;
    { u32x4 v; ix_stage_load(KI, brow, 0, tid, v); ix_stage_write(lds, 0, tid, v); }
    __syncthreads();
    for (int tile = 0; tile < ntile; ++tile) {
        u32x4 nx = {0u, 0u, 0u, 0u}; const bool more = tile + 1 < ntile;
        if (more) ix_stage_load(KI, brow, tile + 1, tid, nx);
        const LAS unsigned char* kt = lds + IXL_KT + (tile & 1) * 8192;
#pragma unroll
        for (int sub = 0; sub < 2; ++sub) {
            float sA, sB; ix_scores(W, kt, sub, lane, sA, sB);
            const int s = tile * 64 + sub * 32 + c;
            if (s <= tA) { const unsigned bin = fkey(sA) >> 21; atomicAdd((unsigned*)&HIST[rA * 1024 + (bin >> 1)], 1u << ((bin & 1u) * 16u)); }
            if (s <= tA + 1) { const unsigned bin = fkey(sB) >> 21; atomicAdd((unsigned*)&HIST[(rA + 1) * 1024 + (bin >> 1)], 1u << ((bin & 1u) * 16u)); }
        }
        if (more) ix_stage_write(lds, (tile + 1) & 1, tid, nx);
        __syncthreads();
    }
#pragma unroll 1
    for (int rr = 0; rr < 4; ++rr) {
        const int row = 4 * wave + rr, n = t0 + row + 1;
        int b1 = -1, need1 = 0;
        if (n > TOPK) {
            const LAS u32x4* hp = (const LAS u32x4*)(HIST + row * 1024 + 16 * lane);
            const u32x4 q0 = hp[0], q1 = hp[1], q2 = hp[2], q3 = hp[3];
            const unsigned wv[16] = {q0.x, q0.y, q0.z, q0.w, q1.x, q1.y, q1.z, q1.w, q2.x, q2.y, q2.z, q2.w, q3.x, q3.y, q3.z, q3.w};
            int tot = 0;
#pragma unroll
            for (int i = 0; i < 16; ++i) tot += (int)(wv[i] & 0xffffu) + (int)(wv[i] >> 16);
            int S = tot;
#pragma unroll
            for (int o = 1; o < 64; o <<= 1) { const int u = __shfl_down(S, o); if (lane + o < 64) S += u; }
            const int above = S - tot; const bool hit = above < TOPK && TOPK <= S;
            int a = above, d = 0, na = 0; bool found = false;
#pragma unroll
            for (int i = 31; i >= 0; --i) { const int cnt = (i & 1) ? (int)(wv[i >> 1] >> 16) : (int)(wv[i >> 1] & 0xffffu);
                if (!found && a + cnt >= TOPK) { found = true; d = i; na = a; } a += cnt; }
            const unsigned long long bm = __ballot(hit); const int src = __ffsll((long long)bm) - 1;
            b1 = __shfl(32 * lane + d, src); need1 = TOPK - __shfl(na, src);
        }
        if (lane == 0) { B1[row] = b1; NEED[row] = need1; }
    }
    __syncthreads();
    const int b1A = B1[rA], b1B = B1[rA + 1];
    unsigned* bmA = BM + (brow + tA) * 256; unsigned* bmB = bmA + 256;
    { u32x4 v; ix_stage_load(KI, brow, 0, tid, v); ix_stage_write(lds, 0, tid, v); }
    __syncthreads();
    for (int tile = 0; tile < ntile; ++tile) {
        u32x4 nx = {0u, 0u, 0u, 0u}; const bool more = tile + 1 < ntile;
        if (more) ix_stage_load(KI, brow, tile + 1, tid, nx);
        const LAS unsigned char* kt = lds + IXL_KT + (tile & 1) * 8192;
#pragma unroll
        for (int sub = 0; sub < 2; ++sub) {
            float sA, sB; ix_scores(W, kt, sub, lane, sA, sB);
            const int s = tile * 64 + sub * 32 + c;
            const unsigned kA = fkey(sA), kB = fkey(sB); const int binA = (int)(kA >> 21), binB = (int)(kB >> 21);
            const bool vA = s <= tA, vB = s <= tA + 1;
            const bool gA = vA && binA > b1A, gB = vB && binB > b1B, eA = vA && binA == b1A, eB = vB && binB == b1B;
            const unsigned long long bgA = __ballot(gA), bgB = __ballot(gB);
            if (c == 0) { bmA[tile * 2 + sub] = hi ? (unsigned)(bgA >> 32) : (unsigned)bgA; bmB[tile * 2 + sub] = hi ? (unsigned)(bgB >> 32) : (unsigned)bgB; }
            if (eA) { const unsigned idx = atomicAdd((unsigned*)&CNT[rA], 1u); if (idx < (unsigned)IX_CAP) LIST[rA * IX_CAP + idx] = (u32x2){kA, (unsigned)s}; }
            if (eB) { const unsigned idx = atomicAdd((unsigned*)&CNT[rA + 1], 1u); if (idx < (unsigned)IX_CAP) LIST[(rA + 1) * IX_CAP + idx] = (u32x2){kB, (unsigned)s}; }
        }
        if (more) ix_stage_write(lds, (tile + 1) & 1, tid, nx);
        __syncthreads();
    }
    { const int wend = ((t0 >> 8) + 1) * 8;
#pragma unroll 1
      for (int rr = 0; rr < 4; ++rr) { unsigned* bmr = BM + (brow + t0 + 4 * wave + rr) * 256;
          for (int w = 2 * ntile + lane; w < wend; w += 64) bmr[w] = 0u; } }
    asm volatile("s_waitcnt vmcnt(0)" ::: "memory");
#pragma unroll 1
    for (int rr = 0; rr < 4; ++rr) {
        const int row = 4 * wave + rr; const int cnt = (int)CNT[row], need = NEED[row];
        if (need == 0) continue;
        if (cnt > IX_CAP) { if (lane == 0) atomicOr((unsigned*)FLAG, 1u << row); continue; }
        const LAS u32x2* L = LIST + row * IX_CAP; unsigned* bmr = BM + (brow + t0 + row) * 256;
        if (need >= cnt) { for (int i = lane; i < cnt; i += 64) { const u32x2 e = L[i]; atomicOr(&bmr[e.y >> 5], 1u << (e.y & 31u)); } continue; }
        unsigned ck[8], cs[8]; int rank[8];
#pragma unroll
        for (int ch = 0; ch < 8; ++ch) { const int i = ch * 64 + lane; u32x2 e = {0u, 0xffffffffu}; if (i < cnt) e = L[i]; ck[ch] = e.x; cs[ch] = e.y; rank[ch] = 0; }
        const int nch = (cnt + 63) >> 6;
        for (int j = 0; j < cnt; ++j) { const u32x2 e = L[j];
#pragma unroll
            for (int ch = 0; ch < 8; ++ch) if (ch < nch) rank[ch] += (e.x > ck[ch] || (e.x == ck[ch] && e.y < cs[ch])) ? 1 : 0; }
#pragma unroll
        for (int ch = 0; ch < 8; ++ch) { const int i = ch * 64 + lane; if (i < cnt && rank[ch] < need) atomicOr(&bmr[cs[ch] >> 5], 1u << (cs[ch] & 31u)); }
    }
    __syncthreads();
    const unsigned flags = FLAG[0];
    if (flags) {
#pragma unroll 1
        for (int row = 0; row < 32; ++row) if ((flags >> row) & 1u) row_select_slow(C, lds, b, t0 + row, BM + (brow + t0 + row) * 256, ((t0 >> 8) + 1) * 8);
    }
}

namespace attn_body {
typedef _Float16 bf16;
using bf16x8=__attribute__((ext_vector_type(8)))short;
using s16x4=__attribute__((ext_vector_type(4)))short;
using f32x16=__attribute__((ext_vector_type(16)))float;
using u32x4=__attribute__((ext_vector_type(4)))unsigned;
constexpr int BATCH=4,NHEAD=8,SEQ=8192,D=64,DM=NHEAD*D;
constexpr int NW=8,QBLK=32,QB=QBLK*NW,KVBLK=64,NQB=SEQ/QB;
constexpr int ATTN_PITCH=DM, ATTN_UNIT_ROWS=QB;
__device__ __forceinline__ int crow(int r,int hi){return (r&3)+8*(r>>2)+4*hi;}
#define SBAR() __builtin_amdgcn_sched_barrier(0)
#define MFMA16(a,b,c,z0,z1,z2) __builtin_amdgcn_mfma_f32_32x32x16_f16(__builtin_bit_cast(f16x8,(a)),__builtin_bit_cast(f16x8,(b)),(c),0,0,0)
__device__ __forceinline__ void cmask(f32x16&p0,f32x16&p1,int jb,int qrel,int hi){
  const float NEG=-INFINITY; int kb=64*jb+4*hi;
  #pragma unroll
  for(int r=0;r<16;++r){int kv=kb+(r&3)+8*(r>>2); if(kv>qrel)p0[r]=NEG; if(kv+32>qrel)p1[r]=NEG;}
}

constexpr int NSLOT=3, SLOTB=8192;
constexpr int LDS_K=0, LDS_V=NSLOT*SLOTB, LDS_WS=2*NSLOT*SLOTB, LDS_OST=LDS_WS+NW*64*4, LDS_BYTES=LDS_OST+NW*4096;
constexpr float C2=0.125f*1.4426950408889634f;
__device__ __forceinline__ void glds16(const void*gsrc,unsigned lds_dst){unsigned keep;
  asm volatile("s_mov_b32 %0, m0\n\ts_mov_b32 m0, %2\n\ts_nop 0\n\tglobal_load_lds_dwordx4 %1, off\n\ts_mov_b32 m0, %0":"=&s"(keep):"v"(gsrc),"s"(lds_dst):"memory");}
__device__ __forceinline__ float max3f(float a,float b,float c){float r;asm("v_max3_f32 %0, %1, %2, %3":"=v"(r):"v"(a),"v"(b),"v"(c));return r;}
__device__ __forceinline__ float max2f(float a,float b){float r;asm("v_max_f32_e32 %0, %1, %2":"=v"(r):"v"(a),"v"(b));return r;}
__device__ __forceinline__ float fadd_s(float a,float b){float r;asm("v_add_f32_e32 %0, %1, %2":"=v"(r):"v"(a),"v"(b));return r;}
__device__ __forceinline__ float fsub_s(float a,float b){float r;asm("v_sub_f32_e32 %0, %1, %2":"=v"(r):"v"(a),"v"(b));return r;}
typedef float f32x2_t __attribute__((ext_vector_type(2))); typedef _Float16 bf16x2_t __attribute__((ext_vector_type(2)));
__device__ __forceinline__ unsigned cvtpk_s(float lo,float hi){f32x2_t v={lo,hi};bf16x2_t b=__builtin_convertvector(v,bf16x2_t);return __builtin_bit_cast(unsigned,b);}
#define WAIT_BAR(N) asm volatile("s_waitcnt vmcnt(" #N ") lgkmcnt(0)\n\ts_barrier":::"memory")

__device__ __forceinline__ void qkt(f32x16&p0,f32x16&p1,const char*Kslot,const bf16x8*qr,const f32x16&negm,int r32,int hi){
  const char*kb=Kslot+hi*1024+r32*16;
  #pragma unroll
  for(int d0=0;d0<4;++d0){
    const bf16x8 b0=*reinterpret_cast<const bf16x8*>(kb+d0*2048);
    const bf16x8 b1=*reinterpret_cast<const bf16x8*>(kb+d0*2048+512);
    if(d0==0){p0=MFMA16(b0,qr[0],negm,0,0,0);p1=MFMA16(b1,qr[0],negm,0,0,0);}
    else{p0=MFMA16(b0,qr[d0],p0,0,0,0);p1=MFMA16(b1,qr[d0],p1,0,0,0);}}
}
typedef __attribute__((address_space(3))) const char* lds_cptr;
typedef short v4i16_t __attribute__((ext_vector_type(4)));
__device__ __forceinline__ void kload8(bf16x8*kf,lds_cptr kp){
  kf[0]=*(const __attribute__((address_space(3))) bf16x8*)(kp);      kf[1]=*(const __attribute__((address_space(3))) bf16x8*)(kp+512);
  kf[2]=*(const __attribute__((address_space(3))) bf16x8*)(kp+2048); kf[3]=*(const __attribute__((address_space(3))) bf16x8*)(kp+2560);
  kf[4]=*(const __attribute__((address_space(3))) bf16x8*)(kp+4096); kf[5]=*(const __attribute__((address_space(3))) bf16x8*)(kp+4608);
  kf[6]=*(const __attribute__((address_space(3))) bf16x8*)(kp+6144); kf[7]=*(const __attribute__((address_space(3))) bf16x8*)(kp+6656);
}
__device__ __forceinline__ void kload2(bf16x8*kf,lds_cptr kp,int j){ kf[2*j]=*(const __attribute__((address_space(3))) bf16x8*)(kp+j*2048); kf[2*j+1]=*(const __attribute__((address_space(3))) bf16x8*)(kp+j*2048+512); }
__device__ __forceinline__ s16x4 vtr(lds_cptr p){ return __builtin_bit_cast(s16x4,__builtin_amdgcn_ds_read_tr16_b64_v4i16((__attribute__((address_space(3))) v4i16_t*)p)); }
__device__ __forceinline__ float rowmax(const f32x16&p0,const f32x16&p1){
  float a=max3f(p0[0],p0[1],p1[0]),b=max3f(p0[2],p0[3],p1[1]);a=max3f(a,p1[2],p1[3]);
  #pragma unroll
  for(int r=4;r<16;r+=4){a=max3f(a,p0[r],p0[r+1]);b=max3f(b,p0[r+2],p0[r+3]);a=max3f(a,p1[r],p1[r+1]);b=max3f(b,p1[r+2],p1[r+3]);}
  const float m=max2f(a,b);
  auto rr=__builtin_amdgcn_permlane32_swap(__float_as_uint(m),__float_as_uint(m),false,false);
  return max2f(__uint_as_float(rr[0]),__uint_as_float(rr[1]));
}
__device__ __forceinline__ void pv(f32x16*o,int vb,bf16x8 pa0,bf16x8 pa1,bf16x8 pa2,bf16x8 pa3){
  #pragma unroll
  for(int d0=0;d0<2;++d0){s16x4 lo[4],hi[4];
    #pragma unroll
    for(int ks=0;ks<4;++ks){
      asm volatile("ds_read_b64_tr_b16 %0,%1 offset:%c2":"=&v"(lo[ks]):"v"(vb),"i"(d0*4096+ks*1024):"memory");
      asm volatile("ds_read_b64_tr_b16 %0,%1 offset:%c2":"=&v"(hi[ks]):"v"(vb),"i"(d0*4096+ks*1024+512):"memory");}
    asm volatile("s_waitcnt lgkmcnt(0)":::"memory");SBAR();
    #define PK(k) (bf16x8){lo[k][0],lo[k][1],lo[k][2],lo[k][3],hi[k][0],hi[k][1],hi[k][2],hi[k][3]}
    o[d0]=MFMA16(pa0,PK(0),o[d0],0,0,0);
    o[d0]=MFMA16(pa1,PK(1),o[d0],0,0,0);
    o[d0]=MFMA16(pa2,PK(2),o[d0],0,0,0);
    o[d0]=MFMA16(pa3,PK(3),o[d0],0,0,0);
    #undef PK
  }
}

#ifndef ATTN_STORE16
#define ATTN_STORE16(p,v) (*(u32x4*)(p)=(v))
#endif
template<int THRL> __device__ __forceinline__ void attn_unit(int b,int h,int qb,const bf16*Q,const bf16*__restrict__ K,const bf16*__restrict__ V,bf16*O,const unsigned*BM,char*shm){
  const int tid=threadIdx.x,lane=tid&63,r32=lane&31,hi=lane>>5; const int wid=__builtin_amdgcn_readfirstlane(tid>>6);
  const long rowbase=(long)b*SEQ; const int q0=qb*QB;
  const bf16*Qw=Q+(rowbase+q0+wid*QBLK)*DM+h*D;
  const bf16*Kh=K+rowbase*DM+h*D,*Vh=V+rowbase*DM+h*D;
  const unsigned lds0=(unsigned)(uintptr_t)shm;
  float*wsf=(float*)(shm+LDS_WS)+wid*64;
  const bf16*ksrc=Kh+(long)lane*DM+wid*8;
  const bf16*vsrc=Vh+(long)(16*(wid&3)+(lane>>2))*DM+(wid>>2)*32+(lane&3)*8;
  const unsigned kdst=lds0+LDS_K+wid*1024, vdst=lds0+LDS_V+wid*1024;
  #define DMA_K(t,slot) glds16(ksrc+(long)(t)*KVBLK*DM,(unsigned)__builtin_amdgcn_readfirstlane(kdst+(slot)))
  #define DMA_V(t,slot) glds16(vsrc+(long)(t)*KVBLK*DM,(unsigned)__builtin_amdgcn_readfirstlane(vdst+(slot)))
  const int vb0=(int)(lds0+LDS_V)+((lane>>4)&1)*32+(lane&3)*8+(4*hi+((lane&15)>>2))*64;
  const char*Kbase=shm+LDS_K; bf16x8 kf[8];
  const lds_cptr shm3=(lds_cptr)shm; const lds_cptr kp0=shm3+LDS_K+hi*1024+r32*16; const lds_cptr vp0=shm3+LDS_V+((lane>>4)&1)*32+(lane&3)*8+(4*hi+((lane&15)>>2))*64;
  const int NT=(q0+QB)/KVBLK;
  unsigned moff=(unsigned)(rowbase+q0+wid*QBLK+r32)*1024u;
  const int sh4=4*hi;
  u32x2 mkE,mkO;
  #define LDMASK(dst,t) do{ asm volatile("global_load_dwordx2 %0, %1, %2":"=v"(dst):"v"(moff),"s"(BM):"memory"); moff+=8u; }while(0)
  #define MKPIN(V_) do{ asm volatile("":"+v"(V_)); V_[0]>>=sh4; V_[1]>>=sh4; }while(0)
  #define MAND(X,r,mw) X[r]=__uint_as_float(__float_as_uint(X[r])&(unsigned)__builtin_amdgcn_sbfe((int)(mw),((r)&3)+8*((r)>>2),1))
  LDMASK(mkE,0);LDMASK(mkO,1);
  DMA_K(0,0);DMA_V(0,0);DMA_K(1,SLOTB);
  bf16x8 qr[4];
  #pragma unroll
  for(int d0=0;d0<4;++d0)qr[d0]=*reinterpret_cast<const bf16x8*>(&Qw[(long)r32*DM+d0*16+hi*8]);
  float mhat=0.f,l_reg=0.f;f32x16 o[2];o[0]=f32x16{};o[1]=f32x16{};f32x16 negm=f32x16{};asm volatile("":"+v"(negm));
  const int qrel=wid*QBLK+r32;
  #define CMASK(P0,P1,t) do{}while(0)
  bool resc=false;
  #define START(P0,P1) do{ const float rm=rowmax(P0,P1); resc=false; \
    { const float dl=rm; mhat=fadd_s(mhat,dl); \
      _Pragma("unroll") for(int r=0;r<16;++r){P0[r]=fsub_s(P0[r],dl);P1[r]=fsub_s(P1[r],dl);} \
      _Pragma("unroll") for(int r=0;r<16;++r)negm[r]=-mhat; asm volatile("":"+v"(negm)); } \
    _Pragma("unroll") for(int r=0;r<16;++r)P0[r]=__builtin_amdgcn_exp2f(P0[r]); }while(0)
  #define RESC() do{ if(resc){ asm volatile("s_waitcnt lgkmcnt(0)":::"memory"); \
      _Pragma("unroll") for(int d_=0;d_<2;++d_) _Pragma("unroll") for(int r=0;r<16;++r)o[d_][r]*=wsf[crow(r,hi)]; } }while(0)
  f32x16 pA0,pA1,pB0,pB1;
  int sl_prev=0,sl_cur=0,sl_next=SLOTB;
  #define ROT() do{sl_prev=sl_cur;sl_cur=sl_next;sl_next=(sl_next==(NSLOT-1)*SLOTB)?0:sl_next+SLOTB;}while(0)
  DMA_K(2,2*SLOTB);
  WAIT_BAR(3); MKPIN(mkE); MKPIN(mkO);
  qkt(pA0,pA1,Kbase,qr,negm,r32,hi);asm volatile("s_nop 15\n\ts_nop 7":"+v"(pA0),"+v"(pA1));CMASK(pA0,pA1,0);
  START(pA0,pA1);
  _Pragma("unroll") for(int r=0;r<16;++r)pA1[r]=__builtin_amdgcn_exp2f(pA1[r]);
  { _Pragma("unroll") for(int r=0;r<16;++r){MAND(pA0,r,mkE[0]);MAND(pA1,r,mkE[1]);} }
  WAIT_BAR(0);
  DMA_K(3,0);DMA_V(1,SLOTB);
  ROT();
  kload8(kf,kp0+sl_cur);
  WAIT_BAR(2);
  s16x4 vlo[8],vhi[8]; u32x4 pw0,pw1,pw2,pw3;
  #define PKW(P,B) cvtpk_s(P[B],P[B+1])
  #define PAF(k) __builtin_bit_cast(bf16x8,pw##k)
  #define VFR(i) (bf16x8){vlo[i][0],vlo[i][1],vlo[i][2],vlo[i][3],vhi[i][0],vhi[i][1],vhi[i][2],vhi[i][3]}
  #define PIN(x) asm volatile("":"+v"(x))
  #define MX3(a,b,c) __builtin_fmaxf(__builtin_fmaxf((a),(b)),(c))
  #define GAPA(MF,A0,A1,A2,A3,W0,W1,PW) do{ MF; sacc+=A0; sacc+=A1; sacc+=A2; sacc+=A3; PIN(sacc); W0; W1; PIN(PW); SBAR(); }while(0)
  #define EX(v) __builtin_amdgcn_exp2f(v)
  #define GAPB(MF,X,B,MW) do{ MF; X[B]=EX(X[B]); X[B+1]=EX(X[B+1]); X[B+2]=EX(X[B+2]); X[B+3]=EX(X[B+3]); MAND(X,B,MW); MAND(X,B+1,MW); MAND(X,B+2,MW); MAND(X,B+3,MW); PIN(X); SBAR(); }while(0)
  #define VRD(i) do{ vlo[i]=vtr(vp_+(((i)>>2)*4096+((i)&3)*1024)); vhi[i]=vtr(vp_+(((i)>>2)*4096+((i)&3)*1024+512)); }while(0)
  #define KRD(G,j) do{ if(G){ kload2(kf,kp0+sl_next,j); SBAR(); } }while(0)
  #define STEP(C0,C1,P0,P1,t,GK,GV,GL,GM,MK,MKN) do{ SBAR(); \
    if(GM){LDMASK(MKN,(t)+1);} \
    const lds_cptr vp_=vp0+sl_prev; \
    VRD(0); SBAR(); float sacc=(P0[0]+P0[1]); \
    GAPA(C0=MFMA16(kf[0],qr[0],negm,0,0,0), P0[2],P0[3],P0[4],P0[5],     pw0[0]=PKW(P0,0), pw0[1]=PKW(P0,2), pw0); \
    VRD(4); SBAR(); GAPA(C1=MFMA16(kf[1],qr[0],negm,0,0,0), P0[6],P0[7],P0[8],P0[9],     pw0[2]=PKW(P0,4), pw0[3]=PKW(P0,6), pw0); \
    VRD(1); SBAR(); GAPA(C0=MFMA16(kf[2],qr[1],C0,0,0,0),   P0[10],P0[11],P0[12],P0[13], pw1[0]=PKW(P0,8), pw1[1]=PKW(P0,10), pw1); \
    VRD(5); SBAR(); GAPA(C1=MFMA16(kf[3],qr[1],C1,0,0,0),   P0[14],P0[15],P1[0],P1[1],   pw1[2]=PKW(P0,12),pw1[3]=PKW(P0,14), pw1); \
    VRD(2); SBAR(); GAPA(C0=MFMA16(kf[4],qr[2],C0,0,0,0),   P1[2],P1[3],P1[4],P1[5],     pw2[0]=PKW(P1,0), pw2[1]=PKW(P1,2), pw2); \
    VRD(6); SBAR(); GAPA(C1=MFMA16(kf[5],qr[2],C1,0,0,0),   P1[6],P1[7],P1[8],P1[9],     pw2[2]=PKW(P1,4), pw2[3]=PKW(P1,6), pw2); \
    VRD(3); SBAR(); GAPA(C0=MFMA16(kf[6],qr[3],C0,0,0,0),   P1[10],P1[11],P1[12],P1[13], pw3[0]=PKW(P1,8), pw3[1]=PKW(P1,10), pw3); \
    VRD(7); SBAR(); GAPA(C1=MFMA16(kf[7],qr[3],C1,0,0,0),   P1[14],P1[15],0.f,0.f,       pw3[2]=PKW(P1,12),pw3[3]=PKW(P1,14), pw3); \
    l_reg+=sacc; \
    if(GK){DMA_K((t)+3,sl_cur);} if(GV){DMA_V((t)+1,sl_next);} \
    CMASK(C0,C1,t); \
    { float a=MX3(C0[0],C0[1],C1[0]),b=MX3(C0[2],C0[3],C1[1]); a=MX3(a,C1[2],C1[3]); \
      _Pragma("unroll") for(int r=4;r<16;r+=4){a=MX3(a,C0[r],C0[r+1]);b=MX3(b,C0[r+2],C0[r+3]);a=MX3(a,C1[r],C1[r+1]);b=MX3(b,C1[r+2],C1[r+3]);} \
      float rm=__builtin_fmaxf(a,b); { auto rr=__builtin_amdgcn_permlane32_swap(__float_as_uint(rm),__float_as_uint(rm),false,false); rm=__builtin_fmaxf(__uint_as_float(rr[0]),__uint_as_float(rr[1])); } \
      resc=false; \
      if(__builtin_expect(__any(rm>(float)THRL),0)){ const float dl=__builtin_fmaxf(rm,0.f); mhat+=dl; \
        _Pragma("unroll") for(int r=0;r<16;++r){C0[r]-=dl;C1[r]-=dl;} \
        _Pragma("unroll") for(int r=0;r<16;++r)negm[r]=-mhat; asm volatile("":"+v"(negm)); \
        const float f=__builtin_amdgcn_exp2f(-dl); l_reg*=f; if(hi==0)wsf[r32]=f; resc=true; } } \
    SBAR(); \
    GAPB(o[0]=MFMA16(PAF(0),VFR(0),o[0],0,0,0), C0,0,(MK)[0]); \
    GAPB(o[1]=MFMA16(PAF(0),VFR(4),o[1],0,0,0), C0,4,(MK)[0]); \
    KRD(GL,0); GAPB(o[0]=MFMA16(PAF(1),VFR(1),o[0],0,0,0), C0,8,(MK)[0]); \
    KRD(GL,1); GAPB(o[1]=MFMA16(PAF(1),VFR(5),o[1],0,0,0), C0,12,(MK)[0]); \
    KRD(GL,2); GAPB(o[0]=MFMA16(PAF(2),VFR(2),o[0],0,0,0), C1,0,(MK)[1]); \
    KRD(GL,3); GAPB(o[1]=MFMA16(PAF(2),VFR(6),o[1],0,0,0), C1,4,(MK)[1]); \
    GAPB(o[0]=MFMA16(PAF(3),VFR(3),o[0],0,0,0), C1,8,(MK)[1]); \
    GAPB(o[1]=MFMA16(PAF(3),VFR(7),o[1],0,0,0), C1,12,(MK)[1]); \
    }while(0)
  int t=1;
  #undef CMASK
  #define CMASK(P0,P1,t) do{}while(0)
  for(;t+5<NT;t+=2){
    STEP(pB0,pB1,pA0,pA1,t,true,true,true,true,mkO,mkE);     WAIT_BAR(2); MKPIN(mkE); RESC(); ROT();
    STEP(pA0,pA1,pB0,pB1,t+1,true,true,true,true,mkE,mkO);   WAIT_BAR(2); MKPIN(mkO); RESC(); ROT();
  }
  #define ENDW(tt) do{ if((tt)+3<NT){WAIT_BAR(2);} else if((tt)+2<NT){WAIT_BAR(1);} else {WAIT_BAR(0);} }while(0)
  for(;t+1<NT;t+=2){
    STEP(pB0,pB1,pA0,pA1,t,(t+3<NT),(t+1<NT),(t+1<NT),true,mkO,mkE);           ENDW(t);   MKPIN(mkE); RESC(); ROT();
    STEP(pA0,pA1,pB0,pB1,t+1,(t+4<NT),(t+2<NT),(t+2<NT),(t+2<NT),mkE,mkO);     ENDW(t+1); MKPIN(mkO); RESC(); ROT();
  }
  STEP(pB0,pB1,pA0,pA1,NT-1,false,false,false,false,mkO,mkE); RESC();
  { float sacc=pB0[0]+pB0[1]; _Pragma("unroll") for(int r=2;r<16;++r)sacc+=pB0[r]; _Pragma("unroll") for(int r=0;r<16;++r)sacc+=pB1[r]; l_reg+=sacc;
    pw0=(u32x4){PKW(pB0,0),PKW(pB0,2),PKW(pB0,4),PKW(pB0,6)};pw1=(u32x4){PKW(pB0,8),PKW(pB0,10),PKW(pB0,12),PKW(pB0,14)};pw2=(u32x4){PKW(pB1,0),PKW(pB1,2),PKW(pB1,4),PKW(pB1,6)};pw3=(u32x4){PKW(pB1,8),PKW(pB1,10),PKW(pB1,12),PKW(pB1,14)};
    SBAR(); pv(o,vb0+sl_cur,PAF(0),PAF(1),PAF(2),PAF(3)); }
  #undef PKW
  #undef PAF
  #undef VFR
  #undef PIN
  #undef MX3
  #undef GAPA
  #undef GAPB
  #undef EX
  #undef VRD
  #undef KRD
  #undef STEP
  #undef ENDW
  {auto rr=__builtin_amdgcn_permlane32_swap(__float_as_uint(l_reg),__float_as_uint(l_reg),false,false);l_reg=__uint_as_float(rr[0])+__uint_as_float(rr[1]);}
  if(hi==0)wsf[32+r32]=l_reg;asm volatile("s_waitcnt lgkmcnt(0)":::"memory");
  float rli[16];
  #pragma unroll
  for(int r=0;r<16;++r)rli[r]=__builtin_amdgcn_rcpf(wsf[32+crow(r,hi)]);
  bf16*Ow=O+(rowbase+q0+wid*QBLK)*DM+h*D;
  { bf16*stg=(bf16*)(shm+LDS_OST)+wid*2048;
    #pragma unroll
    for(int r=0;r<16;++r){const int orow=crow(r,hi);
      #pragma unroll
      for(int d0=0;d0<2;++d0)stg[orow*64+d0*32+r32]=(bf16)(o[d0][r]*rli[r]);}
    asm volatile("s_waitcnt lgkmcnt(0)":::"memory");
    #pragma unroll
    for(int i=0;i<4;++i){const int row=i*8+(lane>>3),ch=lane&7; const u32x4 v=*(const u32x4*)(stg+row*64+ch*8); ATTN_STORE16(Ow+(long)row*DM+ch*8,v);} }
  asm volatile("s_waitcnt lgkmcnt(0)\n\ts_barrier":::"memory");
  #undef LDMASK
  #undef MKPIN
  #undef MAND
  #undef DMA_K
  #undef DMA_V
  #undef CMASK
  #undef START
  #undef RESC
  #undef ROT
}
constexpr int ATTN_LDS_BYTES=LDS_BYTES;
struct AttnTensors { const bf16* Q; const bf16* K; const bf16* V; bf16* O; const unsigned* BM; };
struct AttnUnit { int bh; int qb; };
struct StaticOrder {
  int vcu;
  __device__ __forceinline__ explicit StaticOrder(int grid,int block):vcu((block%8)*(grid/8)+block/8){}
  __device__ __forceinline__ bool next(int i,AttnUnit&u)const{ if(i>=4)return false; const int s=vcu&7; u.bh=vcu>>3; u.qb=(i==0)?s:(i==1)?15-s:(i==2)?16+s:31-s; return true; }
  __device__ __forceinline__ void a_ready(const AttnUnit&)const{}
  __device__ __forceinline__ void done(const AttnUnit&)const{}
};
template<class Sched,int THRL=8> __device__ __forceinline__ void attn_phase(char*lds,const AttnTensors&T,const Sched&S){
  AttnUnit u;
  for(int i=0;S.next(i,u);++i){ S.a_ready(u); attn_unit<THRL>(u.bh/NHEAD,u.bh%NHEAD,u.qb,T.Q,T.K,T.V,T.O,T.BM,lds); S.done(u); }
}

constexpr float STICK_STOP=-152.0f;
__device__ __forceinline__ void stick_unit(int b,int h,int qb,const bf16*Q,const bf16*__restrict__ K,const bf16*__restrict__ V,bf16*O,char*shm){
  const int tid=threadIdx.x,lane=tid&63,r32=lane&31,hi=lane>>5; const int wid=__builtin_amdgcn_readfirstlane(tid>>6);
  const long rowbase=(long)b*SEQ; const int q0=qb*QB,q0w=q0+wid*QBLK,trow=q0w+r32;
  const bf16*Qw=Q+(rowbase+q0w)*DM+h*D;
  const bf16*Kh=K+rowbase*DM+h*D,*Vh=V+rowbase*DM+h*D;
  const unsigned lds0=(unsigned)(uintptr_t)shm;
  const bf16*ksrc=Kh+(long)lane*DM+wid*8;
  const bf16*vsrc=Vh+(long)(16*(wid&3)+(lane>>2))*DM+(wid>>2)*32+(lane&3)*8;
  const unsigned kdst=lds0+LDS_K+wid*1024, vdst=lds0+LDS_V+wid*1024;
  #define DMA_K(t,slot) glds16(ksrc+(long)(t)*KVBLK*DM,(unsigned)__builtin_amdgcn_readfirstlane(kdst+(slot)))
  #define DMA_V(t,slot) glds16(vsrc+(long)(t)*KVBLK*DM,(unsigned)__builtin_amdgcn_readfirstlane(vdst+(slot)))
  const int vb0=(int)(lds0+LDS_V)+((lane>>4)&1)*32+(lane&3)*8+(4*hi+((lane&15)>>2))*64;
  volatile __attribute__((address_space(3))) unsigned*flags=(volatile __attribute__((address_space(3))) unsigned*)((__attribute__((address_space(3))) char*)shm+LDS_WS);
  const int Thi=4*qb+3,Tw0=(q0w+31)>>6;
  DMA_K(Thi,0);DMA_V(Thi,0);
  bf16x8 qr[4];
  #pragma unroll
  for(int d0=0;d0<4;++d0)qr[d0]=*reinterpret_cast<const bf16x8*>(&Qw[(long)r32*DM+d0*16+hi*8]);
  f32x16 o[2];o[0]=f32x16{};o[1]=f32x16{}; f32x16 zero16=f32x16{};
  float carry=0.f; bool done=false;
  WAIT_BAR(0);
  for(int T=Thi;;--T){
    const int par=(Thi-T)&1,slot=par*SLOTB;
    if(T>0){DMA_K(T-1,SLOTB-slot);DMA_V(T-1,SLOTB-slot);}
    if(T<=Tw0&&!done){
      f32x16 p0,p1; qkt(p0,p1,shm+LDS_K+slot,qr,zero16,r32,hi);
      const int kb=T*KVBLK+4*hi;
      f32x16 l0,l1;
      #pragma unroll
      for(int r=0;r<16;++r){ const int key=kb+(r&3)+8*(r>>2);
        { const float z=p0[r],sp=__builtin_fmaxf(z,0.f)+__builtin_amdgcn_logf(1.f+__builtin_amdgcn_exp2f(-__builtin_fabsf(z))); const bool v=key<trow; l0[r]=v?-sp:0.f; p0[r]=v?z-sp:-INFINITY; }
        { const float z=p1[r],sp=__builtin_fmaxf(z,0.f)+__builtin_amdgcn_logf(1.f+__builtin_amdgcn_exp2f(-__builtin_fabsf(z))); const bool v=key+32<trow; l1[r]=v?-sp:0.f; p1[r]=v?z-sp:-INFINITY; } }
      float GE[8],GO[8];
      #pragma unroll
      for(int j=0;j<8;++j){ const float g=(j<4)?((l0[4*j]+l0[4*j+1])+(l0[4*j+2]+l0[4*j+3])):((l1[4*(j-4)]+l1[4*(j-4)+1])+(l1[4*(j-4)+2]+l1[4*(j-4)+3]));
        auto rr=__builtin_amdgcn_permlane32_swap(__float_as_uint(g),__float_as_uint(g),false,false); GE[j]=__uint_as_float(rr[0]); GO[j]=__uint_as_float(rr[1]); }
      float run=0.f,base[8];
      #pragma unroll
      for(int j=7;j>=0;--j){ const float so=run; run+=GO[j]; const float se=run; run+=GE[j]; base[j]=carry+(hi?so:se); }
      #pragma unroll
      for(int j=0;j<4;++j){
        { const float a3=base[j],a2=a3+l0[4*j+3],a1=a2+l0[4*j+2],a0=a1+l0[4*j+1];
          p0[4*j+3]=__builtin_amdgcn_exp2f(p0[4*j+3]+a3); p0[4*j+2]=__builtin_amdgcn_exp2f(p0[4*j+2]+a2); p0[4*j+1]=__builtin_amdgcn_exp2f(p0[4*j+1]+a1); p0[4*j]=__builtin_amdgcn_exp2f(p0[4*j]+a0); }
        { const float a3=base[4+j],a2=a3+l1[4*j+3],a1=a2+l1[4*j+2],a0=a1+l1[4*j+1];
          p1[4*j+3]=__builtin_amdgcn_exp2f(p1[4*j+3]+a3); p1[4*j+2]=__builtin_amdgcn_exp2f(p1[4*j+2]+a2); p1[4*j+1]=__builtin_amdgcn_exp2f(p1[4*j+1]+a1); p1[4*j]=__builtin_amdgcn_exp2f(p1[4*j]+a0); } }
      carry+=run;
      u32x4 pw0,pw1,pw2,pw3;
      #define PKW(P,B) cvtpk_s(P[B],P[B+1])
      pw0=(u32x4){PKW(p0,0),PKW(p0,2),PKW(p0,4),PKW(p0,6)};pw1=(u32x4){PKW(p0,8),PKW(p0,10),PKW(p0,12),PKW(p0,14)};pw2=(u32x4){PKW(p1,0),PKW(p1,2),PKW(p1,4),PKW(p1,6)};pw3=(u32x4){PKW(p1,8),PKW(p1,10),PKW(p1,12),PKW(p1,14)};
      #undef PKW
      SBAR(); pv(o,vb0+slot,__builtin_bit_cast(bf16x8,pw0),__builtin_bit_cast(bf16x8,pw1),__builtin_bit_cast(bf16x8,pw2),__builtin_bit_cast(bf16x8,pw3));
      done=__all(carry<STICK_STOP);
    }
    if(T==0)done=true;
    if(lane==0)flags[par*8+wid]=done?1u:0u;
    WAIT_BAR(0);
    unsigned alld=1u;
    #pragma unroll
    for(int w=0;w<8;++w)alld&=flags[par*8+w];
    if(alld)break;
  }
  bf16*Ow=O+(rowbase+q0w)*DM+h*D;
  { bf16*stg=(bf16*)(shm+LDS_OST)+wid*2048;
    #pragma unroll
    for(int r=0;r<16;++r){const int orow=crow(r,hi);
      #pragma unroll
      for(int d0=0;d0<2;++d0)stg[orow*64+d0*32+r32]=(bf16)(o[d0][r]);}
    asm volatile("s_waitcnt lgkmcnt(0)":::"memory");
    #pragma unroll
    for(int i=0;i<4;++i){const int row=i*8+(lane>>3),ch=lane&7; const u32x4 v=*(const u32x4*)(stg+row*64+ch*8); ATTN_STORE16(Ow+(long)row*DM+ch*8,v);} }
  asm volatile("s_waitcnt lgkmcnt(0)\n\ts_barrier":::"memory");
  #undef DMA_K
  #undef DMA_V
}
#undef SBAR
#undef WAIT_BAR
#undef MFMA16
}

__device__ __forceinline__ void stick_item(const Ctx& C, LAS float* attw, int b, int t, int h, int lane) {
    f16* QB = (f16*)(C.ws + WS_QB); const f16* KB = (const f16*)(C.ws + WS_KB); const f16* VB = (const f16*)(C.ws + WS_VB);
    const size_t brow = (size_t)b * SEQ, row = brow + t;
    u32x4 q[8];
#pragma unroll
    for (int i = 0; i < 8; ++i) q[i] = ((const u32x4*)(QB + row * 512 + h * 64))[i];
    float o = 0.f, carry = 0.f;
    for (int base = 0; base < t; base += 64) {
        const int s = t - 1 - base - lane; const bool valid = s >= 0;
        float z = 0.f;
        if (valid) { const u32x4* kp = (const u32x4*)(KB + (brow + s) * 512 + h * 64);
#pragma unroll
            for (int i = 0; i < 8; ++i) z = dot2x4(q[i], kp[i], z); }
        z *= 0.6931471805599453f;
        const float L = log1pf(expf(-fabsf(z)));
        const float l1m = valid ? -(fmaxf(z, 0.f) + L) : 0.f;
        const float lsg = fminf(z, 0.f) - L;
        float incl = l1m;
#pragma unroll
        for (int ofs = 1; ofs < 64; ofs <<= 1) { const float u = __shfl_up(incl, ofs); if (lane >= ofs) incl += u; }
        const float after = carry + (incl - l1m);
        const float att = valid ? expf(lsg + after) : 0.f;
        carry += __shfl(incl, 63);
        attw[lane] = att;
        asm volatile("s_waitcnt lgkmcnt(0)" ::: "memory");
        const int cnt = (t - base) < 64 ? (t - base) : 64;
        const f16* vp = VB + (brow + (t - 1 - base)) * 512 + h * 64 + lane;
#pragma unroll 8
        for (int l = 0; l < cnt; ++l) o += attw[l] * (float)vp[-(ptrdiff_t)l * 512];
        asm volatile("s_waitcnt lgkmcnt(0)" ::: "memory");
        if (carry < -105.f) break;
    }
    ((f16*)(C.ws + WS_OB))[row * 512 + h * 64 + lane] = (f16)o;
}

#ifndef DIAG
#define DIAG 0
#endif
#if DIAG
constexpr size_t WS_DIAG = 500 * MiB;
__device__ __forceinline__ unsigned hash_u(unsigned x) { x ^= x >> 16; x *= 0x7feb352dU; x ^= x >> 15; x *= 0x846ca68bU; x ^= x >> 16; return x; }
__device__ __forceinline__ bool close_(float got, float ref) { return fabsf(got - ref) <= 0.02f * fabsf(ref) + 0.01f; }
#endif
struct Args { const float* in[14]; float* out; unsigned char* ws; int ph_lo, ph_hi; };
constexpr int NPHASES = 12;

__global__ void __launch_bounds__(NTHREADS, 2) hyb_fwd(Args args) {
    extern __shared__ __attribute__((aligned(16))) unsigned char lds_raw[];
    LAS unsigned char* lds = (LAS unsigned char*)lds_raw;
    cg::grid_group grid = cg::this_grid();
    Ctx C;
    C.x = args.in[0]; C.c = args.in[1]; C.w_ada = args.in[2]; C.b_ada = args.in[3]; C.g_pre_mix = args.in[4]; C.w_in = args.in[5]; C.w_up_a = args.in[6]; C.w_up_b = args.in[7];
    C.w_out = args.in[8]; C.g_post_mix = args.in[9]; C.g_pre_ffn = args.in[10]; C.w_ff1 = args.in[11]; C.w_ff2 = args.in[12]; C.g_post_ffn = args.in[13];
    C.out = args.out; C.ws = args.ws; C.G = gridDim.x;
    { const int bx = blockIdx.x; C.vcu = (C.G % 8 == 0) ? (bx % 8) * (C.G / 8) + bx / 8 : bx; }
    const int lo = args.ph_lo, hi = args.ph_hi;
    const int tid = threadIdx.x, lane = tid & 63, wave = tid >> 6;
#define IN(k) (lo <= (k) && (k) < hi)
#define SEAM(k) do { if (IN(k) && IN((k) + 1)) grid.sync(); } while (0)
    unsigned char* ws = C.ws;

    if (IN(0)) { p0_prologue(C, lds); } SEAM(0);
    if (IN(1)) { p1_norm_rows(C); } SEAM(1);
    if (IN(2)) {
        pg8::Gemm g{(const f16*)(ws + WS_H), (const f16*)(ws + WS_WIN), M, NPROJ, DM}; pg8::StaticOrder S; S.init(M, NPROJ, C.G, (int)blockIdx.x);
        EpiProj E{ws}; pg8::gemm_phase<EpiProj>(lds, g, S, E);
    } SEAM(2);
    if (IN(3)) {
        for (int i = C.vcu; i < 1024; i += C.G) { const int b = i >> 8, j = i & 255, blk = (b & 1) ? 255 - j : j; ix_unit(C, lds, b, 32 * blk); }
#if DIAG
        __syncthreads();
        for (int i = C.vcu; i < 256; i += C.G) { const int row = (int)(hash_u(i * 2654435761u + 17u) % (unsigned)M); row_select_slow(C, lds, row / SEQ, row % SEQ, (unsigned*)(ws + WS_DIAG + MiB) + i * 256, 256); }
#endif
    } SEAM(3);
    if (IN(4)) {
        __syncthreads();
        {
            const attn_body::AttnTensors AT{(const attn_body::bf16*)(ws + WS_QA), (const attn_body::bf16*)(ws + WS_KA), (const attn_body::bf16*)(ws + WS_VA), (attn_body::bf16*)(ws + WS_OA), (const unsigned*)(ws + WS_BM)};
            if (C.G == 256) { const attn_body::StaticOrder S((int)C.G, (int)blockIdx.x); attn_body::attn_phase<attn_body::StaticOrder>((char*)lds_raw, AT, S); }
            else { for (int i = C.vcu; i < 1024; i += C.G) attn_body::attn_unit<8>((i >> 5) / 8, (i >> 5) % 8, i & 31, AT.Q, AT.K, AT.V, AT.O, AT.BM, (char*)lds_raw); }
        }
        __syncthreads();
        for (int i = C.vcu; i < 1024; i += C.G) attn_body::stick_unit((i >> 5) / 8, (i >> 5) % 8, i & 31, (const attn_body::bf16*)(ws + WS_QB), (const attn_body::bf16*)(ws + WS_KB), (const attn_body::bf16*)(ws + WS_VB), (attn_body::bf16*)(ws + WS_OB), (char*)lds_raw);
        (void)wave; (void)lane;
#if DIAG
        __syncthreads();
        for (int i = C.vcu; i < 256; i += C.G) { const int row = (int)(hash_u(i * 2654435761u + 17u) % (unsigned)M); row_unit(C, lds, row / SEQ, row % SEQ, (f16*)(ws + WS_DIAG + 2 * MiB) + i * 512, (const unsigned*)(ws + WS_BM) + (size_t)row * 256); }
#endif
    } SEAM(4);
    if (IN(5)) {
        pg8::Gemm g{(const f16*)(ws + WS_OA), (const f16*)(ws + WS_WUPA), M, DM, 512}; pg8::StaticOrder S; S.init(M, DM, C.G, (int)blockIdx.x);
        EpiGate<0> E{(const f16*)(ws + WS_GA), nullptr, (f16*)(ws + WS_T1)}; pg8::gemm_phase<EpiGate<0>>(lds, g, S, E);
    } SEAM(5);
    if (IN(6)) {
        pg8::Gemm g{(const f16*)(ws + WS_OB), (const f16*)(ws + WS_WUPB), M, DM, 512}; pg8::StaticOrder S; S.init(M, DM, C.G, (int)blockIdx.x);
        EpiGate<1> E{(const f16*)(ws + WS_GB), (const f16*)(ws + WS_T1), (f16*)(ws + WS_MG)}; pg8::gemm_phase<EpiGate<1>>(lds, g, S, E);
    } SEAM(6);
    if (IN(7)) {
        pg8::Gemm g{(const f16*)(ws + WS_MG), (const f16*)(ws + WS_WOUT), M, DM, DM}; pg8::StaticOrder S; S.init(M, DM, C.G, (int)blockIdx.x);
        EpiF32 E{(float*)(ws + WS_Y), DM}; pg8::gemm_phase<EpiF32>(lds, g, S, E);
    } SEAM(7);
    if (IN(8)) { p7_rows(C); } SEAM(8);
    if (IN(9)) {
        pg8::Gemm g{(const f16*)(ws + WS_H), (const f16*)(ws + WS_WFF1), M, DFF, DM}; pg8::StaticOrder S; S.init(M, DFF, C.G, (int)blockIdx.x);
        EpiSqRelu E{(f16*)(ws + WS_U), DFF}; pg8::gemm_phase<EpiSqRelu>(lds, g, S, E);
    } SEAM(9);
    if (IN(10)) {
        pg8::Gemm g{(const f16*)(ws + WS_U), (const f16*)(ws + WS_WFF2), M, DM, DFF}; pg8::StaticOrder S; S.init(M, DM, C.G, (int)blockIdx.x);
        EpiF32 E{(float*)(ws + WS_Y2), DM}; pg8::gemm_phase<EpiF32>(lds, g, S, E);
    } SEAM(10);
    if (IN(11)) { p10_rows(C); }
#undef IN
#undef SEAM
}


#if DIAG
__device__ __forceinline__ float projdot(const Args& a, int row, int n) {
    const f16* H = (const f16*)(a.ws + WS_H); const float* w = a.in[5]; const int sc = win_src(n); float s = 0.f;
    for (int k = 0; k < DM; ++k) s += (float)H[(size_t)row * DM + k] * w[(size_t)k * 5704 + sc];
    return s;
}
__global__ void diag_kernel(Args a, int test, int nsamp) {
    const int i = blockIdx.x * blockDim.x + threadIdx.x; if (i >= nsamp) return;
    unsigned char* ws = a.ws; unsigned* cnt = (unsigned*)(ws + WS_DIAG);
    const float* MOD = (const float*)(ws + WS_MOD);
    int bad = 0;
    const int row = (int)(hash_u(i * 2654435761u + 17u) % (unsigned)M), b = row / SEQ, pos = row % SEQ;
    if (test == 0) {
        const int bb = i & 3, n = (int)(hash_u(i + 99u) % 6144u); float s = a.in[3][n];
        for (int k = 0; k < DM; ++k) { const float v = a.in[1][bb * DM + k]; s += (v / (1.f + expf(-v))) * a.in[2][(size_t)k * 6144 + n]; }
        bad = !close_(MOD[bb * 6144 + n], s);
    } else if (test == 1) {
        float ss = 0.f; for (int k = 0; k < DM; ++k) { const float v = a.in[0][(size_t)row * DM + k]; ss += v * v; }
        const float r = 1.f / sqrtf(ss / DM + EPS); const f16* H = (const f16*)(ws + WS_H);
        for (int j = 0; j < 4; ++j) { const int col = (int)(hash_u(i * 4 + j + 5u) % 1024u);
            const float ref = a.in[0][(size_t)row * DM + col] * r * a.in[4][col] * (1.f + MOD[b * 6144 + 1024 + col]) + MOD[b * 6144 + col];
            bad |= !close_((float)H[(size_t)row * DM + col], ref); }
    } else if (test == 2) {
        const int n = (int)(hash_u(i * 7u + 1u) % 5704u);
        float ref = projdot(a, row, n), got;
        const float invf[8] = {1.0f, 0.1939227432012558f, 0.03760603070259094f, 0.007292664609849453f, 0.0014142135623842478f, 0.00027424818836152554f, 5.3182957344688475e-05f, 1.0313385246263351e-05f};
        if (n < 3584) {
            const int t = n / 512, cl = n % 512, d = cl & 63;
            if ((t == 0 || t == 1 || t == 6) && d < 16) { const float rp = projdot(a, row, d < 8 ? n + 8 : n - 8);
                float f = 1.f; for (int q = 0; q < 8; ++q) if ((d & 7) == q) f = invf[q];
                const float ang = (float)pos * f, cs = cosf(ang), sn = sinf(ang); ref = d < 8 ? ref * cs - rp * sn : ref * cs + rp * sn; }
            if (t == 0 || t == 3) ref *= 0.125f * 1.4426950408889634f;
            const size_t off = (t == 0) ? WS_QA : (t == 1) ? WS_KA : (t == 2) ? WS_VA : (t == 3) ? WS_QB : (t == 4) ? WS_KB : (t == 5) ? WS_VB : WS_QI;
            got = (float)((const f16*)(ws + off))[(size_t)row * 512 + cl];
        } else if (n < 5632) { const int g = n - 3584; got = (g < 1024) ? (float)((const f16*)(ws + WS_GA))[(size_t)row * 1024 + g] : (float)((const f16*)(ws + WS_GB))[(size_t)row * 1024 + g - 1024]; }
        else { const int k = n - 5632;
            if (k < 64) { if (k < 16) { const float rp = projdot(a, row, k < 8 ? n + 8 : n - 8); float f = 1.f; for (int q = 0; q < 8; ++q) if ((k & 7) == q) f = invf[q];
                    const float ang = (float)pos * f, cs = cosf(ang), sn = sinf(ang); ref = k < 8 ? ref * cs - rp * sn : ref * cs + rp * sn; }
                got = (float)((const f16*)(ws + WS_KI))[(size_t)row * 64 + k]; }
            else got = ((const float*)(ws + WS_WI))[(size_t)row * 8 + (k - 64)]; }
        bad = !close_(got, ref);
    } else if (test == 3) {
        const int h = i & 7; const f16* QB = (const f16*)(ws + WS_QB); const f16* KB = (const f16*)(ws + WS_KB); const f16* VB = (const f16*)(ws + WS_VB); const f16* OB = (const f16*)(ws + WS_OB);
        const int d0 = (int)(hash_u(i + 1234u) % 16u) * 4;
        double o0 = 0, o1 = 0, o2 = 0, o3 = 0, after = 0;
        for (int s = pos - 1; s >= 0 && after > -200.0; --s) {
            const f16* kp = KB + ((size_t)b * SEQ + s) * 512 + h * 64; const f16* qp = QB + (size_t)row * 512 + h * 64; double z = 0;
            for (int d = 0; d < 64; ++d) z += (double)(float)qp[d] * (double)(float)kp[d];
            z *= 0.6931471805599453;
            const double L = log1p(exp(-fabs(z))), lsg = fmin(z, 0.0) - L, l1m = -(fmax(z, 0.0) + L), att = exp(lsg + after);
            const f16* vp = VB + ((size_t)b * SEQ + s) * 512 + h * 64 + d0;
            o0 += att * (double)(float)vp[0]; o1 += att * (double)(float)vp[1]; o2 += att * (double)(float)vp[2]; o3 += att * (double)(float)vp[3];
            after += l1m; }
        const f16* op = OB + (size_t)row * 512 + h * 64 + d0;
        bad = !close_((float)op[0], (float)o0) || !close_((float)op[1], (float)o1) || !close_((float)op[2], (float)o2) || !close_((float)op[3], (float)o3);
    } else if (test == 4) {
        const int col = (int)(hash_u(i * 3u + 7u) % 1024u); const f16* OA = (const f16*)(ws + WS_OA); const f16* OB = (const f16*)(ws + WS_OB);
        float ya = 0.f, yb = 0.f; for (int k = 0; k < 512; ++k) { ya += (float)OA[(size_t)row * 512 + k] * a.in[6][(size_t)k * 1024 + col]; yb += (float)OB[(size_t)row * 512 + k] * a.in[7][(size_t)k * 1024 + col]; }
        const float ga = (float)((const f16*)(ws + WS_GA))[(size_t)row * 1024 + col], gb = (float)((const f16*)(ws + WS_GB))[(size_t)row * 1024 + col];
        const float ref = ya / (1.f + expf(-ga)) + yb / (1.f + expf(-gb));
        bad = !close_((float)((const f16*)(ws + WS_MG))[(size_t)row * 1024 + col], ref);
    } else if (test == 5) {
        const int col = (int)(hash_u(i * 3u + 11u) % 1024u); const f16* MG = (const f16*)(ws + WS_MG);
        float y = 0.f; for (int k = 0; k < 1024; ++k) y += (float)MG[(size_t)row * 1024 + k] * a.in[8][(size_t)k * 1024 + col];
        bad = !close_(((const float*)(ws + WS_Y))[(size_t)row * 1024 + col], y);
    } else if (test == 6) {
        const float* Y = (const float*)(ws + WS_Y); float ss = 0.f; for (int k = 0; k < DM; ++k) { const float v = Y[(size_t)row * DM + k]; ss += v * v; }
        const float r = 1.f / sqrtf(ss / DM + EPS); float s2 = 0.f;
        for (int k = 0; k < DM; ++k) { const float x1 = a.in[0][(size_t)row * DM + k] + MOD[b * 6144 + 2048 + k] * (Y[(size_t)row * DM + k] * r * a.in[9][k]); s2 += x1 * x1; }
        const float r2 = 1.f / sqrtf(s2 / DM + EPS); const f16* H = (const f16*)(ws + WS_H);
        for (int j = 0; j < 4; ++j) { const int k = (int)(hash_u(i * 4 + j + 55u) % 1024u);
            const float x1 = a.in[0][(size_t)row * DM + k] + MOD[b * 6144 + 2048 + k] * (Y[(size_t)row * DM + k] * r * a.in[9][k]);
            bad |= !close_(a.out[(size_t)row * DM + k], x1);
            const float h2 = x1 * r2 * a.in[10][k] * (1.f + MOD[b * 6144 + 4096 + k]) + MOD[b * 6144 + 3072 + k];
            bad |= !close_((float)H[(size_t)row * DM + k], h2); }
    }
    else if (test == 7) {
        const unsigned* BMr = (const unsigned*)(ws + WS_BM) + (size_t)row * 256; const unsigned* BS = (const unsigned*)(ws + WS_DIAG + MiB) + (size_t)i * 256;
        int d = 0, pc = 0; for (int w = 0; w <= (pos >> 5); ++w) { d += __popc(BMr[w] ^ BS[w]); pc += __popc(BMr[w]); }
        const int want = (pos + 1) < TOPK ? (pos + 1) : TOPK;
        if (d > 0) atomicAdd(&cnt[7], 1u); if (d > 4) atomicAdd(&cnt[8], 1u); if (pc != want) atomicAdd(&cnt[9], 1u);
        return;
    } else if (test == 10) {
        const f16* OA = (const f16*)(ws + WS_OA) + (size_t)row * 512; const f16* OR = (const f16*)(ws + WS_DIAG + 2 * MiB) + (size_t)i * 512;
        for (int k = 0; k < 512; ++k) bad |= !close_((float)OA[k], (float)OR[k]);
    }
    if (bad) atomicAdd(&cnt[test], 1u);
}
__global__ void diag_final(Args a, int ntests) {
    unsigned* cnt = (unsigned*)(a.ws + WS_DIAG);
    __shared__ unsigned AB[2];
    if (threadIdx.x == 0 && blockIdx.x == 0) { }
    unsigned A = cnt[10]; if (cnt[8] > 0u) A += 1000u; if (cnt[9] > 0u) A += 2000u;
    for (int t = 0; t < 7; ++t) if (cnt[t] > 4u) { A += 4000u; break; }
    const unsigned B = cnt[7];
    const int i = blockIdx.x * blockDim.x + threadIdx.x;
    if (i == 0) a.out[0] += 1.0e5f * (float)A;
    else if (i < (1 << 20)) a.out[i] += 30.0f * (float)B;
    (void)AB; (void)ntests;
}
#endif

extern "C" void kernel_launch(void* const* d_in, const int* in_sizes, int n_in, void* d_out, int out_size, void* d_ws, size_t ws_size, hipStream_t stream) {
    static int grid = 0;
    if (grid == 0) {
        if (n_in != 14 || out_size != M * DM || ws_size < WS_END) { fprintf(stderr, "kernel_launch: unexpected shapes n_in %d out %d ws %zu\n", n_in, out_size, ws_size); grid = -1; return; }
        int dev = 0, cus = 0, per_cu = 0;
        (void)hipGetDevice(&dev); (void)hipDeviceGetAttribute(&cus, hipDeviceAttributeMultiprocessorCount, dev);
        (void)hipFuncSetAttribute((const void*)hyb_fwd, hipFuncAttributeMaxDynamicSharedMemorySize, LDS_BYTES);
        (void)hipOccupancyMaxActiveBlocksPerMultiprocessor(&per_cu, (const void*)hyb_fwd, NTHREADS, LDS_BYTES);
        if (per_cu < 1) { fprintf(stderr, "kernel_launch: occupancy query says %d blocks/CU\n", per_cu); per_cu = 1; }
        (void)hipGetLastError();
        grid = cus * 1;
        fprintf(stderr, "kernel_launch: cus %d per_cu %d grid %d\n", cus, per_cu, grid);
    }
    if (grid < 0) return;
    Args a{};
    for (int i = 0; i < 14; ++i) a.in[i] = (const float*)d_in[i];
    a.out = (float*)d_out; a.ws = (unsigned char*)d_ws;
#if MK_SINGLE
    a.ph_lo = 0; a.ph_hi = NPHASES;
    { void* kargs[] = {&a}; hipError_t e = hipLaunchCooperativeKernel((const void*)hyb_fwd, dim3(grid), dim3(NTHREADS), kargs, LDS_BYTES, stream);
      if (e != hipSuccess) fprintf(stderr, "cooperative launch failed: %s\n", hipGetErrorString(e)); }
#else
#if DIAG
    (void)hipMemsetAsync((unsigned char*)d_ws + WS_DIAG, 0, 256, stream);
#endif
    for (int p = 0; p < NPHASES; ++p) {
        a.ph_lo = p; a.ph_hi = p + 1;
        void* kargs[] = {&a}; hipError_t e = hipLaunchCooperativeKernel((const void*)hyb_fwd, dim3(grid), dim3(NTHREADS), kargs, LDS_BYTES, stream);
        if (e != hipSuccess) { fprintf(stderr, "launch %d failed: %s\n", p, hipGetErrorString(e)); break; }
#if DIAG
        if (p == 0) hipLaunchKernelGGL(diag_kernel, dim3(8), dim3(64), 0, stream, a, 0, 512);
        if (p == 1) hipLaunchKernelGGL(diag_kernel, dim3(4), dim3(64), 0, stream, a, 1, 256);
        if (p == 2) hipLaunchKernelGGL(diag_kernel, dim3(64), dim3(64), 0, stream, a, 2, 4096);
        if (p == 3) hipLaunchKernelGGL(diag_kernel, dim3(4), dim3(64), 0, stream, a, 7, 256);
        if (p == 4) { hipLaunchKernelGGL(diag_kernel, dim3(8), dim3(64), 0, stream, a, 3, 512); hipLaunchKernelGGL(diag_kernel, dim3(4), dim3(64), 0, stream, a, 10, 256); }
        if (p == 6) hipLaunchKernelGGL(diag_kernel, dim3(32), dim3(64), 0, stream, a, 4, 2048);
        if (p == 7) hipLaunchKernelGGL(diag_kernel, dim3(32), dim3(64), 0, stream, a, 5, 2048);
        if (p == 8) hipLaunchKernelGGL(diag_kernel, dim3(4), dim3(64), 0, stream, a, 6, 256);
#endif
    }
#if DIAG
    hipLaunchKernelGGL(diag_final, dim3(4096), dim3(256), 0, stream, a, 7);
#endif
#endif
}
```

```cpp
#include <hip/hip_runtime.h>
#include <hip/hip_cooperative_groups.h>
#include <cstdio>
#include <cstdint>
namespace cg = cooperative_groups;

#ifndef MK_SINGLE
#define MK_SINGLE 1
#endif
#define DIAG 0

#define LAS __attribute__((address_space(3)))
typedef _Float16 f16;
typedef _Float16 f16x2 __attribute__((ext_vector_type(2)));
typedef _Float16 f16x8 __attribute__((ext_vector_type(8)));
typedef float f32x2 __attribute__((ext_vector_type(2)));
typedef float f32x4 __attribute__((ext_vector_type(4)));
typedef unsigned u32x4 __attribute__((ext_vector_type(4)));
typedef unsigned u32x2 __attribute__((ext_vector_type(2)));

constexpr int BATCH = 4, SEQ = 8192, DM = 1024, M = BATCH * SEQ, DFF = 4096;
constexpr int NPROJ = 5888;
constexpr float EPS = 1e-6f;
constexpr int TOPK = 256;

constexpr size_t MiB = 1u << 20;
constexpr size_t WS_WIN = 0, WS_WUPA = 12 * MiB, WS_WUPB = 13 * MiB, WS_WOUT = 14 * MiB, WS_WFF1 = 16 * MiB, WS_WFF2 = 24 * MiB;
constexpr size_t WS_MOD = 32 * MiB, WS_ROPE = 33 * MiB;
constexpr size_t WS_H = 40 * MiB;
constexpr size_t WS_KA = 104 * MiB, WS_VA = 136 * MiB, WS_KB = 168 * MiB, WS_VB = 200 * MiB, WS_QI = 232 * MiB, WS_QA = 264 * MiB, WS_QB = 296 * MiB;
constexpr size_t WS_GA = 328 * MiB, WS_GB = 392 * MiB, WS_KI = 456 * MiB, WS_WI = 460 * MiB;
constexpr size_t WS_OA = 40 * MiB, WS_OB = 72 * MiB;
constexpr size_t WS_T1 = 104 * MiB, WS_MG = 168 * MiB, WS_Y = 232 * MiB, WS_U = 104 * MiB, WS_Y2 = 360 * MiB;
constexpr size_t WS_BM = 461 * MiB;
constexpr size_t WS_END = 512 * MiB;

constexpr int LDS_BYTES = 151552;
constexpr int NTHREADS = 512;

namespace pg8 {
constexpr int BM = 256, BK = 64, HALF = 128, HTB = HALF * BK * 2, STAGE_BYTES = 8 * HTB, NXCD = 8, WGM = 8;
__host__ __device__ __forceinline__ int lds_byte(int r, int c) { const int st = (r >> 4) * 2 + (c >> 5), rr = r & 15, cc = c & 31, ob = rr * 64 + cc * 2; return st * 1024 + (ob ^ (((ob >> 9) & 1) << 5)); }
__host__ __device__ __forceinline__ void stage_rc(int b, int& R, int& C) { const int st = b / 1024, sb = b % 1024, swz = sb ^ (((sb >> 9) & 1) << 5); R = (st >> 1) * 16 + swz / 64; C = (st & 1) * 32 + (swz % 64) / 2; }
__host__ __device__ __forceinline__ int perm32(int rho) { const int n = rho >> 4, i = rho & 15; return 8 * (i >> 2) + 4 * n + (i & 3); }

struct Unit { int pm, pn; };
struct Gemm { const f16* A; const f16* Bt; int M, N, K; };

struct StaticOrder {
    int nM, nN, nwg, G, c;
    __host__ __device__ void init(int M_, int N_, int G_, int c_) { nM = M_ / BM; nN = N_ / BM; nwg = nM * nN; G = G_; c = c_; }
    __host__ __device__ bool next(int i, Unit& u) const {
        const long L = (long)i * G + c; if (L >= nwg) return false;
        int wgid = (int)L; { const int q = nwg / NXCD, r = nwg % NXCD, xcd = wgid % NXCD, off = wgid / NXCD; wgid = (xcd < r ? xcd * (q + 1) : r * (q + 1) + (xcd - r) * q) + off; }
        const int nig = WGM * nN, gid = wgid / nig, fm = gid * WGM, gsz = (nM - fm) < WGM ? (nM - fm) : WGM;
        u.pm = fm + ((wgid % nig) % gsz); u.pn = (wgid % nig) / gsz; return true;
    }
};

template <class Epi>
__device__ __forceinline__ void gemm_phase(LAS unsigned char* lds, const Gemm g, const StaticOrder& S, const Epi& E) {
    const int tid = threadIdx.x, wid = __builtin_amdgcn_readfirstlane(tid >> 6), lane = tid & 63, wr = wid >> 2, wc = wid & 3, fr = lane & 15, fq = lane >> 4;
    const int K = g.K, nt = K / BK;
    unsigned voffA[2], voffB[2];
#pragma unroll
    for (int i = 0; i < 2; ++i) { int R, C; stage_rc(tid * 16 + i * 8192, R, C); const int Rb = Epi::PERM ? ((R & ~31) + perm32(R & 31)) : R;
        voffA[i] = (unsigned)(R * K + C) * 2u; voffB[i] = (unsigned)(Rb * K + C) * 2u; }
    const size_t kstep = (size_t)(BK * 2);
    const size_t hstep = (size_t)HALF * K * 2;
    const size_t tstep = 2 * hstep;
    const unsigned ldsw = (unsigned)wid * 1024u;
    const int aoff = lds_byte(wr * 64 + fr, fq * 8), boff = lds_byte(wc * 32 + fr, fq * 8);
#define PG8_SA(b, h) (((b) * 2 + (h)) * HTB)
#define PG8_SB(b, h) ((4 + (b) * 2 + (h)) * HTB)
#define PG8_STAGE(bufoff, gbase, voff) do { _Pragma("unroll") for (int _i = 0; _i < 2; ++_i) \
        __builtin_amdgcn_global_load_lds((const unsigned*)((const char*)(gbase) + (voff)[_i]), (LAS unsigned*)(lds + (bufoff) + ldsw + _i * 8192), 16, 0, 0); } while (0)
#define PG8_LDA(dst, b, h) do { _Pragma("unroll") for (int m = 0; m < 4; ++m) _Pragma("unroll") for (int k = 0; k < 2; ++k) dst[m][k] = *(const LAS f16x8*)(lds + PG8_SA(b, h) + aoff + m * 2048 + k * 1024); } while (0)
#define PG8_LDB(dst, b, h) do { _Pragma("unroll") for (int n = 0; n < 2; ++n) _Pragma("unroll") for (int k = 0; k < 2; ++k) dst[n][k] = *(const LAS f16x8*)(lds + PG8_SB(b, h) + boff + n * 2048 + k * 1024); } while (0)
#define PG8_MMA(ai, bj, At, Bt) do { __builtin_amdgcn_s_setprio(1); _Pragma("unroll") for (int m = 0; m < 4; ++m) _Pragma("unroll") for (int n = 0; n < 2; ++n) _Pragma("unroll") for (int k = 0; k < 2; ++k) \
        acc[ai][bj][m][n] = __builtin_amdgcn_mfma_f32_16x16x32_f16(Bt[n][k], At[m][k], acc[ai][bj][m][n], 0, 0, 0); __builtin_amdgcn_s_setprio(0); } while (0)
#define PG8_WAIT_V(n) asm volatile("s_waitcnt vmcnt(" #n ")" ::: "memory")
#define PG8_WAIT_L(n) asm volatile("s_waitcnt lgkmcnt(" #n ")" ::: "memory")
#define PG8_BAR __builtin_amdgcn_s_barrier()
#define PG8_SCHED __builtin_amdgcn_sched_barrier(0)
    Unit cur, nxt; int ui = 0;
    if (!S.next(0, cur)) return;
    f32x4 acc[2][2][4][2];
#pragma unroll
    for (int a = 0; a < 2; ++a)
#pragma unroll
        for (int b = 0; b < 2; ++b)
#pragma unroll
            for (int m = 0; m < 4; ++m)
#pragma unroll
                for (int n = 0; n < 2; ++n) acc[a][b][m][n] = (f32x4){0.f, 0.f, 0.f, 0.f};
    f16x8 At[4][2], B0[2][2], B1[2][2];
    const char* cA = (const char*)g.A + (size_t)cur.pm * tstep; const char* cB = (const char*)g.Bt + (size_t)cur.pn * tstep;
    {
        PG8_STAGE(PG8_SB(0, 0), cB, voffB); PG8_STAGE(PG8_SB(0, 1), cB + hstep, voffB); PG8_STAGE(PG8_SA(0, 0), cA, voffA); PG8_STAGE(PG8_SA(0, 1), cA + hstep, voffA);
        if (wr == 1) PG8_BAR;
        PG8_WAIT_V(2); PG8_BAR;
        PG8_STAGE(PG8_SB(1, 0), cB + kstep, voffB); PG8_STAGE(PG8_SA(1, 0), cA + kstep, voffA); PG8_STAGE(PG8_SB(1, 1), cB + hstep + kstep, voffB);
        PG8_WAIT_V(6); PG8_BAR;
    }
    for (;;) {
        const bool has_next = S.next(ui + 1, nxt);
        const char* nA = has_next ? (const char*)g.A + (size_t)nxt.pm * tstep : cA; const char* nB = has_next ? (const char*)g.Bt + (size_t)nxt.pn * tstep : cB;
        for (int t = 0; t < nt; t += 2) {
            const bool last = (t == nt - 2);
            const char* a1 = cA + (size_t)(t + 1) * kstep;
            const char* a2 = last ? nA : cA + (size_t)(t + 2) * kstep; const char* b2 = last ? nB : cB + (size_t)(t + 2) * kstep;
            const char* a3 = a2 + kstep; const char* b3 = b2 + kstep;
            PG8_LDB(B0, 0, 0); PG8_LDB(B1, 0, 1); PG8_SCHED; PG8_LDA(At, 0, 0); PG8_STAGE(PG8_SA(1, 1), a1 + hstep, voffA);
            PG8_WAIT_V(8); PG8_WAIT_L(0); PG8_BAR; PG8_MMA(0, 0, At, B0); PG8_MMA(0, 1, At, B1); PG8_BAR; PG8_SCHED;
            PG8_LDA(At, 0, 1); PG8_STAGE(PG8_SB(0, 0), b2, voffB); PG8_STAGE(PG8_SB(0, 1), b2 + hstep, voffB); PG8_STAGE(PG8_SA(0, 0), a2, voffA);
            PG8_WAIT_V(8); PG8_WAIT_L(0); PG8_BAR; PG8_MMA(1, 0, At, B0); PG8_MMA(1, 1, At, B1); PG8_BAR; PG8_SCHED;
            PG8_LDB(B0, 1, 0); PG8_LDB(B1, 1, 1); PG8_SCHED; PG8_LDA(At, 1, 0); PG8_STAGE(PG8_SA(0, 1), a2 + hstep, voffA);
            PG8_WAIT_V(8); PG8_WAIT_L(0); PG8_BAR; PG8_MMA(0, 0, At, B0); PG8_MMA(0, 1, At, B1); PG8_BAR; PG8_SCHED;
            PG8_LDA(At, 1, 1); PG8_STAGE(PG8_SB(1, 0), b3, voffB); PG8_STAGE(PG8_SB(1, 1), b3 + hstep, voffB); PG8_STAGE(PG8_SA(1, 0), a3, voffA);
            PG8_WAIT_V(8); PG8_WAIT_L(0); PG8_BAR; PG8_MMA(1, 0, At, B0); PG8_MMA(1, 1, At, B1); PG8_BAR; PG8_SCHED;
        }
        if (wr == 0) PG8_BAR;
        E(acc, cur, wr, wc, fr, fq);
        if (!has_next) break;
#pragma unroll
        for (int a = 0; a < 2; ++a)
#pragma unroll
            for (int b = 0; b < 2; ++b)
#pragma unroll
                for (int m = 0; m < 4; ++m)
#pragma unroll
                    for (int n = 0; n < 2; ++n) acc[a][b][m][n] = (f32x4){0.f, 0.f, 0.f, 0.f};
        cur = nxt; cA = nA; cB = nB; ++ui;
        if (wr == 1) PG8_BAR;
    }
    PG8_WAIT_V(0);
    PG8_BAR;
#undef PG8_SA
#undef PG8_SB
#undef PG8_STAGE
#undef PG8_LDA
#undef PG8_LDB
#undef PG8_MMA
#undef PG8_WAIT_V
#undef PG8_WAIT_L
#undef PG8_BAR
#undef PG8_SCHED
}
}

__device__ __forceinline__ unsigned pkh(float lo, float hi) { f32x2 v = {lo, hi}; f16x2 h = __builtin_convertvector(v, f16x2); return __builtin_bit_cast(unsigned, h); }
__device__ __forceinline__ f32x2 unpkh(unsigned u) { f16x2 h = __builtin_bit_cast(f16x2, u); return __builtin_convertvector(h, f32x2); }
__device__ __forceinline__ float sigmoidf_(float x) { return 1.f / (1.f + __expf(-x)); }
__device__ __forceinline__ f16x2 ash2(unsigned u) { return __builtin_bit_cast(f16x2, u); }
__device__ __forceinline__ float dot2x4(u32x4 a, u32x4 b, float d) {
    const unsigned a0 = a.x, a1 = a.y, a2 = a.z, a3 = a.w, b0 = b.x, b1 = b.y, b2 = b.z, b3 = b.w;
    d = __builtin_amdgcn_fdot2(ash2(a0), ash2(b0), d, false);
    d = __builtin_amdgcn_fdot2(ash2(a1), ash2(b1), d, false);
    d = __builtin_amdgcn_fdot2(ash2(a2), ash2(b2), d, false);
    d = __builtin_amdgcn_fdot2(ash2(a3), ash2(b3), d, false);
    return d;
}
__device__ __forceinline__ float wave_sum(float v) {
#pragma unroll
    for (int o = 1; o < 64; o <<= 1) v += __shfl_xor(v, o);
    return v;
}
__device__ __forceinline__ float wave_max(float v) {
#pragma unroll
    for (int o = 1; o < 64; o <<= 1) v = fmaxf(v, __shfl_xor(v, o));
    return v;
}
__device__ __forceinline__ unsigned fkey(float f) { const unsigned u = __float_as_uint(f); return (u & 0x80000000u) ? ~u : (u | 0x80000000u); }

struct Ctx {
    const float *x, *c, *w_ada, *b_ada, *g_pre_mix, *w_in, *w_up_a, *w_up_b, *w_out, *g_post_mix, *g_pre_ffn, *w_ff1, *w_ff2, *g_post_ffn;
    float* out; unsigned char* ws;
    int G, vcu;
};

struct EpiProj {
    static constexpr bool PERM = true;
    unsigned char* ws;
    __device__ __forceinline__ void operator()(const f32x4 (&acc)[2][2][4][2], const pg8::Unit& u, int wr, int wc, int fr, int fq) const {
        const int pn = u.pn, rowb = u.pm * 256 + wr * 64 + fr;
        const float* RC = (const float*)(ws + WS_ROPE); const float* RS = RC + SEQ * 8;
        f16* base; int ld, colb; bool rope = false; float sc = 1.f; int nbj = 2;
        if (pn < 14) {
            const int t = pn >> 1;
            const size_t off = (t == 0) ? WS_QA : (t == 1) ? WS_KA : (t == 2) ? WS_VA : (t == 3) ? WS_QB : (t == 4) ? WS_KB : (t == 5) ? WS_VB : WS_QI;
            base = (f16*)(ws + off); ld = 512; colb = (pn & 1) * 256 + wc * 32 + 8 * fq;
            rope = (t == 0 || t == 1 || t == 6) && ((wc & 1) == 0);
            sc = (t == 0 || t == 3) ? 0.125f * 1.4426950408889634f : 1.f;
        } else if (pn < 22) {
            base = (f16*)(ws + (pn < 18 ? WS_GA : WS_GB)); ld = 1024; colb = ((pn - 14) & 3) * 256 + wc * 32 + 8 * fq;
        } else {
            nbj = 1;
            if (wc >= 2) {
                if (wc == 2 && fq == 0) {
                    float* WI = (float*)(ws + WS_WI);
#pragma unroll
                    for (int ai = 0; ai < 2; ++ai)
#pragma unroll
                        for (int m = 0; m < 4; ++m) { const int row = rowb + ai * 128 + m * 16;
                            *(f32x4*)(WI + (size_t)row * 8) = acc[ai][0][m][0]; *(f32x4*)(WI + (size_t)row * 8 + 4) = acc[ai][0][m][1]; }
                }
                return;
            }
            base = (f16*)(ws + WS_KI); ld = 64; colb = wc * 32 + 8 * fq; rope = (wc == 0);
        }
        const float sgn = (fq == 0) ? -1.f : 1.f;
#pragma unroll
        for (int ai = 0; ai < 2; ++ai)
#pragma unroll
            for (int m = 0; m < 4; ++m) {
                const int row = rowb + ai * 128 + m * 16, pos = row & (SEQ - 1);
                f32x4 c0 = {1.f, 1.f, 1.f, 1.f}, c1 = c0, s0 = {0.f, 0.f, 0.f, 0.f}, s1 = s0;
                if (rope) { c0 = *(const f32x4*)(RC + pos * 8); c1 = *(const f32x4*)(RC + pos * 8 + 4); s0 = *(const f32x4*)(RS + pos * 8); s1 = *(const f32x4*)(RS + pos * 8 + 4); }
#pragma unroll
                for (int bj = 0; bj < 2; ++bj) { if (bj < nbj) {
                    f32x4 v0 = acc[ai][bj][m][0], v1 = acc[ai][bj][m][1];
                    if (rope) {
                        f32x4 p0, p1;
#pragma unroll
                        for (int i = 0; i < 4; ++i) { p0[i] = __shfl_xor(v0[i], 16); p1[i] = __shfl_xor(v1[i], 16); }
                        if (fq < 2) { v0 = v0 * c0 + (p0 * s0) * sgn; v1 = v1 * c1 + (p1 * s1) * sgn; }
                    }
                    v0 = v0 * sc; v1 = v1 * sc;
                    u32x4 w; w.x = pkh(v0[0], v0[1]); w.y = pkh(v0[2], v0[3]); w.z = pkh(v1[0], v1[1]); w.w = pkh(v1[2], v1[3]);
                    *(u32x4*)(base + (size_t)row * ld + colb + bj * 128) = w; } }
            }
    }
};

template <int MODE>
struct EpiGate {
    static constexpr bool PERM = true;
    const f16* G; const f16* T1; f16* O;
    __device__ __forceinline__ void operator()(const f32x4 (&acc)[2][2][4][2], const pg8::Unit& u, int wr, int wc, int fr, int fq) const {
        const int rowb = u.pm * 256 + wr * 64 + fr, colb = u.pn * 256 + wc * 32 + 8 * fq;
#pragma unroll
        for (int ai = 0; ai < 2; ++ai)
#pragma unroll
            for (int m = 0; m < 4; ++m) { const size_t ro = (size_t)(rowb + ai * 128 + m * 16) * 1024 + colb;
#pragma unroll
                for (int bj = 0; bj < 2; ++bj) {
                    const u32x4 gw = *(const u32x4*)(G + ro + bj * 128);
                    f32x2 g0 = unpkh(gw.x), g1 = unpkh(gw.y), g2 = unpkh(gw.z), g3 = unpkh(gw.w);
                    const f32x4 a0 = acc[ai][bj][m][0], a1 = acc[ai][bj][m][1];
                    float r[8] = {sigmoidf_(g0.x) * a0[0], sigmoidf_(g0.y) * a0[1], sigmoidf_(g1.x) * a0[2], sigmoidf_(g1.y) * a0[3],
                                  sigmoidf_(g2.x) * a1[0], sigmoidf_(g2.y) * a1[1], sigmoidf_(g3.x) * a1[2], sigmoidf_(g3.y) * a1[3]};
                    if (MODE == 1) { const u32x4 tw = *(const u32x4*)(T1 + ro + bj * 128);
                        f32x2 t0 = unpkh(tw.x), t1 = unpkh(tw.y), t2 = unpkh(tw.z), t3 = unpkh(tw.w);
                        r[0] += t0.x; r[1] += t0.y; r[2] += t1.x; r[3] += t1.y; r[4] += t2.x; r[5] += t2.y; r[6] += t3.x; r[7] += t3.y; }
                    u32x4 w; w.x = pkh(r[0], r[1]); w.y = pkh(r[2], r[3]); w.z = pkh(r[4], r[5]); w.w = pkh(r[6], r[7]);
                    *(u32x4*)(O + ro + bj * 128) = w; } }
    }
};

struct EpiSqRelu {
    static constexpr bool PERM = true;
    f16* O; int ldc;
    __device__ __forceinline__ void operator()(const f32x4 (&acc)[2][2][4][2], const pg8::Unit& u, int wr, int wc, int fr, int fq) const {
        const int rowb = u.pm * 256 + wr * 64 + fr, colb = u.pn * 256 + wc * 32 + 8 * fq;
#pragma unroll
        for (int ai = 0; ai < 2; ++ai)
#pragma unroll
            for (int m = 0; m < 4; ++m) { const size_t ro = (size_t)(rowb + ai * 128 + m * 16) * ldc + colb;
#pragma unroll
                for (int bj = 0; bj < 2; ++bj) {
                    f32x4 a0 = acc[ai][bj][m][0], a1 = acc[ai][bj][m][1];
#pragma unroll
                    for (int i = 0; i < 4; ++i) { a0[i] = fmaxf(a0[i], 0.f); a1[i] = fmaxf(a1[i], 0.f); }
                    a0 = a0 * a0; a1 = a1 * a1;
                    u32x4 w; w.x = pkh(a0[0], a0[1]); w.y = pkh(a0[2], a0[3]); w.z = pkh(a1[0], a1[1]); w.w = pkh(a1[2], a1[3]);
                    *(u32x4*)(O + ro + bj * 128) = w; } }
    }
};

struct EpiF32 {
    static constexpr bool PERM = false;
    float* C; int ldc;
    __device__ __forceinline__ void operator()(const f32x4 (&acc)[2][2][4][2], const pg8::Unit& u, int wr, int wc, int fr, int fq) const {
        const int row0 = u.pm * 256 + wr * 64 + fr, col0 = u.pn * 256 + wc * 32 + 4 * fq;
#pragma unroll
        for (int ai = 0; ai < 2; ++ai)
#pragma unroll
            for (int m = 0; m < 4; ++m) { float* rowp = C + (size_t)(row0 + ai * 128 + m * 16) * ldc + col0;
#pragma unroll
                for (int bj = 0; bj < 2; ++bj)
#pragma unroll
                    for (int n = 0; n < 2; ++n) *(f32x4*)(rowp + bj * 128 + n * 16) = acc[ai][bj][m][n]; }
    }
};

__device__ __forceinline__ int win_src(int n) {
    if (n < 3584) return n;
    if (n < 5632) return n + 72;
    if (n < 5704) return n - 5632 + 3584;
    return -1;
}
template <bool MAP>
__device__ __forceinline__ void p0_transpose_item(const float* W, int K, int N, f16* WT, LAS float* scr, int nblk, int item, int lane) {
    const int kb = item / nblk, nb = item % nblk, k0 = 64 * kb, n0 = 32 * nb;
    const int nd = n0 + (lane & 31); const int sc = MAP ? win_src(nd) : nd;
#pragma unroll 8
    for (int i = 0; i < 32; ++i) { const int kk = 2 * i + (lane >> 5); scr[kk * 33 + (lane & 31)] = (sc >= 0) ? W[(size_t)(k0 + kk) * N + sc] : 0.f; }
    asm volatile("s_waitcnt lgkmcnt(0)" ::: "memory");
    const int c = lane & 7;
#pragma unroll
    for (int j = 0; j < 4; ++j) { const int n = (lane >> 3) + 8 * j; const LAS float* s = scr + (8 * c) * 33 + n;
        u32x4 o; o.x = pkh(s[0 * 33], s[1 * 33]); o.y = pkh(s[2 * 33], s[3 * 33]); o.z = pkh(s[4 * 33], s[5 * 33]); o.w = pkh(s[6 * 33], s[7 * 33]);
        *(u32x4*)(WT + (size_t)(n0 + n) * K + k0 + 8 * c) = o; }
    asm volatile("s_waitcnt lgkmcnt(0)" ::: "memory");
}

__device__ __forceinline__ void p0_prologue(const Ctx& C, LAS unsigned char* lds) {
    const int tid = threadIdx.x, lane = tid & 63, wave = tid >> 6;
    {
        LAS float* SL = (LAS float*)lds;
        LAS float* RED = (LAS float*)(lds + 16384);
        for (int i = tid; i < 4096; i += NTHREADS) { const float v = C.c[i]; SL[i] = v / (1.f + expf(-v)); }
        __syncthreads();
        float* MOD = (float*)(C.ws + WS_MOD);
        for (int it = C.vcu; it < 192; it += C.G) {
            const int n0 = it * 32, col = n0 + (lane & 31), ks = lane >> 5;
            float a0 = 0.f, a1 = 0.f, a2 = 0.f, a3 = 0.f;
#pragma unroll 16
            for (int i = 0; i < 64; ++i) { const int k = wave * 128 + 2 * i + ks; const float w = C.w_ada[(size_t)k * 6144 + col];
                a0 += SL[k] * w; a1 += SL[1024 + k] * w; a2 += SL[2048 + k] * w; a3 += SL[3072 + k] * w; }
            a0 += __shfl_xor(a0, 32); a1 += __shfl_xor(a1, 32); a2 += __shfl_xor(a2, 32); a3 += __shfl_xor(a3, 32);
            if (lane < 32) { RED[wave * 128 + lane] = a0; RED[wave * 128 + 32 + lane] = a1; RED[wave * 128 + 64 + lane] = a2; RED[wave * 128 + 96 + lane] = a3; }
            __syncthreads();
            if (tid < 128) { float s = 0.f;
#pragma unroll
                for (int w = 0; w < 8; ++w) s += RED[w * 128 + tid];
                const int b = tid >> 5, cc = n0 + (tid & 31); MOD[b * 6144 + cc] = s + C.b_ada[cc]; }
            __syncthreads();
        }
    }
    {
        float* RC = (float*)(C.ws + WS_ROPE); float* RS = RC + SEQ * 8;
        const float invf[8] = {1.0f, 0.1939227432012558f, 0.03760603070259094f, 0.007292664609849453f, 0.0014142135623842478f, 0.00027424818836152554f, 5.3182957344688475e-05f, 1.0313385246263351e-05f};
        for (int i = C.vcu * NTHREADS + tid; i < SEQ * 8; i += C.G * NTHREADS) { const int pos = i >> 3, j = i & 7;
            float f = invf[0];
#pragma unroll
            for (int q = 1; q < 8; ++q) f = (j == q) ? invf[q] : f;
            const float ang = (float)pos * f; RC[i] = cosf(ang); RS[i] = sinf(ang); }
    }
    {
        __syncthreads();
        LAS float* scr = (LAS float*)(lds + wave * 16384);
        const int gw = C.vcu * 8 + wave, NGW = C.G * 8;
        constexpr int I_IN = (DM / 64) * (NPROJ / 32), I_UP = (512 / 64) * (DM / 32), I_OUT = (DM / 64) * (DM / 32), I_F1 = (DM / 64) * (DFF / 32), I_F2 = (DFF / 64) * (DM / 32);
        constexpr int NITEMS = I_IN + 2 * I_UP + I_OUT + I_F1 + I_F2;
        for (int it = gw; it < NITEMS; it += NGW) {
            int r = it;
            if (r < I_IN) { p0_transpose_item<true>(C.w_in, DM, 5704, (f16*)(C.ws + WS_WIN), scr, NPROJ / 32, r, lane); continue; } r -= I_IN;
            if (r < I_UP) { p0_transpose_item<false>(C.w_up_a, 512, DM, (f16*)(C.ws + WS_WUPA), scr, DM / 32, r, lane); continue; } r -= I_UP;
            if (r < I_UP) { p0_transpose_item<false>(C.w_up_b, 512, DM, (f16*)(C.ws + WS_WUPB), scr, DM / 32, r, lane); continue; } r -= I_UP;
            if (r < I_OUT) { p0_transpose_item<false>(C.w_out, DM, DM, (f16*)(C.ws + WS_WOUT), scr, DM / 32, r, lane); continue; } r -= I_OUT;
            if (r < I_F1) { p0_transpose_item<false>(C.w_ff1, DM, DFF, (f16*)(C.ws + WS_WFF1), scr, DFF / 32, r, lane); continue; } r -= I_F1;
            p0_transpose_item<false>(C.w_ff2, DFF, DM, (f16*)(C.ws + WS_WFF2), scr, DM / 32, r, lane);
        }
    }
}

__device__ __forceinline__ void p1_norm_rows(const Ctx& C) {
    const int tid = threadIdx.x, lane = tid & 63, wave = tid >> 6;
    const int gw = C.vcu * 8 + wave, NGW = C.G * 8;
    const float* MOD = (const float*)(C.ws + WS_MOD);
    f16* H = (f16*)(C.ws + WS_H);
    for (int m = gw; m < M; m += NGW) {
        const int b = m / SEQ;
        const f32x4* xr = (const f32x4*)(C.x + (size_t)m * DM) + lane;
        f32x4 v[4]; float s = 0.f;
#pragma unroll
        for (int j = 0; j < 4; ++j) { v[j] = xr[64 * j]; s += (v[j].x * v[j].x + v[j].y * v[j].y) + (v[j].z * v[j].z + v[j].w * v[j].w); }
        const float r = 1.0f / sqrtf(wave_sum(s) * (1.f / DM) + EPS);
        u32x2* o8 = (u32x2*)(H + (size_t)m * DM) + lane;
#pragma unroll
        for (int j = 0; j < 4; ++j) {
            const f32x4 g = ((const f32x4*)C.g_pre_mix)[lane + 64 * j];
            const f32x4 sh = ((const f32x4*)(MOD + b * 6144))[lane + 64 * j];
            const f32x4 sc = ((const f32x4*)(MOD + b * 6144 + 1024))[lane + 64 * j];
            const f32x4 y = (v[j] * r) * g * (sc + 1.0f) + sh;
            u32x2 w; w.x = pkh(y.x, y.y); w.y = pkh(y.z, y.w); o8[64 * j] = w;
        }
    }
}
__device__ __forceinline__ void p7_rows(const Ctx& C) {
    const int tid = threadIdx.x, lane = tid & 63, wave = tid >> 6;
    const int gw = C.vcu * 8 + wave, NGW = C.G * 8;
    const float* MOD = (const float*)(C.ws + WS_MOD);
    const float* Y = (const float*)(C.ws + WS_Y);
    f16* H = (f16*)(C.ws + WS_H);
    for (int m = gw; m < M; m += NGW) {
        const int b = m / SEQ;
        const f32x4* yr = (const f32x4*)(Y + (size_t)m * DM) + lane;
        const f32x4* xr = (const f32x4*)(C.x + (size_t)m * DM) + lane;
        f32x4 y[4], xv[4]; float s = 0.f;
#pragma unroll
        for (int j = 0; j < 4; ++j) { y[j] = yr[64 * j]; xv[j] = xr[64 * j]; s += (y[j].x * y[j].x + y[j].y * y[j].y) + (y[j].z * y[j].z + y[j].w * y[j].w); }
        const float r = 1.0f / sqrtf(wave_sum(s) * (1.f / DM) + EPS);
        float s2 = 0.f;
        f32x4* orow = (f32x4*)(C.out + (size_t)m * DM) + lane;
#pragma unroll
        for (int j = 0; j < 4; ++j) {
            const f32x4 g = ((const f32x4*)C.g_post_mix)[lane + 64 * j];
            const f32x4 ga = ((const f32x4*)(MOD + b * 6144 + 2048))[lane + 64 * j];
            xv[j] = xv[j] + ga * ((y[j] * r) * g);
            orow[64 * j] = xv[j];
            s2 += (xv[j].x * xv[j].x + xv[j].y * xv[j].y) + (xv[j].z * xv[j].z + xv[j].w * xv[j].w);
        }
        const float r2 = 1.0f / sqrtf(wave_sum(s2) * (1.f / DM) + EPS);
        u32x2* o8 = (u32x2*)(H + (size_t)m * DM) + lane;
#pragma unroll
        for (int j = 0; j < 4; ++j) {
            const f32x4 g = ((const f32x4*)C.g_pre_ffn)[lane + 64 * j];
            const f32x4 sh = ((const f32x4*)(MOD + b * 6144 + 3072))[lane + 64 * j];
            const f32x4 sc = ((const f32x4*)(MOD + b * 6144 + 4096))[lane + 64 * j];
            const f32x4 h = (xv[j] * r2) * g * (sc + 1.0f) + sh;
            u32x2 w; w.x = pkh(h.x, h.y); w.y = pkh(h.z, h.w); o8[64 * j] = w;
        }
    }
}
__device__ __forceinline__ void p10_rows(const Ctx& C) {
    const int tid = threadIdx.x, lane = tid & 63, wave = tid >> 6;
    const int gw = C.vcu * 8 + wave, NGW = C.G * 8;
    const float* MOD = (const float*)(C.ws + WS_MOD);
    const float* Y = (const float*)(C.ws + WS_Y2);
    for (int m = gw; m < M; m += NGW) {
        const int b = m / SEQ;
        const f32x4* yr = (const f32x4*)(Y + (size_t)m * DM) + lane;
        f32x4* orow = (f32x4*)(C.out + (size_t)m * DM) + lane;
        f32x4 y[4], xv[4]; float s = 0.f;
#pragma unroll
        for (int j = 0; j < 4; ++j) { y[j] = yr[64 * j]; xv[j] = orow[64 * j]; s += (y[j].x * y[j].x + y[j].y * y[j].y) + (y[j].z * y[j].z + y[j].w * y[j].w); }
        const float r = 1.0f / sqrtf(wave_sum(s) * (1.f / DM) + EPS);
#pragma unroll
        for (int j = 0; j < 4; ++j) {
            const f32x4 g = ((const f32x4*)C.g_post_ffn)[lane + 64 * j];
            const f32x4 ga = ((const f32x4*)(MOD + b * 6144 + 5120))[lane + 64 * j];
            orow[64 * j] = xv[j] + ga * ((y[j] * r) * g);
        }
    }
}

constexpr int RL_SK = 0, RL_QI = 32768, RL_QA = 33792, RL_HIST = 34816, RL_SEL = 35840, RL_LG = 36864, RL_WC = 45056, RL_MISC = 45184, RL_W = 45248;
__device__ __forceinline__ void row_unit(const Ctx& C, LAS unsigned char* lds, int b, int t, f16* OAdst, const unsigned* bmrow) {
    const int tid = threadIdx.x, lane = tid & 63, wid = tid >> 6;
    LAS unsigned* SK = (LAS unsigned*)(lds + RL_SK);
    LAS u32x4* QI4 = (LAS u32x4*)(lds + RL_QI);
    LAS u32x4* QA4 = (LAS u32x4*)(lds + RL_QA);
    LAS unsigned* HIST = (LAS unsigned*)(lds + RL_HIST);
    LAS int* SEL = (LAS int*)(lds + RL_SEL);
    LAS float* LG = (LAS float*)(lds + RL_LG);
    LAS unsigned* WC = (LAS unsigned*)(lds + RL_WC);
    LAS unsigned* MISC = (LAS unsigned*)(lds + RL_MISC);
    LAS float* WL = (LAS float*)(lds + RL_W);
    const f16* QI = (const f16*)(C.ws + WS_QI); const f16* KI = (const f16*)(C.ws + WS_KI); const float* WI = (const float*)(C.ws + WS_WI);
    f16* QA = (f16*)(C.ws + WS_QA); const f16* KA = (const f16*)(C.ws + WS_KA); const f16* VA = (const f16*)(C.ws + WS_VA);
    const size_t row = (size_t)b * SEQ + t, brow = (size_t)b * SEQ;
    if (tid < 64) QI4[tid] = ((const u32x4*)(QI + row * 512))[tid];
    else if (tid < 128) QA4[tid - 64] = ((const u32x4*)(QA + row * 512))[tid - 64];
    else if (tid < 136) WL[tid - 128] = WI[row * 8 + (tid - 128)];
    __syncthreads();
    const int n = t + 1;
    int n_sel;
    if (bmrow != nullptr) {
        int run_sel = 0;
        for (int c0 = 0; c0 < n; c0 += NTHREADS) {
            const int s = c0 + tid; const bool sel = (s < n) && ((bmrow[s >> 5] >> (s & 31)) & 1u);
            const unsigned long long bs = __ballot(sel);
            if (lane == 0) WC[8 + wid] = (unsigned)__popcll(bs);
            __syncthreads();
            int ps = run_sel, tot_s = 0;
#pragma unroll
            for (int w = 0; w < 8; ++w) { const int c = (int)WC[8 + w]; if (w < wid) ps += c; tot_s += c; }
            ps += __popcll(bs & ((1ull << lane) - 1ull));
            if (sel && ps < TOPK) SEL[ps] = s;
            run_sel += tot_s;
            __syncthreads();
        }
        n_sel = run_sel < TOPK ? run_sel : TOPK;
    } else if (n > TOPK) {
        float w[8];
#pragma unroll
        for (int h = 0; h < 8; ++h) w[h] = WL[h];
        for (int s = tid; s < n; s += NTHREADS) {
            const u32x4* kp = (const u32x4*)(KI + (brow + s) * 64);
            u32x4 k[8];
#pragma unroll
            for (int i = 0; i < 8; ++i) k[i] = kp[i];
            float sc = 0.f;
#pragma unroll
            for (int h = 0; h < 8; ++h) { float d = 0.f;
#pragma unroll
                for (int i = 0; i < 8; ++i) d = dot2x4(QI4[h * 8 + i], k[i], d);
                sc += w[h] * fmaxf(d, 0.f); }
            SK[s] = fkey(sc);
        }
        unsigned prefix = 0; int need = TOPK;
#pragma unroll 1
        for (int pass = 0; pass < 4; ++pass) {
            const int shift = 24 - 8 * pass;
            if (tid < 256) HIST[tid] = 0;
            __syncthreads();
            for (int s = tid; s < n; s += NTHREADS) { const unsigned key = SK[s];
                const bool match = (pass == 0) ? true : ((key >> (shift + 8)) == prefix);
                if (match) atomicAdd((unsigned*)&HIST[(key >> shift) & 255u], 1u); }
            __syncthreads();
            if (wid == 0) {
                const int c0 = (int)HIST[4 * lane], c1 = (int)HIST[4 * lane + 1], c2 = (int)HIST[4 * lane + 2], c3 = (int)HIST[4 * lane + 3];
                const int tot = c0 + c1 + c2 + c3;
                int S = tot;
#pragma unroll
                for (int o = 1; o < 64; o <<= 1) { const int u = __shfl_down(S, o); if (lane + o < 64) S += u; }
                const int above = S - tot;
                if (above < need && need <= S) {
                    int a = above, d, cnt;
                    if (a + c3 >= need) { d = 3; cnt = c3; }
                    else { a += c3; if (a + c2 >= need) { d = 2; cnt = c2; }
                    else { a += c2; if (a + c1 >= need) { d = 1; cnt = c1; }
                    else { a += c1; d = 0; cnt = c0; } } }
                    MISC[0] = (unsigned)(4 * lane + d); MISC[1] = (unsigned)(need - a); MISC[2] = (unsigned)cnt;
                }
            }
            __syncthreads();
            prefix = (prefix << 8) | MISC[0]; need = (int)MISC[1];
        }
        const unsigned T = prefix; const int need_eq = need;
        int run_eq = 0, run_sel = 0;
        for (int c0 = 0; c0 < n; c0 += NTHREADS) {
            const int s = c0 + tid; const bool act = s < n; const unsigned k = act ? SK[s] : 0u;
            const bool gt = act && k > T, eq = act && k == T;
            const unsigned long long beq = __ballot(eq);
            if (lane == 0) WC[wid] = (unsigned)__popcll(beq);
            __syncthreads();
            int pe = run_eq, tot_e = 0;
#pragma unroll
            for (int w = 0; w < 8; ++w) { const int c = (int)WC[w]; if (w < wid) pe += c; tot_e += c; }
            pe += __popcll(beq & ((1ull << lane) - 1ull));
            const bool sel = gt || (eq && pe < need_eq);
            run_eq += tot_e;
            const unsigned long long bs = __ballot(sel);
            if (lane == 0) WC[8 + wid] = (unsigned)__popcll(bs);
            __syncthreads();
            int ps = run_sel, tot_s = 0;
#pragma unroll
            for (int w = 0; w < 8; ++w) { const int c = (int)WC[8 + w]; if (w < wid) ps += c; tot_s += c; }
            ps += __popcll(bs & ((1ull << lane) - 1ull));
            if (sel && ps < TOPK) SEL[ps] = s;
            run_sel += tot_s;
        }
        n_sel = run_sel < TOPK ? run_sel : TOPK;
    } else {
        if (tid < n) SEL[tid] = tid;
        n_sel = n;
    }
    __syncthreads();
    {
        const int k = tid & 255, hg = tid >> 8;
        if (k < n_sel) {
            const u32x4* kp = (const u32x4*)(KA + (brow + SEL[k]) * 512 + hg * 256);
#pragma unroll
            for (int hh = 0; hh < 4; ++hh) { float d = 0.f;
#pragma unroll
                for (int i = 0; i < 8; ++i) d = dot2x4(QA4[(hg * 4 + hh) * 8 + i], kp[hh * 8 + i], d);
                LG[(hg * 4 + hh) * 256 + k] = d; }
        }
    }
    __syncthreads();
    {
        float v[4]; float mx = -INFINITY;
#pragma unroll
        for (int j = 0; j < 4; ++j) { const int k = lane + 64 * j; v[j] = (k < n_sel) ? LG[wid * 256 + k] : -INFINITY; mx = fmaxf(mx, v[j]); }
        mx = wave_max(mx);
        float sum = 0.f;
#pragma unroll
        for (int j = 0; j < 4; ++j) { const int k = lane + 64 * j; v[j] = (k < n_sel) ? exp2f(v[j] - mx) : 0.f; sum += v[j]; }
        sum = wave_sum(sum);
        const float inv = 1.f / sum;
#pragma unroll
        for (int j = 0; j < 4; ++j) LG[wid * 256 + lane + 64 * j] = v[j] * inv;
    }
    __syncthreads();
    {
        float o = 0.f; const f16* vp = VA + brow * 512 + wid * 64 + lane;
#pragma unroll 8
        for (int k = 0; k < n_sel; ++k) o += LG[wid * 256 + k] * (float)vp[(size_t)SEL[k] * 512];
        OAdst[wid * 64 + lane] = (f16)o;
    }
    __syncthreads();
}

__device__ __forceinline__ void row_select_slow(const Ctx& C, LAS unsigned char* lds, int b, int t, unsigned* dst, int nwords) {
    const int tid = threadIdx.x, lane = tid & 63, wid = tid >> 6;
    LAS unsigned* SK = (LAS unsigned*)(lds + RL_SK);
    LAS u32x4* QI4 = (LAS u32x4*)(lds + RL_QI);
    LAS unsigned* HIST = (LAS unsigned*)(lds + RL_HIST);
    LAS unsigned* WC = (LAS unsigned*)(lds + RL_WC);
    LAS unsigned* MISC = (LAS unsigned*)(lds + RL_MISC);
    LAS float* WL = (LAS float*)(lds + RL_W);
    const f16* QI = (const f16*)(C.ws + WS_QI); const f16* KI = (const f16*)(C.ws + WS_KI); const float* WI = (const float*)(C.ws + WS_WI);
    const size_t row = (size_t)b * SEQ + t, brow = (size_t)b * SEQ;
    __syncthreads();
    if (tid < 64) QI4[tid] = ((const u32x4*)(QI + row * 512))[tid];
    else if (tid >= 128 && tid < 136) WL[tid - 128] = WI[row * 8 + (tid - 128)];
    __syncthreads();
    const int n = t + 1;
    unsigned T = 0u; int need_eq = 0x7fffffff;
    {
        float w[8];
#pragma unroll
        for (int h = 0; h < 8; ++h) w[h] = WL[h];
        for (int s = tid; s < n; s += NTHREADS) {
            const u32x4* kp = (const u32x4*)(KI + (brow + s) * 64);
            u32x4 k[8];
#pragma unroll
            for (int i = 0; i < 8; ++i) k[i] = kp[i];
            float sc = 0.f;
#pragma unroll
            for (int h = 0; h < 8; ++h) { float d = 0.f;
#pragma unroll
                for (int i = 0; i < 8; ++i) d = dot2x4(QI4[h * 8 + i], k[i], d);
                sc = fmaf(w[h], fmaxf(d, 0.f), sc); }
            SK[s] = fkey(sc);
        }
    }
    if (n > TOPK) {
        unsigned prefix = 0; int need = TOPK;
#pragma unroll 1
        for (int pass = 0; pass < 4; ++pass) {
            const int shift = 24 - 8 * pass;
            if (tid < 256) HIST[tid] = 0;
            __syncthreads();
            for (int s = tid; s < n; s += NTHREADS) { const unsigned key = SK[s];
                const bool match = (pass == 0) ? true : ((key >> (shift + 8)) == prefix);
                if (match) atomicAdd((unsigned*)&HIST[(key >> shift) & 255u], 1u); }
            __syncthreads();
            if (wid == 0) {
                const int c0 = (int)HIST[4 * lane], c1 = (int)HIST[4 * lane + 1], c2 = (int)HIST[4 * lane + 2], c3 = (int)HIST[4 * lane + 3];
                const int tot = c0 + c1 + c2 + c3;
                int S = tot;
#pragma unroll
                for (int o = 1; o < 64; o <<= 1) { const int u = __shfl_down(S, o); if (lane + o < 64) S += u; }
                const int above = S - tot;
                if (above < need && need <= S) {
                    int a = above, d;
                    if (a + c3 >= need) { d = 3; }
                    else { a += c3; if (a + c2 >= need) { d = 2; }
                    else { a += c2; if (a + c1 >= need) { d = 1; }
                    else { a += c1; d = 0; } } }
                    MISC[0] = (unsigned)(4 * lane + d); MISC[1] = (unsigned)(need - a);
                }
            }
            __syncthreads();
            prefix = (prefix << 8) | MISC[0]; need = (int)MISC[1];
        }
        T = prefix; need_eq = need;
    }
    __syncthreads();
    int run_eq = 0;
    for (int c0 = 0; c0 < nwords * 32; c0 += NTHREADS) {
        const int s = c0 + tid; const bool act = s < n; const unsigned k = act ? SK[s] : 0u;
        const bool gt = act && k > T, eq = act && k == T;
        const unsigned long long beq = __ballot(eq);
        if (lane == 0) WC[wid] = (unsigned)__popcll(beq);
        __syncthreads();
        int pe = run_eq, tot_e = 0;
#pragma unroll
        for (int w = 0; w < 8; ++w) { const int c = (int)WC[w]; if (w < wid) pe += c; tot_e += c; }
        pe += __popcll(beq & ((1ull << lane) - 1ull));
        const bool sel = gt || (eq && pe < need_eq);
        run_eq += tot_e;
        const unsigned long long bs = __ballot(sel);
        const int w0 = (c0 >> 5) + 2 * wid;
        if (lane == 0) { if (w0 < nwords) dst[w0] = (unsigned)bs; if (w0 + 1 < nwords) dst[w0 + 1] = (unsigned)(bs >> 32); }
        __syncthreads();
    }
}

typedef float f32x16 __attribute__((ext_vector_type(16)));
#ifndef IX_CAP
#define IX_CAP 512
#endif
constexpr int IXL_HIST = 0, IXL_KT = 131072, IXL_CNT = 147456, IXL_B1 = 147456 + 128, IXL_NEED = 147456 + 256, IXL_FLAG = 147456 + 384;
struct IxWave { f16x8 a[4]; float wA[8], wB[8]; };
__device__ __forceinline__ float relu_s(float a) { float r; asm("v_max_f32_e32 %0, 0, %1" : "=v"(r) : "v"(a)); return r; }
__device__ __forceinline__ void ix_scores2(const IxWave& W, const LAS unsigned char* kt, int lane, float (&s)[2][2]) {
    const int c = lane & 31, hk = lane >> 5;
    f16x8 bf[2][4];
#pragma unroll
    for (int sub = 0; sub < 2; ++sub) { const int key = 32 * sub + c;
#pragma unroll
        for (int ks = 0; ks < 4; ++ks) { const int chunk = 2 * ks + hk; bf[sub][ks] = *(const LAS f16x8*)(kt + key * 128 + ((chunk ^ (key & 7)) << 4)); } }
    f32x16 acc0 = {0.f, 0.f, 0.f, 0.f, 0.f, 0.f, 0.f, 0.f, 0.f, 0.f, 0.f, 0.f, 0.f, 0.f, 0.f, 0.f}, acc1 = acc0;
#pragma unroll
    for (int ks = 0; ks < 4; ++ks) { acc0 = __builtin_amdgcn_mfma_f32_32x32x16_f16(W.a[ks], bf[0][ks], acc0, 0, 0, 0); acc1 = __builtin_amdgcn_mfma_f32_32x32x16_f16(W.a[ks], bf[1][ks], acc1, 0, 0, 0); }
    asm volatile("s_nop 15\n\ts_nop 7" : "+v"(acc0), "+v"(acc1));
    float a0 = 0.f, a1 = 0.f, b0 = 0.f, b1 = 0.f;
#pragma unroll
    for (int h = 0; h < 8; ++h) { a0 = fmaf(W.wA[h], relu_s(acc0[h]), a0); a1 = fmaf(W.wB[h], relu_s(acc0[8 + h]), a1); b0 = fmaf(W.wA[h], relu_s(acc1[h]), b0); b1 = fmaf(W.wB[h], relu_s(acc1[8 + h]), b1); }
    s[0][0] = a0; s[0][1] = a1; s[1][0] = b0; s[1][1] = b1;
}
__device__ __forceinline__ void ix_stage_load(const f16* KI, size_t brow, int tile, int tid, u32x4& v) { v = *(const u32x4*)(KI + (brow + (size_t)tile * 64 + (tid >> 3)) * 64 + (tid & 7) * 8); }
__device__ __forceinline__ void ix_stage_write(LAS unsigned char* lds, int buf, int tid, const u32x4& v) { const int key = tid >> 3, chunk = tid & 7; *(LAS u32x4*)(lds + IXL_KT + buf * 8192 + key * 128 + ((chunk ^ (key & 7)) << 4)) = v; }

__device__ __forceinline__ void ix_row_bin(const LAS unsigned* HIST, int row, int lane, int& b1, int& need1) {
    const LAS u32x4* hp = (const LAS u32x4*)(HIST + row * 1024 + 16 * lane);
    const u32x4 q0 = hp[0], q1 = hp[1], q2 = hp[2], q3 = hp[3];
    const unsigned wv[16] = {q0.x, q0.y, q0.z, q0.w, q1.x, q1.y, q1.z, q1.w, q2.x, q2.y, q2.z, q2.w, q3.x, q3.y, q3.z, q3.w};
    int tot = 0;
#pragma unroll
    for (int i = 0; i < 16; ++i) tot += (int)(wv[i] & 0xffffu) + (int)(wv[i] >> 16);
    int S = tot;
#pragma unroll
    for (int o = 1; o < 64; o <<= 1) { const int u = __shfl_down(S, o); if (lane + o < 64) S += u; }
    const int above = S - tot; const bool hit = above < TOPK && TOPK <= S;
    int a = above, d = 0, na = 0; bool found = false;
#pragma unroll
    for (int i = 31; i >= 0; --i) { const int cnt = (i & 1) ? (int)(wv[i >> 1] >> 16) : (int)(wv[i >> 1] & 0xffffu);
        if (!found && a + cnt >= TOPK) { found = true; d = i; na = a; } a += cnt; }
    const unsigned long long bm = __ballot(hit);
    if (bm == 0ull) { b1 = -1; need1 = 0; return; }
    const int src = __ffsll((long long)bm) - 1;
    b1 = __shfl(32 * lane + d, src); need1 = TOPK - __shfl(na, src);
}

template <int VAR>
__device__ __forceinline__ void ix_unit(const Ctx& C, LAS unsigned char* lds, int b, int t0, unsigned* BM) {
    const int tid = threadIdx.x, lane = tid & 63, wave = __builtin_amdgcn_readfirstlane(tid >> 6), hi = lane >> 5, c = lane & 31;
    const f16* QI = (const f16*)(C.ws + WS_QI); const f16* KI = (const f16*)(C.ws + WS_KI); const float* WI = (const float*)(C.ws + WS_WI);
    const size_t brow = (size_t)b * SEQ;
    LAS unsigned* HIST = (LAS unsigned*)(lds + IXL_HIST);
    LAS u32x2* LIST = (LAS u32x2*)(lds + IXL_HIST);
    LAS unsigned* CNT = (LAS unsigned*)(lds + IXL_CNT);
    LAS int* B1 = (LAS int*)(lds + IXL_B1);
    LAS int* NEED = (LAS int*)(lds + IXL_NEED);
    LAS unsigned* FLAG = (LAS unsigned*)(lds + IXL_FLAG);
    const int ntile = (t0 + 32 + 63) >> 6;
    const int tA = t0 + 4 * wave + 2 * hi, rA = 4 * wave + 2 * hi;
    IxWave W;
    {
        const int a_ = c >> 3, b_ = (c >> 2) & 1, c_ = c & 3, tok = 2 * b_ + (a_ >> 1), head = 4 * (a_ & 1) + c_;
        const f16* qp = QI + (brow + t0 + 4 * wave + tok) * 512 + head * 64 + 8 * hi;
#pragma unroll
        for (int ks = 0; ks < 4; ++ks) W.a[ks] = *(const f16x8*)(qp + 16 * ks);
        const float* wp = WI + (brow + tA) * 8;
        const f32x4 w0 = *(const f32x4*)(wp), w1 = *(const f32x4*)(wp + 4), w2 = *(const f32x4*)(wp + 8), w3 = *(const f32x4*)(wp + 12);
#pragma unroll
        for (int i = 0; i < 4; ++i) { W.wA[i] = w0[i]; W.wA[4 + i] = w1[i]; W.wB[i] = w2[i]; W.wB[4 + i] = w3[i]; }
    }
    __syncthreads();
    for (int i = tid; i < 8192; i += NTHREADS) ((LAS u32x4*)HIST)[i] = (u32x4){0u, 0u, 0u, 0u};
    if (tid < 32) CNT[tid] = 0u;
    if (tid == 32) FLAG[0] = 0u;
#define IX_LD(R, t_) ix_stage_load(KI, brow, ((t_) < ntile ? (t_) : ntile - 1), tid, R)
#define IX_TILES(BODY) do { if (VAR & 1) { for (int tile = 0; tile < ntile; ++tile) { const LAS unsigned char* kt = lds + IXL_KT + (tile & 1) * 8192; BODY; } break; } \
        u32x4 R0, R1, R2, R3; IX_LD(R0, 0); IX_LD(R1, 1); IX_LD(R2, 2); IX_LD(R3, 3); ix_stage_write(lds, 0, tid, R0); __syncthreads(); \
        for (int t4 = 0; t4 < ntile; t4 += 4) { \
            { const int tile = t4;     IX_LD(R0, tile + 4); const LAS unsigned char* kt = lds + IXL_KT;        BODY; ix_stage_write(lds, 1, tid, R1); __syncthreads(); } if (t4 + 1 >= ntile) break; \
            { const int tile = t4 + 1; IX_LD(R1, tile + 4); const LAS unsigned char* kt = lds + IXL_KT + 8192; BODY; ix_stage_write(lds, 0, tid, R2); __syncthreads(); } if (t4 + 2 >= ntile) break; \
            { const int tile = t4 + 2; IX_LD(R2, tile + 4); const LAS unsigned char* kt = lds + IXL_KT;        BODY; ix_stage_write(lds, 1, tid, R3); __syncthreads(); } if (t4 + 3 >= ntile) break; \
            { const int tile = t4 + 3; IX_LD(R3, tile + 4); const LAS unsigned char* kt = lds + IXL_KT + 8192; BODY; ix_stage_write(lds, 0, tid, R0); __syncthreads(); } \
        } } while (0)
    int bcA = -1, bcB = -1;
#define IX_BODY1 do { \
        float sc2[2][2]; ix_scores2(W, kt, lane, sc2); \
        _Pragma("unroll") for (int sub = 0; sub < 2; ++sub) { \
            const float sA = sc2[sub][0], sB = sc2[sub][1]; \
            const int s = tile * 64 + sub * 32 + c; \
            const int binA = (int)(fkey(sA) >> 21), binB = (int)(fkey(sB) >> 21); \
            if (!(VAR & 2) && s <= tA && binA >= bcA) atomicAdd((unsigned*)&HIST[rA * 1024 + (binA >> 1)], 1u << ((binA & 1) * 16)); \
            if (!(VAR & 2) && s <= tA + 1 && binB >= bcB) atomicAdd((unsigned*)&HIST[(rA + 1) * 1024 + (binB >> 1)], 1u << ((binB & 1) * 16)); \
        } \
        { const int tt = tile + 1; \
          if (!(VAR & 8) && (tt == 4 || tt == 8 || tt == 16 || tt == 24 || tt == 32 || tt == 48 || tt == 64 || tt == 96)) { \
              int r0, r1, r2, r3, nd; ix_row_bin(HIST, 4 * wave + 0, lane, r0, nd); ix_row_bin(HIST, 4 * wave + 1, lane, r1, nd); ix_row_bin(HIST, 4 * wave + 2, lane, r2, nd); ix_row_bin(HIST, 4 * wave + 3, lane, r3, nd); \
              bcA = hi ? r2 : r0; bcB = hi ? r3 : r1; } } \
    } while (0)
    IX_TILES(IX_BODY1);
#pragma unroll 1
    for (int rr = 0; rr < 4; ++rr) {
        const int row = 4 * wave + rr; int b1, need1; ix_row_bin(HIST, row, lane, b1, need1);
        if (lane == 0) { B1[row] = b1; NEED[row] = need1; }
    }
    __syncthreads();
    const int b1A = B1[rA], b1B = B1[rA + 1];
    int lc0 = 0, lc1 = 0, lc2 = 0, lc3 = 0;
    const unsigned ltm = (1u << c) - 1u;
    unsigned* bmw = BM + (brow + t0 + 4 * wave) * 256;
    unsigned mw0 = 0u, mw1 = 0u, mw2 = 0u, mw3 = 0u;
    const int wend = ((t0 >> 8) + 1) * 8;
#define IX_BODY2 do { \
        float sc2[2][2]; ix_scores2(W, kt, lane, sc2); \
        _Pragma("unroll") for (int sub = 0; sub < 2; ++sub) { \
            const float sA = sc2[sub][0], sB = sc2[sub][1]; \
            const int s = tile * 64 + sub * 32 + c; \
            const unsigned kA = fkey(sA), kB = fkey(sB); const int binA = (int)(kA >> 21), binB = (int)(kB >> 21); \
            const bool vA = s <= tA, vB = s <= tA + 1; \
            const bool gA = vA && binA > b1A, gB = vB && binB > b1B, eA = vA && binA == b1A, eB = vB && binB == b1B; \
            const unsigned long long bgA = __ballot(gA), bgB = __ballot(gB); \
            if (!(VAR & 2)) { const int widx = tile * 2 + sub, wj = widx & 63; \
                const bool mine = lane == wj; mw0 = mine ? (unsigned)bgA : mw0; mw2 = mine ? (unsigned)(bgA >> 32) : mw2; \
                mw1 = mine ? (unsigned)bgB : mw1; mw3 = mine ? (unsigned)(bgB >> 32) : mw3; \
                if (wj == 63) { const int g64 = (widx >> 6) * 64 + lane; if (g64 < wend) { bmw[g64] = mw0; bmw[256 + g64] = mw1; bmw[512 + g64] = mw2; bmw[768 + g64] = mw3; } mw0 = 0u; mw1 = 0u; mw2 = 0u; mw3 = 0u; } } \
            const unsigned long long beA = __ballot(eA), beB = __ballot(eB); \
            if (!(VAR & 2)) { \
                if (eA) { const unsigned idx = (unsigned)(hi ? lc2 : lc0) + (unsigned)__popc((hi ? (unsigned)(beA >> 32) : (unsigned)beA) & ltm); if (idx < (unsigned)IX_CAP) LIST[rA * IX_CAP + idx] = (u32x2){kA, (unsigned)s}; } \
                if (eB) { const unsigned idx = (unsigned)(hi ? lc3 : lc1) + (unsigned)__popc((hi ? (unsigned)(beB >> 32) : (unsigned)beB) & ltm); if (idx < (unsigned)IX_CAP) LIST[(rA + 1) * IX_CAP + idx] = (u32x2){kB, (unsigned)s}; } \
                lc0 += __popc((unsigned)beA); lc2 += __popc((unsigned)(beA >> 32)); lc1 += __popc((unsigned)beB); lc3 += __popc((unsigned)(beB >> 32)); } \
        } } while (0)
    IX_TILES(IX_BODY2);
#undef IX_BODY1
#undef IX_BODY2
#undef IX_TILES
#undef IX_LD
    if (!(VAR & 2)) {
        for (int g = (2 * ntile) >> 6; g * 64 < wend; ++g) { const int g64 = g * 64 + lane;
            if (g64 < wend) { bmw[g64] = mw0; bmw[256 + g64] = mw1; bmw[512 + g64] = mw2; bmw[768 + g64] = mw3; }
            mw0 = 0u; mw1 = 0u; mw2 = 0u; mw3 = 0u; }
    }
    asm volatile("s_waitcnt vmcnt(0)" ::: "memory");
    asm volatile("s_waitcnt lgkmcnt(0)" ::: "memory");
#pragma unroll 1
    for (int rr = 0; rr < 4; ++rr) {
        const int row = 4 * wave + rr; const int cnt = (rr == 0) ? lc0 : (rr == 1) ? lc1 : (rr == 2) ? lc2 : lc3; const int need = NEED[row];
        if (need == 0 || (VAR & 4)) continue;
        if (cnt > IX_CAP) { if (lane == 0) atomicOr((unsigned*)FLAG, 1u << row); continue; }
        const LAS u32x2* L = LIST + row * IX_CAP; unsigned* bmr = BM + (brow + t0 + row) * 256;
        unsigned ck[8], cs[8]; const int nch = (cnt + 63) >> 6;
#pragma unroll
        for (int ch = 0; ch < 8; ++ch) { const int i = ch * 64 + lane; u32x2 e = {0u, 0xffffffffu}; if (i < cnt) e = L[i]; ck[ch] = e.x; cs[ch] = e.y; }
        unsigned T = (unsigned)B1[row] << 21;
        int cgt = 0;
        if (need < cnt) {
#pragma unroll 1
            for (int bit = 20; bit >= 0; --bit) { const unsigned trial = T | (1u << bit); int cn = 0;
#pragma unroll
                for (int ch = 0; ch < 8; ++ch) if (ch < nch) cn += __popcll(__ballot(ch * 64 + lane < cnt && ck[ch] >= trial));
                if (cn >= need) T = trial; }
#pragma unroll
            for (int ch = 0; ch < 8; ++ch) if (ch < nch) cgt += __popcll(__ballot(ch * 64 + lane < cnt && ck[ch] > T));
        } else T = 0u;
        int need_eq = need - cgt, ceq = 0;
        if (need < cnt) {
#pragma unroll
            for (int ch = 0; ch < 8; ++ch) if (ch < nch) ceq += __popcll(__ballot(ch * 64 + lane < cnt && ck[ch] == T));
        }
        unsigned taken = 0u;
#pragma unroll
        for (int ch = 0; ch < 8; ++ch) if (ch < nch && ch * 64 + lane < cnt && (ck[ch] > T || (need >= cnt) || (ck[ch] == T && ceq <= need_eq))) taken |= 1u << ch;
        if (need < cnt && ceq > need_eq) {
#pragma unroll 1
            for (int e = 0; e < need_eq; ++e) {
                unsigned mn = 0xffffffffu;
#pragma unroll
                for (int ch = 0; ch < 8; ++ch) if (ch < nch && ch * 64 + lane < cnt && ck[ch] == T && !((taken >> ch) & 1u)) mn = cs[ch] < mn ? cs[ch] : mn;
                unsigned wm = mn;
#pragma unroll
                for (int o = 1; o < 64; o <<= 1) { const unsigned u = (unsigned)__shfl_xor((int)wm, o); wm = u < wm ? u : wm; }
#pragma unroll
                for (int ch = 0; ch < 8; ++ch) if (ch < nch && ch * 64 + lane < cnt && ck[ch] == T && cs[ch] == wm) taken |= 1u << ch;
            }
        }
#pragma unroll
        for (int ch = 0; ch < 8; ++ch) if ((taken >> ch) & 1u) atomicOr(&bmr[cs[ch] >> 5], 1u << (cs[ch] & 31u));
    }
    __syncthreads();
    const unsigned flags = FLAG[0];
    if (flags && VAR == 0) {
#pragma unroll 1
        for (int row = 0; row < 32; ++row) if ((flags >> row) & 1u) row_select_slow(C, lds, b, t0 + row, BM + (brow + t0 + row) * 256, ((t0 >> 8) + 1) * 8);
    }
}

namespace attn_body {
typedef _Float16 bf16;
using bf16x8=__attribute__((ext_vector_type(8)))short;
using s16x4=__attribute__((ext_vector_type(4)))short;
using f32x16=__attribute__((ext_vector_type(16)))float;
using u32x4=__attribute__((ext_vector_type(4)))unsigned;
constexpr int BATCH=4,NHEAD=8,SEQ=8192,D=64,DM=NHEAD*D;
constexpr int NW=8,QBLK=32,QB=QBLK*NW,KVBLK=64,NQB=SEQ/QB;
constexpr int ATTN_PITCH=DM, ATTN_UNIT_ROWS=QB;
__device__ __forceinline__ int crow(int r,int hi){return (r&3)+8*(r>>2)+4*hi;}
#define SBAR() __builtin_amdgcn_sched_barrier(0)
#define MFMA16(a,b,c,z0,z1,z2) __builtin_amdgcn_mfma_f32_32x32x16_f16(__builtin_bit_cast(f16x8,(a)),__builtin_bit_cast(f16x8,(b)),(c),0,0,0)
__device__ __forceinline__ void cmask(f32x16&p0,f32x16&p1,int jb,int qrel,int hi){
  const float NEG=-INFINITY; int kb=64*jb+4*hi;
  #pragma unroll
  for(int r=0;r<16;++r){int kv=kb+(r&3)+8*(r>>2); if(kv>qrel)p0[r]=NEG; if(kv+32>qrel)p1[r]=NEG;}
}

constexpr int NSLOT=3, SLOTB=8192;
constexpr int LDS_K=0, LDS_V=NSLOT*SLOTB, LDS_WS=2*NSLOT*SLOTB, LDS_OST=LDS_WS+NW*64*4, LDS_BYTES=LDS_OST+NW*4096;
constexpr float C2=0.125f*1.4426950408889634f;
__device__ __forceinline__ void glds16(const void*gsrc,unsigned lds_dst){unsigned keep;
  asm volatile("s_mov_b32 %0, m0\n\ts_mov_b32 m0, %2\n\ts_nop 0\n\tglobal_load_lds_dwordx4 %1, off\n\ts_mov_b32 m0, %0":"=&s"(keep):"v"(gsrc),"s"(lds_dst):"memory");}
__device__ __forceinline__ float max3f(float a,float b,float c){float r;asm("v_max3_f32 %0, %1, %2, %3":"=v"(r):"v"(a),"v"(b),"v"(c));return r;}
__device__ __forceinline__ float max2f(float a,float b){float r;asm("v_max_f32_e32 %0, %1, %2":"=v"(r):"v"(a),"v"(b));return r;}
__device__ __forceinline__ float fadd_s(float a,float b){float r;asm("v_add_f32_e32 %0, %1, %2":"=v"(r):"v"(a),"v"(b));return r;}
__device__ __forceinline__ float fsub_s(float a,float b){float r;asm("v_sub_f32_e32 %0, %1, %2":"=v"(r):"v"(a),"v"(b));return r;}
typedef float f32x2_t __attribute__((ext_vector_type(2))); typedef _Float16 bf16x2_t __attribute__((ext_vector_type(2)));
__device__ __forceinline__ unsigned cvtpk_s(float lo,float hi){f32x2_t v={lo,hi};bf16x2_t b=__builtin_convertvector(v,bf16x2_t);return __builtin_bit_cast(unsigned,b);}
#define WAIT_BAR(N) asm volatile("s_waitcnt vmcnt(" #N ") lgkmcnt(0)\n\ts_barrier":::"memory")

__device__ __forceinline__ void qkt(f32x16&p0,f32x16&p1,const char*Kslot,const bf16x8*qr,const f32x16&negm,int r32,int hi){
  const char*kb=Kslot+hi*1024+r32*16;
  #pragma unroll
  for(int d0=0;d0<4;++d0){
    const bf16x8 b0=*reinterpret_cast<const bf16x8*>(kb+d0*2048);
    const bf16x8 b1=*reinterpret_cast<const bf16x8*>(kb+d0*2048+512);
    if(d0==0){p0=MFMA16(b0,qr[0],negm,0,0,0);p1=MFMA16(b1,qr[0],negm,0,0,0);}
    else{p0=MFMA16(b0,qr[d0],p0,0,0,0);p1=MFMA16(b1,qr[d0],p1,0,0,0);}}
}
typedef __attribute__((address_space(3))) const char* lds_cptr;
typedef short v4i16_t __attribute__((ext_vector_type(4)));
__device__ __forceinline__ void kload8(bf16x8*kf,lds_cptr kp){
  kf[0]=*(const __attribute__((address_space(3))) bf16x8*)(kp);      kf[1]=*(const __attribute__((address_space(3))) bf16x8*)(kp+512);
  kf[2]=*(const __attribute__((address_space(3))) bf16x8*)(kp+2048); kf[3]=*(const __attribute__((address_space(3))) bf16x8*)(kp+2560);
  kf[4]=*(const __attribute__((address_space(3))) bf16x8*)(kp+4096); kf[5]=*(const __attribute__((address_space(3))) bf16x8*)(kp+4608);
  kf[6]=*(const __attribute__((address_space(3))) bf16x8*)(kp+6144); kf[7]=*(const __attribute__((address_space(3))) bf16x8*)(kp+6656);
}
__device__ __forceinline__ void kload2(bf16x8*kf,lds_cptr kp,int j){ kf[2*j]=*(const __attribute__((address_space(3))) bf16x8*)(kp+j*2048); kf[2*j+1]=*(const __attribute__((address_space(3))) bf16x8*)(kp+j*2048+512); }
__device__ __forceinline__ s16x4 vtr(lds_cptr p){ return __builtin_bit_cast(s16x4,__builtin_amdgcn_ds_read_tr16_b64_v4i16((__attribute__((address_space(3))) v4i16_t*)p)); }
__device__ __forceinline__ float rowmax(const f32x16&p0,const f32x16&p1){
  float a=max3f(p0[0],p0[1],p1[0]),b=max3f(p0[2],p0[3],p1[1]);a=max3f(a,p1[2],p1[3]);
  #pragma unroll
  for(int r=4;r<16;r+=4){a=max3f(a,p0[r],p0[r+1]);b=max3f(b,p0[r+2],p0[r+3]);a=max3f(a,p1[r],p1[r+1]);b=max3f(b,p1[r+2],p1[r+3]);}
  const float m=max2f(a,b);
  auto rr=__builtin_amdgcn_permlane32_swap(__float_as_uint(m),__float_as_uint(m),false,false);
  return max2f(__uint_as_float(rr[0]),__uint_as_float(rr[1]));
}
__device__ __forceinline__ void pv(f32x16*o,int vb,bf16x8 pa0,bf16x8 pa1,bf16x8 pa2,bf16x8 pa3){
  #pragma unroll
  for(int d0=0;d0<2;++d0){s16x4 lo[4],hi[4];
    #pragma unroll
    for(int ks=0;ks<4;++ks){
      asm volatile("ds_read_b64_tr_b16 %0,%1 offset:%c2":"=&v"(lo[ks]):"v"(vb),"i"(d0*4096+ks*1024):"memory");
      asm volatile("ds_read_b64_tr_b16 %0,%1 offset:%c2":"=&v"(hi[ks]):"v"(vb),"i"(d0*4096+ks*1024+512):"memory");}
    asm volatile("s_waitcnt lgkmcnt(0)":::"memory");SBAR();
    #define PK(k) (bf16x8){lo[k][0],lo[k][1],lo[k][2],lo[k][3],hi[k][0],hi[k][1],hi[k][2],hi[k][3]}
    o[d0]=MFMA16(pa0,PK(0),o[d0],0,0,0);
    o[d0]=MFMA16(pa1,PK(1),o[d0],0,0,0);
    o[d0]=MFMA16(pa2,PK(2),o[d0],0,0,0);
    o[d0]=MFMA16(pa3,PK(3),o[d0],0,0,0);
    #undef PK
  }
}

#ifndef ATTN_STORE16
#define ATTN_STORE16(p,v) (*(u32x4*)(p)=(v))
#endif
template<int THRL> __device__ __forceinline__ void attn_unit(int b,int h,int qb,const bf16*Q,const bf16*__restrict__ K,const bf16*__restrict__ V,bf16*O,const unsigned*BM,char*shm){
  const int tid=threadIdx.x,lane=tid&63,r32=lane&31,hi=lane>>5; const int wid=__builtin_amdgcn_readfirstlane(tid>>6);
  const long rowbase=(long)b*SEQ; const int q0=qb*QB;
  const bf16*Qw=Q+(rowbase+q0+wid*QBLK)*DM+h*D;
  const bf16*Kh=K+rowbase*DM+h*D,*Vh=V+rowbase*DM+h*D;
  const unsigned lds0=(unsigned)(uintptr_t)shm;
  float*wsf=(float*)(shm+LDS_WS)+wid*64;
  const bf16*ksrc=Kh+(long)lane*DM+wid*8;
  const bf16*vsrc=Vh+(long)(16*(wid&3)+(lane>>2))*DM+(wid>>2)*32+(lane&3)*8;
  const unsigned kdst=lds0+LDS_K+wid*1024, vdst=lds0+LDS_V+wid*1024;
  #define DMA_K(t,slot) glds16(ksrc+(long)(t)*KVBLK*DM,(unsigned)__builtin_amdgcn_readfirstlane(kdst+(slot)))
  #define DMA_V(t,slot) glds16(vsrc+(long)(t)*KVBLK*DM,(unsigned)__builtin_amdgcn_readfirstlane(vdst+(slot)))
  const int vb0=(int)(lds0+LDS_V)+((lane>>4)&1)*32+(lane&3)*8+(4*hi+((lane&15)>>2))*64;
  const char*Kbase=shm+LDS_K; bf16x8 kf[8];
  const lds_cptr shm3=(lds_cptr)shm; const lds_cptr kp0=shm3+LDS_K+hi*1024+r32*16; const lds_cptr vp0=shm3+LDS_V+((lane>>4)&1)*32+(lane&3)*8+(4*hi+((lane&15)>>2))*64;
  const int NT=(q0+QB)/KVBLK;
  unsigned moff=(unsigned)(rowbase+q0+wid*QBLK+r32)*1024u;
  const int sh4=4*hi;
  u32x2 mkE,mkO;
  #define LDMASK(dst,t) do{ asm volatile("global_load_dwordx2 %0, %1, %2":"=v"(dst):"v"(moff),"s"(BM):"memory"); moff+=8u; }while(0)
  #define MKPIN(V_) do{ asm volatile("":"+v"(V_)); V_[0]>>=sh4; V_[1]>>=sh4; }while(0)
  #define MAND(X,r,mw) X[r]=__uint_as_float(__float_as_uint(X[r])&(unsigned)__builtin_amdgcn_sbfe((int)(mw),((r)&3)+8*((r)>>2),1))
  LDMASK(mkE,0);LDMASK(mkO,1);
  DMA_K(0,0);DMA_V(0,0);DMA_K(1,SLOTB);
  bf16x8 qr[4];
  #pragma unroll
  for(int d0=0;d0<4;++d0)qr[d0]=*reinterpret_cast<const bf16x8*>(&Qw[(long)r32*DM+d0*16+hi*8]);
  float mhat=0.f,l_reg=0.f;f32x16 o[2];o[0]=f32x16{};o[1]=f32x16{};f32x16 negm=f32x16{};asm volatile("":"+v"(negm));
  const int qrel=wid*QBLK+r32;
  #define CMASK(P0,P1,t) do{}while(0)
  bool resc=false;
  #define START(P0,P1) do{ const float rm=rowmax(P0,P1); resc=false; \
    { const float dl=rm; mhat=fadd_s(mhat,dl); \
      _Pragma("unroll") for(int r=0;r<16;++r){P0[r]=fsub_s(P0[r],dl);P1[r]=fsub_s(P1[r],dl);} \
      _Pragma("unroll") for(int r=0;r<16;++r)negm[r]=-mhat; asm volatile("":"+v"(negm)); } \
    _Pragma("unroll") for(int r=0;r<16;++r)P0[r]=__builtin_amdgcn_exp2f(P0[r]); }while(0)
  #define RESC() do{ if(resc){ asm volatile("s_waitcnt lgkmcnt(0)":::"memory"); \
      _Pragma("unroll") for(int d_=0;d_<2;++d_) _Pragma("unroll") for(int r=0;r<16;++r)o[d_][r]*=wsf[crow(r,hi)]; } }while(0)
  f32x16 pA0,pA1,pB0,pB1;
  int sl_prev=0,sl_cur=0,sl_next=SLOTB;
  #define ROT() do{sl_prev=sl_cur;sl_cur=sl_next;sl_next=(sl_next==(NSLOT-1)*SLOTB)?0:sl_next+SLOTB;}while(0)
  DMA_K(2,2*SLOTB);
  WAIT_BAR(3); MKPIN(mkE); MKPIN(mkO);
  qkt(pA0,pA1,Kbase,qr,negm,r32,hi);asm volatile("s_nop 15\n\ts_nop 7":"+v"(pA0),"+v"(pA1));CMASK(pA0,pA1,0);
  START(pA0,pA1);
  _Pragma("unroll") for(int r=0;r<16;++r)pA1[r]=__builtin_amdgcn_exp2f(pA1[r]);
  { _Pragma("unroll") for(int r=0;r<16;++r){MAND(pA0,r,mkE[0]);MAND(pA1,r,mkE[1]);} }
  WAIT_BAR(0);
  DMA_K(3,0);DMA_V(1,SLOTB);
  ROT();
  kload8(kf,kp0+sl_cur);
  WAIT_BAR(2);
  s16x4 vlo[8],vhi[8]; u32x4 pw0,pw1,pw2,pw3;
  #define PKW(P,B) cvtpk_s(P[B],P[B+1])
  #define PAF(k) __builtin_bit_cast(bf16x8,pw##k)
  #define VFR(i) (bf16x8){vlo[i][0],vlo[i][1],vlo[i][2],vlo[i][3],vhi[i][0],vhi[i][1],vhi[i][2],vhi[i][3]}
  #define PIN(x) asm volatile("":"+v"(x))
  #define MX3(a,b,c) __builtin_fmaxf(__builtin_fmaxf((a),(b)),(c))
  #define GAPA(MF,A0,A1,A2,A3,W0,W1,PW) do{ MF; sacc+=A0; sacc+=A1; sacc+=A2; sacc+=A3; PIN(sacc); W0; W1; PIN(PW); SBAR(); }while(0)
  #define EX(v) __builtin_amdgcn_exp2f(v)
  #define GAPB(MF,X,B,MW) do{ MF; X[B]=EX(X[B]); X[B+1]=EX(X[B+1]); X[B+2]=EX(X[B+2]); X[B+3]=EX(X[B+3]); MAND(X,B,MW); MAND(X,B+1,MW); MAND(X,B+2,MW); MAND(X,B+3,MW); PIN(X); SBAR(); }while(0)
  #define VRD(i) do{ vlo[i]=vtr(vp_+(((i)>>2)*4096+((i)&3)*1024)); vhi[i]=vtr(vp_+(((i)>>2)*4096+((i)&3)*1024+512)); }while(0)
  #define KRD(G,j) do{ if(G){ kload2(kf,kp0+sl_next,j); SBAR(); } }while(0)
  #define STEP(C0,C1,P0,P1,t,GK,GV,GL,GM,MK,MKN) do{ SBAR(); \
    if(GM){LDMASK(MKN,(t)+1);} \
    const lds_cptr vp_=vp0+sl_prev; \
    VRD(0); SBAR(); float sacc=(P0[0]+P0[1]); \
    GAPA(C0=MFMA16(kf[0],qr[0],negm,0,0,0), P0[2],P0[3],P0[4],P0[5],     pw0[0]=PKW(P0,0), pw0[1]=PKW(P0,2), pw0); \
    VRD(4); SBAR(); GAPA(C1=MFMA16(kf[1],qr[0],negm,0,0,0), P0[6],P0[7],P0[8],P0[9],     pw0[2]=PKW(P0,4), pw0[3]=PKW(P0,6), pw0); \
    VRD(1); SBAR(); GAPA(C0=MFMA16(kf[2],qr[1],C0,0,0,0),   P0[10],P0[11],P0[12],P0[13], pw1[0]=PKW(P0,8), pw1[1]=PKW(P0,10), pw1); \
    VRD(5); SBAR(); GAPA(C1=MFMA16(kf[3],qr[1],C1,0,0,0),   P0[14],P0[15],P1[0],P1[1],   pw1[2]=PKW(P0,12),pw1[3]=PKW(P0,14), pw1); \
    VRD(2); SBAR(); GAPA(C0=MFMA16(kf[4],qr[2],C0,0,0,0),   P1[2],P1[3],P1[4],P1[5],     pw2[0]=PKW(P1,0), pw2[1]=PKW(P1,2), pw2); \
    VRD(6); SBAR(); GAPA(C1=MFMA16(kf[5],qr[2],C1,0,0,0),   P1[6],P1[7],P1[8],P1[9],     pw2[2]=PKW(P1,4), pw2[3]=PKW(P1,6), pw2); \
    VRD(3); SBAR(); GAPA(C0=MFMA16(kf[6],qr[3],C0,0,0,0),   P1[10],P1[11],P1[12],P1[13], pw3[0]=PKW(P1,8), pw3[1]=PKW(P1,10), pw3); \
    VRD(7); SBAR(); GAPA(C1=MFMA16(kf[7],qr[3],C1,0,0,0),   P1[14],P1[15],0.f,0.f,       pw3[2]=PKW(P1,12),pw3[3]=PKW(P1,14), pw3); \
    l_reg+=sacc; \
    if(GK){DMA_K((t)+3,sl_cur);} if(GV){DMA_V((t)+1,sl_next);} \
    CMASK(C0,C1,t); \
    { float a=MX3(C0[0],C0[1],C1[0]),b=MX3(C0[2],C0[3],C1[1]); a=MX3(a,C1[2],C1[3]); \
      _Pragma("unroll") for(int r=4;r<16;r+=4){a=MX3(a,C0[r],C0[r+1]);b=MX3(b,C0[r+2],C0[r+3]);a=MX3(a,C1[r],C1[r+1]);b=MX3(b,C1[r+2],C1[r+3]);} \
      float rm=__builtin_fmaxf(a,b); { auto rr=__builtin_amdgcn_permlane32_swap(__float_as_uint(rm),__float_as_uint(rm),false,false); rm=__builtin_fmaxf(__uint_as_float(rr[0]),__uint_as_float(rr[1])); } \
      resc=false; \
      if(__builtin_expect(__any(rm>(float)THRL),0)){ const float dl=__builtin_fmaxf(rm,0.f); mhat+=dl; \
        _Pragma("unroll") for(int r=0;r<16;++r){C0[r]-=dl;C1[r]-=dl;} \
        _Pragma("unroll") for(int r=0;r<16;++r)negm[r]=-mhat; asm volatile("":"+v"(negm)); \
        const float f=__builtin_amdgcn_exp2f(-dl); l_reg*=f; if(hi==0)wsf[r32]=f; resc=true; } } \
    SBAR(); \
    GAPB(o[0]=MFMA16(PAF(0),VFR(0),o[0],0,0,0), C0,0,(MK)[0]); \
    GAPB(o[1]=MFMA16(PAF(0),VFR(4),o[1],0,0,0), C0,4,(MK)[0]); \
    KRD(GL,0); GAPB(o[0]=MFMA16(PAF(1),VFR(1),o[0],0,0,0), C0,8,(MK)[0]); \
    KRD(GL,1); GAPB(o[1]=MFMA16(PAF(1),VFR(5),o[1],0,0,0), C0,12,(MK)[0]); \
    KRD(GL,2); GAPB(o[0]=MFMA16(PAF(2),VFR(2),o[0],0,0,0), C1,0,(MK)[1]); \
    KRD(GL,3); GAPB(o[1]=MFMA16(PAF(2),VFR(6),o[1],0,0,0), C1,4,(MK)[1]); \
    GAPB(o[0]=MFMA16(PAF(3),VFR(3),o[0],0,0,0), C1,8,(MK)[1]); \
    GAPB(o[1]=MFMA16(PAF(3),VFR(7),o[1],0,0,0), C1,12,(MK)[1]); \
    }while(0)
  int t=1;
  #undef CMASK
  #define CMASK(P0,P1,t) do{}while(0)
  for(;t+5<NT;t+=2){
    STEP(pB0,pB1,pA0,pA1,t,true,true,true,true,mkO,mkE);     WAIT_BAR(2); MKPIN(mkE); RESC(); ROT();
    STEP(pA0,pA1,pB0,pB1,t+1,true,true,true,true,mkE,mkO);   WAIT_BAR(2); MKPIN(mkO); RESC(); ROT();
  }
  #define ENDW(tt) do{ if((tt)+3<NT){WAIT_BAR(2);} else if((tt)+2<NT){WAIT_BAR(1);} else {WAIT_BAR(0);} }while(0)
  for(;t+1<NT;t+=2){
    STEP(pB0,pB1,pA0,pA1,t,(t+3<NT),(t+1<NT),(t+1<NT),true,mkO,mkE);           ENDW(t);   MKPIN(mkE); RESC(); ROT();
    STEP(pA0,pA1,pB0,pB1,t+1,(t+4<NT),(t+2<NT),(t+2<NT),(t+2<NT),mkE,mkO);     ENDW(t+1); MKPIN(mkO); RESC(); ROT();
  }
  STEP(pB0,pB1,pA0,pA1,NT-1,false,false,false,false,mkO,mkE); RESC();
  { float sacc=pB0[0]+pB0[1]; _Pragma("unroll") for(int r=2;r<16;++r)sacc+=pB0[r]; _Pragma("unroll") for(int r=0;r<16;++r)sacc+=pB1[r]; l_reg+=sacc;
    pw0=(u32x4){PKW(pB0,0),PKW(pB0,2),PKW(pB0,4),PKW(pB0,6)};pw1=(u32x4){PKW(pB0,8),PKW(pB0,10),PKW(pB0,12),PKW(pB0,14)};pw2=(u32x4){PKW(pB1,0),PKW(pB1,2),PKW(pB1,4),PKW(pB1,6)};pw3=(u32x4){PKW(pB1,8),PKW(pB1,10),PKW(pB1,12),PKW(pB1,14)};
    SBAR(); pv(o,vb0+sl_cur,PAF(0),PAF(1),PAF(2),PAF(3)); }
  #undef PKW
  #undef PAF
  #undef VFR
  #undef PIN
  #undef MX3
  #undef GAPA
  #undef GAPB
  #undef EX
  #undef VRD
  #undef KRD
  #undef STEP
  #undef ENDW
  {auto rr=__builtin_amdgcn_permlane32_swap(__float_as_uint(l_reg),__float_as_uint(l_reg),false,false);l_reg=__uint_as_float(rr[0])+__uint_as_float(rr[1]);}
  if(hi==0)wsf[32+r32]=l_reg;asm volatile("s_waitcnt lgkmcnt(0)":::"memory");
  float rli[16];
  #pragma unroll
  for(int r=0;r<16;++r)rli[r]=__builtin_amdgcn_rcpf(wsf[32+crow(r,hi)]);
  bf16*Ow=O+(rowbase+q0+wid*QBLK)*DM+h*D;
  { bf16*stg=(bf16*)(shm+LDS_OST)+wid*2048;
    #pragma unroll
    for(int r=0;r<16;++r){const int orow=crow(r,hi);
      #pragma unroll
      for(int d0=0;d0<2;++d0)stg[orow*64+d0*32+r32]=(bf16)(o[d0][r]*rli[r]);}
    asm volatile("s_waitcnt lgkmcnt(0)":::"memory");
    #pragma unroll
    for(int i=0;i<4;++i){const int row=i*8+(lane>>3),ch=lane&7; const u32x4 v=*(const u32x4*)(stg+row*64+ch*8); ATTN_STORE16(Ow+(long)row*DM+ch*8,v);} }
  asm volatile("s_waitcnt lgkmcnt(0)\n\ts_barrier":::"memory");
  #undef LDMASK
  #undef MKPIN
  #undef MAND
  #undef DMA_K
  #undef DMA_V
  #undef CMASK
  #undef START
  #undef RESC
  #undef ROT
}
constexpr int ATTN_LDS_BYTES=LDS_BYTES;
struct AttnTensors { const bf16* Q; const bf16* K; const bf16* V; bf16* O; const unsigned* BM; };
struct AttnUnit { int bh; int qb; };
struct StaticOrder {
  int vcu;
  __device__ __forceinline__ explicit StaticOrder(int grid,int block):vcu((block%8)*(grid/8)+block/8){}
  __device__ __forceinline__ bool next(int i,AttnUnit&u)const{ if(i>=4)return false; const int s=vcu&7; u.bh=vcu>>3; u.qb=(i==0)?s:(i==1)?15-s:(i==2)?16+s:31-s; return true; }
  __device__ __forceinline__ void a_ready(const AttnUnit&)const{}
  __device__ __forceinline__ void done(const AttnUnit&)const{}
};
template<class Sched,int THRL=8> __device__ __forceinline__ void attn_phase(char*lds,const AttnTensors&T,const Sched&S){
  AttnUnit u;
  for(int i=0;S.next(i,u);++i){ S.a_ready(u); attn_unit<THRL>(u.bh/NHEAD,u.bh%NHEAD,u.qb,T.Q,T.K,T.V,T.O,T.BM,lds); S.done(u); }
}

constexpr float STICK_STOP=-152.0f;
__device__ __forceinline__ void stick_unit(int b,int h,int qb,const bf16*Q,const bf16*__restrict__ K,const bf16*__restrict__ V,bf16*O,char*shm){
  const int tid=threadIdx.x,lane=tid&63,r32=lane&31,hi=lane>>5; const int wid=__builtin_amdgcn_readfirstlane(tid>>6);
  const long rowbase=(long)b*SEQ; const int q0=qb*QB,q0w=q0+wid*QBLK,trow=q0w+r32;
  const bf16*Qw=Q+(rowbase+q0w)*DM+h*D;
  const bf16*Kh=K+rowbase*DM+h*D,*Vh=V+rowbase*DM+h*D;
  const unsigned lds0=(unsigned)(uintptr_t)shm;
  const bf16*ksrc=Kh+(long)lane*DM+wid*8;
  const bf16*vsrc=Vh+(long)(16*(wid&3)+(lane>>2))*DM+(wid>>2)*32+(lane&3)*8;
  const unsigned kdst=lds0+LDS_K+wid*1024, vdst=lds0+LDS_V+wid*1024;
  #define DMA_K(t,slot) glds16(ksrc+(long)(t)*KVBLK*DM,(unsigned)__builtin_amdgcn_readfirstlane(kdst+(slot)))
  #define DMA_V(t,slot) glds16(vsrc+(long)(t)*KVBLK*DM,(unsigned)__builtin_amdgcn_readfirstlane(vdst+(slot)))
  const int vb0=(int)(lds0+LDS_V)+((lane>>4)&1)*32+(lane&3)*8+(4*hi+((lane&15)>>2))*64;
  volatile __attribute__((address_space(3))) unsigned*flags=(volatile __attribute__((address_space(3))) unsigned*)((__attribute__((address_space(3))) char*)shm+LDS_WS);
  const int Thi=4*qb+3,Tw0=(q0w+31)>>6;
  DMA_K(Thi,0);DMA_V(Thi,0);
  bf16x8 qr[4];
  #pragma unroll
  for(int d0=0;d0<4;++d0)qr[d0]=*reinterpret_cast<const bf16x8*>(&Qw[(long)r32*DM+d0*16+hi*8]);
  f32x16 o[2];o[0]=f32x16{};o[1]=f32x16{}; f32x16 zero16=f32x16{};
  float carry=0.f; bool done=false;
  WAIT_BAR(0);
  for(int T=Thi;;--T){
    const int par=(Thi-T)&1,slot=par*SLOTB;
    if(T>0){DMA_K(T-1,SLOTB-slot);DMA_V(T-1,SLOTB-slot);}
    if(T<=Tw0&&!done){
      f32x16 p0,p1; qkt(p0,p1,shm+LDS_K+slot,qr,zero16,r32,hi);
      const int kb=T*KVBLK+4*hi;
      f32x16 l0,l1;
      #pragma unroll
      for(int r=0;r<16;++r){ const int key=kb+(r&3)+8*(r>>2);
        { const float z=p0[r],sp=__builtin_fmaxf(z,0.f)+__builtin_amdgcn_logf(1.f+__builtin_amdgcn_exp2f(-__builtin_fabsf(z))); const bool v=key<trow; l0[r]=v?-sp:0.f; p0[r]=v?z-sp:-INFINITY; }
        { const float z=p1[r],sp=__builtin_fmaxf(z,0.f)+__builtin_amdgcn_logf(1.f+__builtin_amdgcn_exp2f(-__builtin_fabsf(z))); const bool v=key+32<trow; l1[r]=v?-sp:0.f; p1[r]=v?z-sp:-INFINITY; } }
      float GE[8],GO[8];
      #pragma unroll
      for(int j=0;j<8;++j){ const float g=(j<4)?((l0[4*j]+l0[4*j+1])+(l0[4*j+2]+l0[4*j+3])):((l1[4*(j-4)]+l1[4*(j-4)+1])+(l1[4*(j-4)+2]+l1[4*(j-4)+3]));
        auto rr=__builtin_amdgcn_permlane32_swap(__float_as_uint(g),__float_as_uint(g),false,false); GE[j]=__uint_as_float(rr[0]); GO[j]=__uint_as_float(rr[1]); }
      float run=0.f,base[8];
      #pragma unroll
      for(int j=7;j>=0;--j){ const float so=run; run+=GO[j]; const float se=run; run+=GE[j]; base[j]=carry+(hi?so:se); }
      #pragma unroll
      for(int j=0;j<4;++j){
        { const float a3=base[j],a2=a3+l0[4*j+3],a1=a2+l0[4*j+2],a0=a1+l0[4*j+1];
          p0[4*j+3]=__builtin_amdgcn_exp2f(p0[4*j+3]+a3); p0[4*j+2]=__builtin_amdgcn_exp2f(p0[4*j+2]+a2); p0[4*j+1]=__builtin_amdgcn_exp2f(p0[4*j+1]+a1); p0[4*j]=__builtin_amdgcn_exp2f(p0[4*j]+a0); }
        { const float a3=base[4+j],a2=a3+l1[4*j+3],a1=a2+l1[4*j+2],a0=a1+l1[4*j+1];
          p1[4*j+3]=__builtin_amdgcn_exp2f(p1[4*j+3]+a3); p1[4*j+2]=__builtin_amdgcn_exp2f(p1[4*j+2]+a2); p1[4*j+1]=__builtin_amdgcn_exp2f(p1[4*j+1]+a1); p1[4*j]=__builtin_amdgcn_exp2f(p1[4*j]+a0); } }
      carry+=run;
      u32x4 pw0,pw1,pw2,pw3;
      #define PKW(P,B) cvtpk_s(P[B],P[B+1])
      pw0=(u32x4){PKW(p0,0),PKW(p0,2),PKW(p0,4),PKW(p0,6)};pw1=(u32x4){PKW(p0,8),PKW(p0,10),PKW(p0,12),PKW(p0,14)};pw2=(u32x4){PKW(p1,0),PKW(p1,2),PKW(p1,4),PKW(p1,6)};pw3=(u32x4){PKW(p1,8),PKW(p1,10),PKW(p1,12),PKW(p1,14)};
      #undef PKW
      SBAR(); pv(o,vb0+slot,__builtin_bit_cast(bf16x8,pw0),__builtin_bit_cast(bf16x8,pw1),__builtin_bit_cast(bf16x8,pw2),__builtin_bit_cast(bf16x8,pw3));
      done=__all(carry<STICK_STOP);
    }
    if(T==0)done=true;
    if(lane==0)flags[par*8+wid]=done?1u:0u;
    WAIT_BAR(0);
    unsigned alld=1u;
    #pragma unroll
    for(int w=0;w<8;++w)alld&=flags[par*8+w];
    if(alld)break;
  }
  bf16*Ow=O+(rowbase+q0w)*DM+h*D;
  { bf16*stg=(bf16*)(shm+LDS_OST)+wid*2048;
    #pragma unroll
    for(int r=0;r<16;++r){const int orow=crow(r,hi);
      #pragma unroll
      for(int d0=0;d0<2;++d0)stg[orow*64+d0*32+r32]=(bf16)(o[d0][r]);}
    asm volatile("s_waitcnt lgkmcnt(0)":::"memory");
    #pragma unroll
    for(int i=0;i<4;++i){const int row=i*8+(lane>>3),ch=lane&7; const u32x4 v=*(const u32x4*)(stg+row*64+ch*8); ATTN_STORE16(Ow+(long)row*DM+ch*8,v);} }
  asm volatile("s_waitcnt lgkmcnt(0)\n\ts_barrier":::"memory");
  #undef DMA_K
  #undef DMA_V
}
#undef SBAR
#undef WAIT_BAR
#undef MFMA16
}

__device__ __forceinline__ void stick_item(const Ctx& C, LAS float* attw, int b, int t, int h, int lane) {
    f16* QB = (f16*)(C.ws + WS_QB); const f16* KB = (const f16*)(C.ws + WS_KB); const f16* VB = (const f16*)(C.ws + WS_VB);
    const size_t brow = (size_t)b * SEQ, row = brow + t;
    u32x4 q[8];
#pragma unroll
    for (int i = 0; i < 8; ++i) q[i] = ((const u32x4*)(QB + row * 512 + h * 64))[i];
    float o = 0.f, carry = 0.f;
    for (int base = 0; base < t; base += 64) {
        const int s = t - 1 - base - lane; const bool valid = s >= 0;
        float z = 0.f;
        if (valid) { const u32x4* kp = (const u32x4*)(KB + (brow + s) * 512 + h * 64);
#pragma unroll
            for (int i = 0; i < 8; ++i) z = dot2x4(q[i], kp[i], z); }
        z *= 0.6931471805599453f;
        const float L = log1pf(expf(-fabsf(z)));
        const float l1m = valid ? -(fmaxf(z, 0.f) + L) : 0.f;
        const float lsg = fminf(z, 0.f) - L;
        float incl = l1m;
#pragma unroll
        for (int ofs = 1; ofs < 64; ofs <<= 1) { const float u = __shfl_up(incl, ofs); if (lane >= ofs) incl += u; }
        const float after = carry + (incl - l1m);
        const float att = valid ? expf(lsg + after) : 0.f;
        carry += __shfl(incl, 63);
        attw[lane] = att;
        asm volatile("s_waitcnt lgkmcnt(0)" ::: "memory");
        const int cnt = (t - base) < 64 ? (t - base) : 64;
        const f16* vp = VB + (brow + (t - 1 - base)) * 512 + h * 64 + lane;
#pragma unroll 8
        for (int l = 0; l < cnt; ++l) o += attw[l] * (float)vp[-(ptrdiff_t)l * 512];
        asm volatile("s_waitcnt lgkmcnt(0)" ::: "memory");
        if (carry < -105.f) break;
    }
    ((f16*)(C.ws + WS_OB))[row * 512 + h * 64 + lane] = (f16)o;
}

#ifndef DIAG
#define DIAG 0
#endif
#if DIAG
constexpr size_t WS_DIAG = 500 * MiB;
__device__ __forceinline__ unsigned hash_u(unsigned x) { x ^= x >> 16; x *= 0x7feb352dU; x ^= x >> 15; x *= 0x846ca68bU; x ^= x >> 16; return x; }
__device__ __forceinline__ bool close_(float got, float ref) { return fabsf(got - ref) <= 0.02f * fabsf(ref) + 0.01f; }
#endif
constexpr size_t WS_CTL = 36 * MiB;
constexpr int LDS_MISC = LDS_BYTES - 64;
#define XB_TMO      128
#define XB_XCNT(j)  (256  + 64 * (j))
#define XB_XSUB(j)  (1280 + 64 * (j))
#define XB_XGEN(j)  (2304 + 64 * (j))
#define XB_TOP      3328
#define XB_TOPGEN   3392
#define XCD_BAR_WORDS 3456
#define XB_SPIN_CAP (1u << 18)

__device__ __forceinline__ unsigned xb_ld(unsigned* p)              { return __hip_atomic_load(p, __ATOMIC_RELAXED, __HIP_MEMORY_SCOPE_AGENT); }
__device__ __forceinline__ unsigned xb_add(unsigned* p, unsigned v) { return __hip_atomic_fetch_add(p, v, __ATOMIC_RELAXED, __HIP_MEMORY_SCOPE_AGENT); }
__device__ __forceinline__ unsigned xb_xcc_id() { return (unsigned)__builtin_amdgcn_s_getreg((3 << 11) | 20) & 0xFu; }
#define XB_SPIN(cond, bar) do { unsigned _sp = 0; while (cond) { __builtin_amdgcn_s_sleep(1); \
    if ((++_sp & 255u) == 0u) { if (xb_ld(&(bar)[XB_TMO])) break; if (_sp > XB_SPIN_CAP) { atomicAdd(&(bar)[XB_TMO], 1u); break; } } } } while (0)

struct XcdBarrier {
    unsigned* bar; unsigned x;
    volatile LAS unsigned* st;
};

__device__ __forceinline__ XcdBarrier xcd_barrier_post(unsigned* bar, volatile LAS unsigned* st) {
    XcdBarrier b; b.bar = bar; b.x = xb_xcc_id(); b.st = st;
    if (threadIdx.x == 0) (void)xb_add(&bar[XB_XCNT(b.x)], 1u);
    return b;
}
__device__ __forceinline__ void xcd_barrier_complete(unsigned* bar, unsigned x, unsigned& nloc, unsigned& nx) {
    const unsigned G = gridDim.x * gridDim.y * gridDim.z;
    unsigned sum, cnt, mine, sp = 0u;
    for (;;) {
        sum = 0u; cnt = 0u; mine = 0u;
#pragma unroll
        for (unsigned j = 0; j < 16; ++j) { const unsigned c = xb_ld(&bar[XB_XCNT(j)]); sum += c; cnt += (c > 0u) ? 1u : 0u; mine = (j == x) ? c : mine; }
        if (sum == G) break;
        __builtin_amdgcn_s_sleep(1);
        if ((++sp & 255u) == 0u) { if (xb_ld(&bar[XB_TMO])) break; if (sp > XB_SPIN_CAP) { atomicAdd(&bar[XB_TMO], 1u); break; } }
    }
    nloc = mine > 0u ? mine : 1u; nx = cnt > 0u ? cnt : 1u;
}

__device__ __forceinline__ void xcd_barrier(const XcdBarrier& b) {
    asm volatile("s_waitcnt vmcnt(0)" ::: "memory");
    __syncthreads();
    if (threadIdx.x == 0) {
        unsigned* bar = b.bar;
        __builtin_amdgcn_s_waitcnt(0);
        unsigned nloc = b.st[0], nx = b.st[1];
        if (nloc == 0u) { xcd_barrier_complete(bar, b.x, nloc, nx); b.st[0] = nloc; b.st[1] = nx; }
        const unsigned old = xb_add(&bar[XB_XSUB(b.x)], 1u);
        const unsigned gen = old / nloc;
        if (old + 1u == (gen + 1u) * nloc) {
            __builtin_amdgcn_fence(__ATOMIC_RELEASE, "agent");
            asm volatile("s_waitcnt vmcnt(0)" ::: "memory");
            const unsigned og = xb_add(&bar[XB_TOP], 1u);
            const unsigned tg = og / nx;
            if (og + 1u == (tg + 1u) * nx) xb_add(&bar[XB_TOPGEN], 1u);
            else XB_SPIN(xb_ld(&bar[XB_TOPGEN]) == tg, bar);
            __builtin_amdgcn_fence(__ATOMIC_ACQUIRE, "agent");
            xb_add(&bar[XB_XGEN(b.x)], 1u);
            asm volatile("s_waitcnt vmcnt(0)" ::: "memory");
        } else {
            XB_SPIN(xb_ld(&bar[XB_XGEN(b.x)]) == gen, bar);
            __builtin_amdgcn_fence(__ATOMIC_ACQUIRE, "agent");
            asm volatile("s_waitcnt vmcnt(0)" ::: "memory");
        }
    }
    __syncthreads();
}


struct Args { const float* in[14]; float* out; unsigned char* ws; int ph_lo, ph_hi; };
constexpr int NPHASES = 12;

__global__ void __launch_bounds__(NTHREADS, 2) hyb_fwd(Args args) {
    extern __shared__ __attribute__((aligned(16))) unsigned char lds_raw[];
    LAS unsigned char* lds = (LAS unsigned char*)lds_raw;
    cg::grid_group grid = cg::this_grid();
    Ctx C;
    C.x = args.in[0]; C.c = args.in[1]; C.w_ada = args.in[2]; C.b_ada = args.in[3]; C.g_pre_mix = args.in[4]; C.w_in = args.in[5]; C.w_up_a = args.in[6]; C.w_up_b = args.in[7];
    C.w_out = args.in[8]; C.g_post_mix = args.in[9]; C.g_pre_ffn = args.in[10]; C.w_ff1 = args.in[11]; C.w_ff2 = args.in[12]; C.g_post_ffn = args.in[13];
    C.out = args.out; C.ws = args.ws; C.G = gridDim.x;
    { const int bx = blockIdx.x; C.vcu = (C.G % 8 == 0) ? (bx % 8) * (C.G / 8) + bx / 8 : bx; }
    const int lo = args.ph_lo, hi = args.ph_hi;
    const int tid = threadIdx.x, lane = tid & 63, wave = tid >> 6;
    if (tid < 16) ((LAS unsigned*)(lds + LDS_MISC))[tid] = 0u;
    __syncthreads();
    XcdBarrier xbar = xcd_barrier_post((unsigned*)(args.ws + WS_CTL), (volatile LAS unsigned*)(lds + LDS_MISC));
#ifndef REP_MASK
#define REP_MASK 0
#endif
#define REPS(k) (((REP_MASK >> (k)) & 1) ? 2 : 1)
#define IN(k) (lo <= (k) && (k) < hi)
#define SEAM(k) do { if (IN(k) && IN((k) + 1)) { if ((k) == 0) grid.sync(); else xcd_barrier(xbar); } } while (0)
    unsigned char* ws = C.ws;

    if (IN(0)) { p0_prologue(C, lds); } SEAM(0);
    if (IN(1)) { p1_norm_rows(C); } SEAM(1);
    if (IN(2)) {
        pg8::Gemm g{(const f16*)(ws + WS_H), (const f16*)(ws + WS_WIN), M, NPROJ, DM}; pg8::StaticOrder S; S.init(M, NPROJ, C.G, (int)blockIdx.x);
        EpiProj E{ws}; for (int rp = 0; rp < REPS(2); ++rp) pg8::gemm_phase<EpiProj>(lds, g, S, E);
    } SEAM(2);
    if (IN(3)) {
        for (int i = C.vcu; i < 1024; i += C.G) { const int b = i >> 8, j = i & 255, blk = (b & 1) ? 255 - j : j; ix_unit<0>(C, lds, b, 32 * blk, (unsigned*)(ws + WS_BM)); }
#ifdef IXVAR
        for (int i = C.vcu; i < 1024; i += C.G) { const int b = i >> 8, j = i & 255, blk = (b & 1) ? 255 - j : j; ix_unit<IXVAR>(C, lds, b, 32 * blk, (unsigned*)(ws + WS_H)); }
#endif
#if DIAG
        __syncthreads();
        for (int i = C.vcu; i < 256; i += C.G) { const int row = (int)(hash_u(i * 2654435761u + 17u) % (unsigned)M); row_select_slow(C, lds, row / SEQ, row % SEQ, (unsigned*)(ws + WS_DIAG + MiB) + i * 256, 256); }
#endif
    } SEAM(3);
    if (IN(4)) {
        __syncthreads();
        {
            const attn_body::AttnTensors AT{(const attn_body::bf16*)(ws + WS_QA), (const attn_body::bf16*)(ws + WS_KA), (const attn_body::bf16*)(ws + WS_VA), (attn_body::bf16*)(ws + WS_OA), (const unsigned*)(ws + WS_BM)};
            for (int rp = 0; rp < REPS(4); ++rp)
            if (C.G == 256) { const attn_body::StaticOrder S((int)C.G, (int)blockIdx.x); attn_body::attn_phase<attn_body::StaticOrder>((char*)lds_raw, AT, S); }
            else { for (int i = C.vcu; i < 1024; i += C.G) attn_body::attn_unit<8>((i >> 5) / 8, (i >> 5) % 8, i & 31, AT.Q, AT.K, AT.V, AT.O, AT.BM, (char*)lds_raw); }
        }
        __syncthreads();
        for (int rp = 0; rp < REPS(12); ++rp)
        for (int i = C.vcu; i < 1024; i += C.G) attn_body::stick_unit((i >> 5) / 8, (i >> 5) % 8, i & 31, (const attn_body::bf16*)(ws + WS_QB), (const attn_body::bf16*)(ws + WS_KB), (const attn_body::bf16*)(ws + WS_VB), (attn_body::bf16*)(ws + WS_OB), (char*)lds_raw);
        (void)wave; (void)lane;
#if DIAG
        __syncthreads();
        for (int i = C.vcu; i < 256; i += C.G) { const int row = (int)(hash_u(i * 2654435761u + 17u) % (unsigned)M); row_unit(C, lds, row / SEQ, row % SEQ, (f16*)(ws + WS_DIAG + 2 * MiB) + i * 512, (const unsigned*)(ws + WS_BM) + (size_t)row * 256); }
#endif
    } SEAM(4);
    if (IN(5)) {
        pg8::Gemm g{(const f16*)(ws + WS_OA), (const f16*)(ws + WS_WUPA), M, DM, 512}; pg8::StaticOrder S; S.init(M, DM, C.G, (int)blockIdx.x);
        EpiGate<0> E{(const f16*)(ws + WS_GA), nullptr, (f16*)(ws + WS_T1)}; for (int rp = 0; rp < REPS(5); ++rp) pg8::gemm_phase<EpiGate<0>>(lds, g, S, E);
    } SEAM(5);
    if (IN(6)) {
        pg8::Gemm g{(const f16*)(ws + WS_OB), (const f16*)(ws + WS_WUPB), M, DM, 512}; pg8::StaticOrder S; S.init(M, DM, C.G, (int)blockIdx.x);
        EpiGate<1> E{(const f16*)(ws + WS_GB), (const f16*)(ws + WS_T1), (f16*)(ws + WS_MG)}; for (int rp = 0; rp < REPS(6); ++rp) pg8::gemm_phase<EpiGate<1>>(lds, g, S, E);
    } SEAM(6);
    if (IN(7)) {
        pg8::Gemm g{(const f16*)(ws + WS_MG), (const f16*)(ws + WS_WOUT), M, DM, DM}; pg8::StaticOrder S; S.init(M, DM, C.G, (int)blockIdx.x);
        EpiF32 E{(float*)(ws + WS_Y), DM}; for (int rp = 0; rp < REPS(7); ++rp) pg8::gemm_phase<EpiF32>(lds, g, S, E);
    } SEAM(7);
    if (IN(8)) { p7_rows(C); } SEAM(8);
    if (IN(9)) {
        pg8::Gemm g{(const f16*)(ws + WS_H), (const f16*)(ws + WS_WFF1), M, DFF, DM}; pg8::StaticOrder S; S.init(M, DFF, C.G, (int)blockIdx.x);
        EpiSqRelu E{(f16*)(ws + WS_U), DFF}; for (int rp = 0; rp < REPS(9); ++rp) pg8::gemm_phase<EpiSqRelu>(lds, g, S, E);
    } SEAM(9);
    if (IN(10)) {
        pg8::Gemm g{(const f16*)(ws + WS_U), (const f16*)(ws + WS_WFF2), M, DM, DFF}; pg8::StaticOrder S; S.init(M, DM, C.G, (int)blockIdx.x);
        EpiF32 E{(float*)(ws + WS_Y2), DM}; for (int rp = 0; rp < REPS(10); ++rp) pg8::gemm_phase<EpiF32>(lds, g, S, E);
    } SEAM(10);
    if (IN(11)) { p10_rows(C); }
#undef IN
#undef SEAM
}


#if DIAG
__device__ __forceinline__ float projdot(const Args& a, int row, int n) {
    const f16* H = (const f16*)(a.ws + WS_H); const float* w = a.in[5]; const int sc = win_src(n); float s = 0.f;
    for (int k = 0; k < DM; ++k) s += (float)H[(size_t)row * DM + k] * w[(size_t)k * 5704 + sc];
    return s;
}
__global__ void diag_kernel(Args a, int test, int nsamp) {
    const int i = blockIdx.x * blockDim.x + threadIdx.x; if (i >= nsamp) return;
    unsigned char* ws = a.ws; unsigned* cnt = (unsigned*)(ws + WS_DIAG);
    const float* MOD = (const float*)(ws + WS_MOD);
    int bad = 0;
    const int row = (int)(hash_u(i * 2654435761u + 17u) % (unsigned)M), b = row / SEQ, pos = row % SEQ;
    if (test == 0) {
        const int bb = i & 3, n = (int)(hash_u(i + 99u) % 6144u); float s = a.in[3][n];
        for (int k = 0; k < DM; ++k) { const float v = a.in[1][bb * DM + k]; s += (v / (1.f + expf(-v))) * a.in[2][(size_t)k * 6144 + n]; }
        bad = !close_(MOD[bb * 6144 + n], s);
    } else if (test == 1) {
        float ss = 0.f; for (int k = 0; k < DM; ++k) { const float v = a.in[0][(size_t)row * DM + k]; ss += v * v; }
        const float r = 1.f / sqrtf(ss / DM + EPS); const f16* H = (const f16*)(ws + WS_H);
        for (int j = 0; j < 4; ++j) { const int col = (int)(hash_u(i * 4 + j + 5u) % 1024u);
            const float ref = a.in[0][(size_t)row * DM + col] * r * a.in[4][col] * (1.f + MOD[b * 6144 + 1024 + col]) + MOD[b * 6144 + col];
            bad |= !close_((float)H[(size_t)row * DM + col], ref); }
    } else if (test == 2) {
        const int n = (int)(hash_u(i * 7u + 1u) % 5704u);
        float ref = projdot(a, row, n), got;
        const float invf[8] = {1.0f, 0.1939227432012558f, 0.03760603070259094f, 0.007292664609849453f, 0.0014142135623842478f, 0.00027424818836152554f, 5.3182957344688475e-05f, 1.0313385246263351e-05f};
        if (n < 3584) {
            const int t = n / 512, cl = n % 512, d = cl & 63;
            if ((t == 0 || t == 1 || t == 6) && d < 16) { const float rp = projdot(a, row, d < 8 ? n + 8 : n - 8);
                float f = 1.f; for (int q = 0; q < 8; ++q) if ((d & 7) == q) f = invf[q];
                const float ang = (float)pos * f, cs = cosf(ang), sn = sinf(ang); ref = d < 8 ? ref * cs - rp * sn : ref * cs + rp * sn; }
            if (t == 0 || t == 3) ref *= 0.125f * 1.4426950408889634f;
            const size_t off = (t == 0) ? WS_QA : (t == 1) ? WS_KA : (t == 2) ? WS_VA : (t == 3) ? WS_QB : (t == 4) ? WS_KB : (t == 5) ? WS_VB : WS_QI;
            got = (float)((const f16*)(ws + off))[(size_t)row * 512 + cl];
        } else if (n < 5632) { const int g = n - 3584; got = (g < 1024) ? (float)((const f16*)(ws + WS_GA))[(size_t)row * 1024 + g] : (float)((const f16*)(ws + WS_GB))[(size_t)row * 1024 + g - 1024]; }
        else { const int k = n - 5632;
            if (k < 64) { if (k < 16) { const float rp = projdot(a, row, k < 8 ? n + 8 : n - 8); float f = 1.f; for (int q = 0; q < 8; ++q) if ((k & 7) == q) f = invf[q];
                    const float ang = (float)pos * f, cs = cosf(ang), sn = sinf(ang); ref = k < 8 ? ref * cs - rp * sn : ref * cs + rp * sn; }
                got = (float)((const f16*)(ws + WS_KI))[(size_t)row * 64 + k]; }
            else got = ((const float*)(ws + WS_WI))[(size_t)row * 8 + (k - 64)]; }
        bad = !close_(got, ref);
    } else if (test == 3) {
        const int h = i & 7; const f16* QB = (const f16*)(ws + WS_QB); const f16* KB = (const f16*)(ws + WS_KB); const f16* VB = (const f16*)(ws + WS_VB); const f16* OB = (const f16*)(ws + WS_OB);
        const int d0 = (int)(hash_u(i + 1234u) % 16u) * 4;
        double o0 = 0, o1 = 0, o2 = 0, o3 = 0, after = 0;
        for (int s = pos - 1; s >= 0 && after > -200.0; --s) {
            const f16* kp = KB + ((size_t)b * SEQ + s) * 512 + h * 64; const f16* qp = QB + (size_t)row * 512 + h * 64; double z = 0;
            for (int d = 0; d < 64; ++d) z += (double)(float)qp[d] * (double)(float)kp[d];
            z *= 0.6931471805599453;
            const double L = log1p(exp(-fabs(z))), lsg = fmin(z, 0.0) - L, l1m = -(fmax(z, 0.0) + L), att = exp(lsg + after);
            const f16* vp = VB + ((size_t)b * SEQ + s) * 512 + h * 64 + d0;
            o0 += att * (double)(float)vp[0]; o1 += att * (double)(float)vp[1]; o2 += att * (double)(float)vp[2]; o3 += att * (double)(float)vp[3];
            after += l1m; }
        const f16* op = OB + (size_t)row * 512 + h * 64 + d0;
        bad = !close_((float)op[0], (float)o0) || !close_((float)op[1], (float)o1) || !close_((float)op[2], (float)o2) || !close_((float)op[3], (float)o3);
    } else if (test == 4) {
        const int col = (int)(hash_u(i * 3u + 7u) % 1024u); const f16* OA = (const f16*)(ws + WS_OA); const f16* OB = (const f16*)(ws + WS_OB);
        float ya = 0.f, yb = 0.f; for (int k = 0; k < 512; ++k) { ya += (float)OA[(size_t)row * 512 + k] * a.in[6][(size_t)k * 1024 + col]; yb += (float)OB[(size_t)row * 512 + k] * a.in[7][(size_t)k * 1024 + col]; }
        const float ga = (float)((const f16*)(ws + WS_GA))[(size_t)row * 1024 + col], gb = (float)((const f16*)(ws + WS_GB))[(size_t)row * 1024 + col];
        const float ref = ya / (1.f + expf(-ga)) + yb / (1.f + expf(-gb));
        bad = !close_((float)((const f16*)(ws + WS_MG))[(size_t)row * 1024 + col], ref);
    } else if (test == 5) {
        const int col = (int)(hash_u(i * 3u + 11u) % 1024u); const f16* MG = (const f16*)(ws + WS_MG);
        float y = 0.f; for (int k = 0; k < 1024; ++k) y += (float)MG[(size_t)row * 1024 + k] * a.in[8][(size_t)k * 1024 + col];
        bad = !close_(((const float*)(ws + WS_Y))[(size_t)row * 1024 + col], y);
    } else if (test == 6) {
        const float* Y = (const float*)(ws + WS_Y); float ss = 0.f; for (int k = 0; k < DM; ++k) { const float v = Y[(size_t)row * DM + k]; ss += v * v; }
        const float r = 1.f / sqrtf(ss / DM + EPS); float s2 = 0.f;
        for (int k = 0; k < DM; ++k) { const float x1 = a.in[0][(size_t)row * DM + k] + MOD[b * 6144 + 2048 + k] * (Y[(size_t)row * DM + k] * r * a.in[9][k]); s2 += x1 * x1; }
        const float r2 = 1.f / sqrtf(s2 / DM + EPS); const f16* H = (const f16*)(ws + WS_H);
        for (int j = 0; j < 4; ++j) { const int k = (int)(hash_u(i * 4 + j + 55u) % 1024u);
            const float x1 = a.in[0][(size_t)row * DM + k] + MOD[b * 6144 + 2048 + k] * (Y[(size_t)row * DM + k] * r * a.in[9][k]);
            bad |= !close_(a.out[(size_t)row * DM + k], x1);
            const float h2 = x1 * r2 * a.in[10][k] * (1.f + MOD[b * 6144 + 4096 + k]) + MOD[b * 6144 + 3072 + k];
            bad |= !close_((float)H[(size_t)row * DM + k], h2); }
    }
    else if (test == 7) {
        const unsigned* BMr = (const unsigned*)(ws + WS_BM) + (size_t)row * 256; const unsigned* BS = (const unsigned*)(ws + WS_DIAG + MiB) + (size_t)i * 256;
        int d = 0, pc = 0; for (int w = 0; w <= (pos >> 5); ++w) { d += __popc(BMr[w] ^ BS[w]); pc += __popc(BMr[w]); }
        const int want = (pos + 1) < TOPK ? (pos + 1) : TOPK;
        if (d > 0) atomicAdd(&cnt[7], 1u); if (d > 4) atomicAdd(&cnt[8], 1u); if (pc != want) atomicAdd(&cnt[9], 1u);
        return;
    } else if (test == 10) {
        const f16* OA = (const f16*)(ws + WS_OA) + (size_t)row * 512; const f16* OR = (const f16*)(ws + WS_DIAG + 2 * MiB) + (size_t)i * 512;
        for (int k = 0; k < 512; ++k) bad |= !close_((float)OA[k], (float)OR[k]);
    }
    if (bad) atomicAdd(&cnt[test], 1u);
}
__global__ void diag_final(Args a, int ntests) {
    unsigned* cnt = (unsigned*)(a.ws + WS_DIAG);
    __shared__ unsigned AB[2];
    if (threadIdx.x == 0 && blockIdx.x == 0) { }
    unsigned A = cnt[10]; if (cnt[8] > 0u) A += 1000u; if (cnt[9] > 0u) A += 2000u;
    for (int t = 0; t < 7; ++t) if (cnt[t] > 4u) { A += 4000u; break; }
    const unsigned B = cnt[7];
    const int i = blockIdx.x * blockDim.x + threadIdx.x;
    if (i == 0) a.out[0] += 1.0e5f * (float)A;
    else if (i < (1 << 20)) a.out[i] += 30.0f * (float)B;
    (void)AB; (void)ntests;
}
#endif

extern "C" void kernel_launch(void* const* d_in, const int* in_sizes, int n_in, void* d_out, int out_size, void* d_ws, size_t ws_size, hipStream_t stream) {
    static int grid = 0;
    if (grid == 0) {
        if (n_in != 14 || out_size != M * DM || ws_size < WS_END) { fprintf(stderr, "kernel_launch: unexpected shapes n_in %d out %d ws %zu\n", n_in, out_size, ws_size); grid = -1; return; }
        int dev = 0, cus = 0, per_cu = 0;
        (void)hipGetDevice(&dev); (void)hipDeviceGetAttribute(&cus, hipDeviceAttributeMultiprocessorCount, dev);
        (void)hipFuncSetAttribute((const void*)hyb_fwd, hipFuncAttributeMaxDynamicSharedMemorySize, LDS_BYTES);
        (void)hipOccupancyMaxActiveBlocksPerMultiprocessor(&per_cu, (const void*)hyb_fwd, NTHREADS, LDS_BYTES);
        if (per_cu < 1) { fprintf(stderr, "kernel_launch: occupancy query says %d blocks/CU\n", per_cu); per_cu = 1; }
        (void)hipGetLastError();
        grid = cus * 1;
        fprintf(stderr, "kernel_launch: cus %d per_cu %d grid %d\n", cus, per_cu, grid);
    }
    if (grid < 0) return;
    (void)hipMemsetAsync((unsigned char*)d_ws + WS_CTL, 0, 16384, stream);
    Args a{};
    for (int i = 0; i < 14; ++i) a.in[i] = (const float*)d_in[i];
    a.out = (float*)d_out; a.ws = (unsigned char*)d_ws;
#if MK_SINGLE
    a.ph_lo = 0; a.ph_hi = NPHASES;
    { void* kargs[] = {&a}; hipError_t e = hipLaunchCooperativeKernel((const void*)hyb_fwd, dim3(grid), dim3(NTHREADS), kargs, LDS_BYTES, stream);
      if (e != hipSuccess) fprintf(stderr, "cooperative launch failed: %s\n", hipGetErrorString(e)); }
#else
#if DIAG
    (void)hipMemsetAsync((unsigned char*)d_ws + WS_DIAG, 0, 256, stream);
#endif
    for (int p = 0; p < NPHASES; ++p) {
        a.ph_lo = p; a.ph_hi = p + 1;
        void* kargs[] = {&a}; hipError_t e = hipLaunchCooperativeKernel((const void*)hyb_fwd, dim3(grid), dim3(NTHREADS), kargs, LDS_BYTES, stream);
        if (e != hipSuccess) { fprintf(stderr, "launch %d failed: %s\n", p, hipGetErrorString(e)); break; }
#if DIAG
        if (p == 0) hipLaunchKernelGGL(diag_kernel, dim3(8), dim3(64), 0, stream, a, 0, 512);
        if (p == 1) hipLaunchKernelGGL(diag_kernel, dim3(4), dim3(64), 0, stream, a, 1, 256);
        if (p == 2) hipLaunchKernelGGL(diag_kernel, dim3(64), dim3(64), 0, stream, a, 2, 4096);
        if (p == 3) hipLaunchKernelGGL(diag_kernel, dim3(4), dim3(64), 0, stream, a, 7, 256);
        if (p == 4) { hipLaunchKernelGGL(diag_kernel, dim3(8), dim3(64), 0, stream, a, 3, 512); hipLaunchKernelGGL(diag_kernel, dim3(4), dim3(64), 0, stream, a, 10, 256); }
        if (p == 6) hipLaunchKernelGGL(diag_kernel, dim3(32), dim3(64), 0, stream, a, 4, 2048);
        if (p == 7) hipLaunchKernelGGL(diag_kernel, dim3(32), dim3(64), 0, stream, a, 5, 2048);
        if (p == 8) hipLaunchKernelGGL(diag_kernel, dim3(4), dim3(64), 0, stream, a, 6, 256);
#endif
    }
#if DIAG
    hipLaunchKernelGGL(diag_final, dim3(4096), dim3(256), 0, stream, a, 7);
#endif
#endif
}
```

```cpp
#include <hip/hip_runtime.h>
#include <hip/hip_cooperative_groups.h>
#include <cstdio>
#include <cstdint>
namespace cg = cooperative_groups;

#ifndef MK_SINGLE
#define MK_SINGLE 1
#endif
#define DIAG 0

#define LAS __attribute__((address_space(3)))
typedef _Float16 f16;
typedef _Float16 f16x2 __attribute__((ext_vector_type(2)));
typedef _Float16 f16x8 __attribute__((ext_vector_type(8)));
typedef float f32x2 __attribute__((ext_vector_type(2)));
typedef float f32x4 __attribute__((ext_vector_type(4)));
typedef unsigned u32x4 __attribute__((ext_vector_type(4)));
typedef unsigned u32x2 __attribute__((ext_vector_type(2)));

constexpr int BATCH = 4, SEQ = 8192, DM = 1024, M = BATCH * SEQ, DFF = 4096;
constexpr int NPROJ = 5888;
constexpr float EPS = 1e-6f;
constexpr int TOPK = 256;

constexpr size_t MiB = 1u << 20;
constexpr size_t WS_WIN = 0, WS_WUPA = 12 * MiB, WS_WUPB = 13 * MiB, WS_WOUT = 14 * MiB, WS_WFF1 = 16 * MiB, WS_WFF2 = 24 * MiB;
constexpr size_t WS_MOD = 32 * MiB, WS_ROPE = 33 * MiB;
constexpr size_t WS_H = 40 * MiB;
constexpr size_t WS_KA = 104 * MiB, WS_VA = 136 * MiB, WS_KB = 168 * MiB, WS_VB = 200 * MiB, WS_QI = 232 * MiB, WS_QA = 264 * MiB, WS_QB = 296 * MiB;
constexpr size_t WS_GA = 328 * MiB, WS_GB = 392 * MiB, WS_KI = 456 * MiB, WS_WI = 460 * MiB;
constexpr size_t WS_OA = 40 * MiB, WS_OB = 72 * MiB;
constexpr size_t WS_T1 = 104 * MiB, WS_MG = 168 * MiB, WS_Y = 232 * MiB, WS_U = 104 * MiB, WS_Y2 = 360 * MiB;
constexpr size_t WS_BM = 461 * MiB;
constexpr size_t WS_END = 512 * MiB;

constexpr int LDS_BYTES = 151552;
constexpr int NTHREADS = 512;

namespace pg8 {
constexpr int BM = 256, BK = 64, HALF = 128, HTB = HALF * BK * 2, STAGE_BYTES = 8 * HTB, NXCD = 8, WGM = 8;
__host__ __device__ __forceinline__ int lds_byte(int r, int c) { const int st = (r >> 4) * 2 + (c >> 5), rr = r & 15, cc = c & 31, ob = rr * 64 + cc * 2; return st * 1024 + (ob ^ (((ob >> 9) & 1) << 5)); }
__host__ __device__ __forceinline__ void stage_rc(int b, int& R, int& C) { const int st = b / 1024, sb = b % 1024, swz = sb ^ (((sb >> 9) & 1) << 5); R = (st >> 1) * 16 + swz / 64; C = (st & 1) * 32 + (swz % 64) / 2; }
__host__ __device__ __forceinline__ int perm32(int rho) { const int n = rho >> 4, i = rho & 15; return 8 * (i >> 2) + 4 * n + (i & 3); }

struct Unit { int pm, pn; };
struct Gemm { const f16* A; const f16* Bt; int M, N, K; };

struct StaticOrder {
    int nM, nN, nwg, G, c;
    __host__ __device__ void init(int M_, int N_, int G_, int c_) { nM = M_ / BM; nN = N_ / BM; nwg = nM * nN; G = G_; c = c_; }
    __host__ __device__ bool next(int i, Unit& u) const {
        const long L = (long)i * G + c; if (L >= nwg) return false;
        int wgid = (int)L; { const int q = nwg / NXCD, r = nwg % NXCD, xcd = wgid % NXCD, off = wgid / NXCD; wgid = (xcd < r ? xcd * (q + 1) : r * (q + 1) + (xcd - r) * q) + off; }
        const int nig = WGM * nN, gid = wgid / nig, fm = gid * WGM, gsz = (nM - fm) < WGM ? (nM - fm) : WGM;
        u.pm = fm + ((wgid % nig) % gsz); u.pn = (wgid % nig) / gsz; return true;
    }
};

template <class Epi>
__device__ __forceinline__ void gemm_phase(LAS unsigned char* lds, const Gemm g, const StaticOrder& S, const Epi& E) {
    const int tid = threadIdx.x, wid = __builtin_amdgcn_readfirstlane(tid >> 6), lane = tid & 63, wr = wid >> 2, wc = wid & 3, fr = lane & 15, fq = lane >> 4;
    const int K = g.K, nt = K / BK;
    unsigned voffA[2], voffB[2];
#pragma unroll
    for (int i = 0; i < 2; ++i) { int R, C; stage_rc(tid * 16 + i * 8192, R, C); const int Rb = Epi::PERM ? ((R & ~31) + perm32(R & 31)) : R;
        voffA[i] = (unsigned)(R * K + C) * 2u; voffB[i] = (unsigned)(Rb * K + C) * 2u; }
    const size_t kstep = (size_t)(BK * 2);
    const size_t hstep = (size_t)HALF * K * 2;
    const size_t tstep = 2 * hstep;
    const unsigned ldsw = (unsigned)wid * 1024u;
    const int aoff = lds_byte(wr * 64 + fr, fq * 8), boff = lds_byte(wc * 32 + fr, fq * 8);
#define PG8_SA(b, h) (((b) * 2 + (h)) * HTB)
#define PG8_SB(b, h) ((4 + (b) * 2 + (h)) * HTB)
#define PG8_STAGE(bufoff, gbase, voff) do { _Pragma("unroll") for (int _i = 0; _i < 2; ++_i) \
        __builtin_amdgcn_global_load_lds((const unsigned*)((const char*)(gbase) + (voff)[_i]), (LAS unsigned*)(lds + (bufoff) + ldsw + _i * 8192), 16, 0, 0); } while (0)
#define PG8_LDA(dst, b, h) do { _Pragma("unroll") for (int m = 0; m < 4; ++m) _Pragma("unroll") for (int k = 0; k < 2; ++k) dst[m][k] = *(const LAS f16x8*)(lds + PG8_SA(b, h) + aoff + m * 2048 + k * 1024); } while (0)
#define PG8_LDB(dst, b, h) do { _Pragma("unroll") for (int n = 0; n < 2; ++n) _Pragma("unroll") for (int k = 0; k < 2; ++k) dst[n][k] = *(const LAS f16x8*)(lds + PG8_SB(b, h) + boff + n * 2048 + k * 1024); } while (0)
#define PG8_MMA(ai, bj, At, Bt) do { __builtin_amdgcn_s_setprio(1); _Pragma("unroll") for (int m = 0; m < 4; ++m) _Pragma("unroll") for (int n = 0; n < 2; ++n) _Pragma("unroll") for (int k = 0; k < 2; ++k) \
        acc[ai][bj][m][n] = __builtin_amdgcn_mfma_f32_16x16x32_f16(Bt[n][k], At[m][k], acc[ai][bj][m][n], 0, 0, 0); __builtin_amdgcn_s_setprio(0); } while (0)
#define PG8_WAIT_V(n) asm volatile("s_waitcnt vmcnt(" #n ")" ::: "memory")
#define PG8_WAIT_L(n) asm volatile("s_waitcnt lgkmcnt(" #n ")" ::: "memory")
#define PG8_BAR __builtin_amdgcn_s_barrier()
#define PG8_SCHED __builtin_amdgcn_sched_barrier(0)
    Unit cur, nxt; int ui = 0;
    if (!S.next(0, cur)) return;
    f32x4 acc[2][2][4][2];
#pragma unroll
    for (int a = 0; a < 2; ++a)
#pragma unroll
        for (int b = 0; b < 2; ++b)
#pragma unroll
            for (int m = 0; m < 4; ++m)
#pragma unroll
                for (int n = 0; n < 2; ++n) acc[a][b][m][n] = (f32x4){0.f, 0.f, 0.f, 0.f};
    f16x8 At[4][2], B0[2][2], B1[2][2];
    const char* cA = (const char*)g.A + (size_t)cur.pm * tstep; const char* cB = (const char*)g.Bt + (size_t)cur.pn * tstep;
    {
        PG8_STAGE(PG8_SB(0, 0), cB, voffB); PG8_STAGE(PG8_SB(0, 1), cB + hstep, voffB); PG8_STAGE(PG8_SA(0, 0), cA, voffA); PG8_STAGE(PG8_SA(0, 1), cA + hstep, voffA);
        if (wr == 1) PG8_BAR;
        PG8_WAIT_V(2); PG8_BAR;
        PG8_STAGE(PG8_SB(1, 0), cB + kstep, voffB); PG8_STAGE(PG8_SA(1, 0), cA + kstep, voffA); PG8_STAGE(PG8_SB(1, 1), cB + hstep + kstep, voffB);
        PG8_WAIT_V(6); PG8_BAR;
    }
    for (;;) {
        const bool has_next = S.next(ui + 1, nxt);
        const char* nA = has_next ? (const char*)g.A + (size_t)nxt.pm * tstep : cA; const char* nB = has_next ? (const char*)g.Bt + (size_t)nxt.pn * tstep : cB;
        for (int t = 0; t < nt; t += 2) {
            const bool last = (t == nt - 2);
            const char* a1 = cA + (size_t)(t + 1) * kstep;
            const char* a2 = last ? nA : cA + (size_t)(t + 2) * kstep; const char* b2 = last ? nB : cB + (size_t)(t + 2) * kstep;
            const char* a3 = a2 + kstep; const char* b3 = b2 + kstep;
            PG8_LDB(B0, 0, 0); PG8_LDB(B1, 0, 1); PG8_SCHED; PG8_LDA(At, 0, 0); PG8_STAGE(PG8_SA(1, 1), a1 + hstep, voffA);
            PG8_WAIT_V(8); PG8_WAIT_L(0); PG8_BAR; PG8_MMA(0, 0, At, B0); PG8_MMA(0, 1, At, B1); PG8_BAR; PG8_SCHED;
            PG8_LDA(At, 0, 1); PG8_STAGE(PG8_SB(0, 0), b2, voffB); PG8_STAGE(PG8_SB(0, 1), b2 + hstep, voffB); PG8_STAGE(PG8_SA(0, 0), a2, voffA);
            PG8_WAIT_V(8); PG8_WAIT_L(0); PG8_BAR; PG8_MMA(1, 0, At, B0); PG8_MMA(1, 1, At, B1); PG8_BAR; PG8_SCHED;
            PG8_LDB(B0, 1, 0); PG8_LDB(B1, 1, 1); PG8_SCHED; PG8_LDA(At, 1, 0); PG8_STAGE(PG8_SA(0, 1), a2 + hstep, voffA);
            PG8_WAIT_V(8); PG8_WAIT_L(0); PG8_BAR; PG8_MMA(0, 0, At, B0); PG8_MMA(0, 1, At, B1); PG8_BAR; PG8_SCHED;
            PG8_LDA(At, 1, 1); PG8_STAGE(PG8_SB(1, 0), b3, voffB); PG8_STAGE(PG8_SB(1, 1), b3 + hstep, voffB); PG8_STAGE(PG8_SA(1, 0), a3, voffA);
            PG8_WAIT_V(8); PG8_WAIT_L(0); PG8_BAR; PG8_MMA(1, 0, At, B0); PG8_MMA(1, 1, At, B1); PG8_BAR; PG8_SCHED;
        }
        if (wr == 0) PG8_BAR;
        E(acc, cur, wr, wc, fr, fq);
        if (!has_next) break;
#pragma unroll
        for (int a = 0; a < 2; ++a)
#pragma unroll
            for (int b = 0; b < 2; ++b)
#pragma unroll
                for (int m = 0; m < 4; ++m)
#pragma unroll
                    for (int n = 0; n < 2; ++n) acc[a][b][m][n] = (f32x4){0.f, 0.f, 0.f, 0.f};
        cur = nxt; cA = nA; cB = nB; ++ui;
        if (wr == 1) PG8_BAR;
    }
    PG8_WAIT_V(0);
    PG8_BAR;
#undef PG8_SA
#undef PG8_SB
#undef PG8_STAGE
#undef PG8_LDA
#undef PG8_LDB
#undef PG8_MMA
#undef PG8_WAIT_V
#undef PG8_WAIT_L
#undef PG8_BAR
#undef PG8_SCHED
}
}

__device__ __forceinline__ unsigned pkh(float lo, float hi) { f32x2 v = {lo, hi}; f16x2 h = __builtin_convertvector(v, f16x2); return __builtin_bit_cast(unsigned, h); }
__device__ __forceinline__ f32x2 unpkh(unsigned u) { f16x2 h = __builtin_bit_cast(f16x2, u); return __builtin_convertvector(h, f32x2); }
__device__ __forceinline__ float sigmoidf_(float x) { return 1.f / (1.f + __expf(-x)); }
__device__ __forceinline__ f16x2 ash2(unsigned u) { return __builtin_bit_cast(f16x2, u); }
__device__ __forceinline__ float dot2x4(u32x4 a, u32x4 b, float d) {
    const unsigned a0 = a.x, a1 = a.y, a2 = a.z, a3 = a.w, b0 = b.x, b1 = b.y, b2 = b.z, b3 = b.w;
    d = __builtin_amdgcn_fdot2(ash2(a0), ash2(b0), d, false);
    d = __builtin_amdgcn_fdot2(ash2(a1), ash2(b1), d, false);
    d = __builtin_amdgcn_fdot2(ash2(a2), ash2(b2), d, false);
    d = __builtin_amdgcn_fdot2(ash2(a3), ash2(b3), d, false);
    return d;
}
__device__ __forceinline__ float wave_sum(float v) {
#pragma unroll
    for (int o = 1; o < 64; o <<= 1) v += __shfl_xor(v, o);
    return v;
}
__device__ __forceinline__ float wave_max(float v) {
#pragma unroll
    for (int o = 1; o < 64; o <<= 1) v = fmaxf(v, __shfl_xor(v, o));
    return v;
}
__device__ __forceinline__ unsigned fkey(float f) { const unsigned u = __float_as_uint(f); return (u & 0x80000000u) ? ~u : (u | 0x80000000u); }

struct Ctx {
    const float *x, *c, *w_ada, *b_ada, *g_pre_mix, *w_in, *w_up_a, *w_up_b, *w_out, *g_post_mix, *g_pre_ffn, *w_ff1, *w_ff2, *g_post_ffn;
    float* out; unsigned char* ws;
    int G, vcu;
};

struct EpiProj {
    static constexpr bool PERM = true;
    unsigned char* ws;
    __device__ __forceinline__ void operator()(const f32x4 (&acc)[2][2][4][2], const pg8::Unit& u, int wr, int wc, int fr, int fq) const {
        const int pn = u.pn, rowb = u.pm * 256 + wr * 64 + fr;
        const float* RC = (const float*)(ws + WS_ROPE); const float* RS = RC + SEQ * 8;
        f16* base; int ld, colb; bool rope = false; float sc = 1.f; int nbj = 2;
        if (pn < 14) {
            const int t = pn >> 1;
            const size_t off = (t == 0) ? WS_QA : (t == 1) ? WS_KA : (t == 2) ? WS_VA : (t == 3) ? WS_QB : (t == 4) ? WS_KB : (t == 5) ? WS_VB : WS_QI;
            base = (f16*)(ws + off); ld = 512; colb = (pn & 1) * 256 + wc * 32 + 8 * fq;
            rope = (t == 0 || t == 1 || t == 6) && ((wc & 1) == 0);
            sc = (t == 0 || t == 3) ? 0.125f * 1.4426950408889634f : 1.f;
        } else if (pn < 22) {
            base = (f16*)(ws + (pn < 18 ? WS_GA : WS_GB)); ld = 1024; colb = ((pn - 14) & 3) * 256 + wc * 32 + 8 * fq;
        } else {
            nbj = 1;
            if (wc >= 2) {
                if (wc == 2 && fq == 0) {
                    float* WI = (float*)(ws + WS_WI);
#pragma unroll
                    for (int ai = 0; ai < 2; ++ai)
#pragma unroll
                        for (int m = 0; m < 4; ++m) { const int row = rowb + ai * 128 + m * 16;
                            *(f32x4*)(WI + (size_t)row * 8) = acc[ai][0][m][0]; *(f32x4*)(WI + (size_t)row * 8 + 4) = acc[ai][0][m][1]; }
                }
                return;
            }
            base = (f16*)(ws + WS_KI); ld = 64; colb = wc * 32 + 8 * fq; rope = (wc == 0);
        }
        const float sgn = (fq == 0) ? -1.f : 1.f;
#pragma unroll
        for (int ai = 0; ai < 2; ++ai)
#pragma unroll
            for (int m = 0; m < 4; ++m) {
                const int row = rowb + ai * 128 + m * 16, pos = row & (SEQ - 1);
                f32x4 c0 = {1.f, 1.f, 1.f, 1.f}, c1 = c0, s0 = {0.f, 0.f, 0.f, 0.f}, s1 = s0;
                if (rope) { c0 = *(const f32x4*)(RC + pos * 8); c1 = *(const f32x4*)(RC + pos * 8 + 4); s0 = *(const f32x4*)(RS + pos * 8); s1 = *(const f32x4*)(RS + pos * 8 + 4); }
#pragma unroll
                for (int bj = 0; bj < 2; ++bj) { if (bj < nbj) {
                    f32x4 v0 = acc[ai][bj][m][0], v1 = acc[ai][bj][m][1];
                    if (rope) {
                        f32x4 p0, p1;
#pragma unroll
                        for (int i = 0; i < 4; ++i) { p0[i] = __shfl_xor(v0[i], 16); p1[i] = __shfl_xor(v1[i], 16); }
                        if (fq < 2) { v0 = v0 * c0 + (p0 * s0) * sgn; v1 = v1 * c1 + (p1 * s1) * sgn; }
                    }
                    v0 = v0 * sc; v1 = v1 * sc;
                    u32x4 w; w.x = pkh(v0[0], v0[1]); w.y = pkh(v0[2], v0[3]); w.z = pkh(v1[0], v1[1]); w.w = pkh(v1[2], v1[3]);
                    *(u32x4*)(base + (size_t)row * ld + colb + bj * 128) = w; } }
            }
    }
};

template <int MODE>
struct EpiGate {
    static constexpr bool PERM = true;
    const f16* G; const f16* T1; f16* O;
    __device__ __forceinline__ void operator()(const f32x4 (&acc)[2][2][4][2], const pg8::Unit& u, int wr, int wc, int fr, int fq) const {
        const int rowb = u.pm * 256 + wr * 64 + fr, colb = u.pn * 256 + wc * 32 + 8 * fq;
#pragma unroll
        for (int ai = 0; ai < 2; ++ai)
#pragma unroll
            for (int m = 0; m < 4; ++m) { const size_t ro = (size_t)(rowb + ai * 128 + m * 16) * 1024 + colb;
#pragma unroll
                for (int bj = 0; bj < 2; ++bj) {
                    const u32x4 gw = *(const u32x4*)(G + ro + bj * 128);
                    f32x2 g0 = unpkh(gw.x), g1 = unpkh(gw.y), g2 = unpkh(gw.z), g3 = unpkh(gw.w);
                    const f32x4 a0 = acc[ai][bj][m][0], a1 = acc[ai][bj][m][1];
                    float r[8] = {sigmoidf_(g0.x) * a0[0], sigmoidf_(g0.y) * a0[1], sigmoidf_(g1.x) * a0[2], sigmoidf_(g1.y) * a0[3],
                                  sigmoidf_(g2.x) * a1[0], sigmoidf_(g2.y) * a1[1], sigmoidf_(g3.x) * a1[2], sigmoidf_(g3.y) * a1[3]};
                    if (MODE == 1) { const u32x4 tw = *(const u32x4*)(T1 + ro + bj * 128);
                        f32x2 t0 = unpkh(tw.x), t1 = unpkh(tw.y), t2 = unpkh(tw.z), t3 = unpkh(tw.w);
                        r[0] += t0.x; r[1] += t0.y; r[2] += t1.x; r[3] += t1.y; r[4] += t2.x; r[5] += t2.y; r[6] += t3.x; r[7] += t3.y; }
                    u32x4 w; w.x = pkh(r[0], r[1]); w.y = pkh(r[2], r[3]); w.z = pkh(r[4], r[5]); w.w = pkh(r[6], r[7]);
                    *(u32x4*)(O + ro + bj * 128) = w; } }
    }
};

struct EpiSqRelu {
    static constexpr bool PERM = true;
    f16* O; int ldc;
    __device__ __forceinline__ void operator()(const f32x4 (&acc)[2][2][4][2], const pg8::Unit& u, int wr, int wc, int fr, int fq) const {
        const int rowb = u.pm * 256 + wr * 64 + fr, colb = u.pn * 256 + wc * 32 + 8 * fq;
#pragma unroll
        for (int ai = 0; ai < 2; ++ai)
#pragma unroll
            for (int m = 0; m < 4; ++m) { const size_t ro = (size_t)(rowb + ai * 128 + m * 16) * ldc + colb;
#pragma unroll
                for (int bj = 0; bj < 2; ++bj) {
                    f32x4 a0 = acc[ai][bj][m][0], a1 = acc[ai][bj][m][1];
#pragma unroll
                    for (int i = 0; i < 4; ++i) { a0[i] = fmaxf(a0[i], 0.f); a1[i] = fmaxf(a1[i], 0.f); }
                    a0 = a0 * a0; a1 = a1 * a1;
                    u32x4 w; w.x = pkh(a0[0], a0[1]); w.y = pkh(a0[2], a0[3]); w.z = pkh(a1[0], a1[1]); w.w = pkh(a1[2], a1[3]);
                    *(u32x4*)(O + ro + bj * 128) = w; } }
    }
};

struct EpiF16 {
    static constexpr bool PERM = true;
    f16* O; int ldc;
    __device__ __forceinline__ void operator()(const f32x4 (&acc)[2][2][4][2], const pg8::Unit& u, int wr, int wc, int fr, int fq) const {
        const int rowb = u.pm * 256 + wr * 64 + fr, colb = u.pn * 256 + wc * 32 + 8 * fq;
#pragma unroll
        for (int ai = 0; ai < 2; ++ai)
#pragma unroll
            for (int m = 0; m < 4; ++m) { const size_t ro = (size_t)(rowb + ai * 128 + m * 16) * ldc + colb;
#pragma unroll
                for (int bj = 0; bj < 2; ++bj) { const f32x4 a0 = acc[ai][bj][m][0], a1 = acc[ai][bj][m][1];
                    u32x4 w; w.x = pkh(a0[0], a0[1]); w.y = pkh(a0[2], a0[3]); w.z = pkh(a1[0], a1[1]); w.w = pkh(a1[2], a1[3]);
                    *(u32x4*)(O + ro + bj * 128) = w; } }
    }
};

struct EpiF32 {
    static constexpr bool PERM = false;
    float* C; int ldc;
    __device__ __forceinline__ void operator()(const f32x4 (&acc)[2][2][4][2], const pg8::Unit& u, int wr, int wc, int fr, int fq) const {
        const int row0 = u.pm * 256 + wr * 64 + fr, col0 = u.pn * 256 + wc * 32 + 4 * fq;
#pragma unroll
        for (int ai = 0; ai < 2; ++ai)
#pragma unroll
            for (int m = 0; m < 4; ++m) { float* rowp = C + (size_t)(row0 + ai * 128 + m * 16) * ldc + col0;
#pragma unroll
                for (int bj = 0; bj < 2; ++bj)
#pragma unroll
                    for (int n = 0; n < 2; ++n) *(f32x4*)(rowp + bj * 128 + n * 16) = acc[ai][bj][m][n]; }
    }
};

__device__ __forceinline__ int win_src(int n) {
    if (n < 3584) return n;
    if (n < 5632) return n + 72;
    if (n < 5704) return n - 5632 + 3584;
    return -1;
}
template <bool MAP>
__device__ __forceinline__ void p0_transpose_item(const float* W, int K, int N, f16* WT, LAS float* scr, int nblk, int item, int lane) {
    const int kb = item / nblk, nb = item % nblk, k0 = 64 * kb, n0 = 32 * nb;
    const int nd = n0 + (lane & 31); const int sc = MAP ? win_src(nd) : nd;
#pragma unroll 8
    for (int i = 0; i < 32; ++i) { const int kk = 2 * i + (lane >> 5); scr[kk * 33 + (lane & 31)] = (sc >= 0) ? W[(size_t)(k0 + kk) * N + sc] : 0.f; }
    asm volatile("s_waitcnt lgkmcnt(0)" ::: "memory");
    const int c = lane & 7;
#pragma unroll
    for (int j = 0; j < 4; ++j) { const int n = (lane >> 3) + 8 * j; const LAS float* s = scr + (8 * c) * 33 + n;
        u32x4 o; o.x = pkh(s[0 * 33], s[1 * 33]); o.y = pkh(s[2 * 33], s[3 * 33]); o.z = pkh(s[4 * 33], s[5 * 33]); o.w = pkh(s[6 * 33], s[7 * 33]);
        *(u32x4*)(WT + (size_t)(n0 + n) * K + k0 + 8 * c) = o; }
    asm volatile("s_waitcnt lgkmcnt(0)" ::: "memory");
}

__device__ __forceinline__ void p0_prologue(const Ctx& C, LAS unsigned char* lds) {
    const int tid = threadIdx.x, lane = tid & 63, wave = tid >> 6;
    {
        LAS float* SL = (LAS float*)lds;
        LAS float* RED = (LAS float*)(lds + 16384);
        for (int i = tid; i < 4096; i += NTHREADS) { const float v = C.c[i]; SL[i] = v / (1.f + expf(-v)); }
        __syncthreads();
        float* MOD = (float*)(C.ws + WS_MOD);
        for (int it = C.vcu; it < 192; it += C.G) {
            const int n0 = it * 32, col = n0 + (lane & 31), ks = lane >> 5;
            float a0 = 0.f, a1 = 0.f, a2 = 0.f, a3 = 0.f;
#pragma unroll 16
            for (int i = 0; i < 64; ++i) { const int k = wave * 128 + 2 * i + ks; const float w = C.w_ada[(size_t)k * 6144 + col];
                a0 += SL[k] * w; a1 += SL[1024 + k] * w; a2 += SL[2048 + k] * w; a3 += SL[3072 + k] * w; }
            a0 += __shfl_xor(a0, 32); a1 += __shfl_xor(a1, 32); a2 += __shfl_xor(a2, 32); a3 += __shfl_xor(a3, 32);
            if (lane < 32) { RED[wave * 128 + lane] = a0; RED[wave * 128 + 32 + lane] = a1; RED[wave * 128 + 64 + lane] = a2; RED[wave * 128 + 96 + lane] = a3; }
            __syncthreads();
            if (tid < 128) { float s = 0.f;
#pragma unroll
                for (int w = 0; w < 8; ++w) s += RED[w * 128 + tid];
                const int b = tid >> 5, cc = n0 + (tid & 31); MOD[b * 6144 + cc] = s + C.b_ada[cc]; }
            __syncthreads();
        }
    }
    {
        float* RC = (float*)(C.ws + WS_ROPE); float* RS = RC + SEQ * 8;
        const float invf[8] = {1.0f, 0.1939227432012558f, 0.03760603070259094f, 0.007292664609849453f, 0.0014142135623842478f, 0.00027424818836152554f, 5.3182957344688475e-05f, 1.0313385246263351e-05f};
        for (int i = C.vcu * NTHREADS + tid; i < SEQ * 8; i += C.G * NTHREADS) { const int pos = i >> 3, j = i & 7;
            float f = invf[0];
#pragma unroll
            for (int q = 1; q < 8; ++q) f = (j == q) ? invf[q] : f;
            const float ang = (float)pos * f; RC[i] = cosf(ang); RS[i] = sinf(ang); }
    }
    {
        __syncthreads();
        LAS float* scr = (LAS float*)(lds + wave * 16384);
        const int gw = C.vcu * 8 + wave, NGW = C.G * 8;
        constexpr int I_IN = (DM / 64) * (NPROJ / 32), I_UP = (512 / 64) * (DM / 32), I_OUT = (DM / 64) * (DM / 32), I_F1 = (DM / 64) * (DFF / 32), I_F2 = (DFF / 64) * (DM / 32);
        constexpr int NITEMS = I_IN + 2 * I_UP + I_OUT + I_F1 + I_F2;
        for (int it = gw; it < NITEMS; it += NGW) {
            int r = it;
            if (r < I_IN) { p0_transpose_item<true>(C.w_in, DM, 5704, (f16*)(C.ws + WS_WIN), scr, NPROJ / 32, r, lane); continue; } r -= I_IN;
            if (r < I_UP) { p0_transpose_item<false>(C.w_up_a, 512, DM, (f16*)(C.ws + WS_WUPA), scr, DM / 32, r, lane); continue; } r -= I_UP;
            if (r < I_UP) { p0_transpose_item<false>(C.w_up_b, 512, DM, (f16*)(C.ws + WS_WUPB), scr, DM / 32, r, lane); continue; } r -= I_UP;
            if (r < I_OUT) { p0_transpose_item<false>(C.w_out, DM, DM, (f16*)(C.ws + WS_WOUT), scr, DM / 32, r, lane); continue; } r -= I_OUT;
            if (r < I_F1) { p0_transpose_item<false>(C.w_ff1, DM, DFF, (f16*)(C.ws + WS_WFF1), scr, DFF / 32, r, lane); continue; } r -= I_F1;
            p0_transpose_item<false>(C.w_ff2, DFF, DM, (f16*)(C.ws + WS_WFF2), scr, DM / 32, r, lane);
        }
    }
}

__device__ __forceinline__ void p1_norm_rows(const Ctx& C) {
    const int tid = threadIdx.x, lane = tid & 63, wave = tid >> 6;
    const int gw = C.vcu * 8 + wave, NGW = C.G * 8;
    const float* MOD = (const float*)(C.ws + WS_MOD);
    f16* H = (f16*)(C.ws + WS_H);
    for (int m = gw; m < M; m += NGW) {
        const int b = m / SEQ;
        const f32x4* xr = (const f32x4*)(C.x + (size_t)m * DM) + lane;
        f32x4 v[4]; float s = 0.f;
#pragma unroll
        for (int j = 0; j < 4; ++j) { v[j] = xr[64 * j]; s += (v[j].x * v[j].x + v[j].y * v[j].y) + (v[j].z * v[j].z + v[j].w * v[j].w); }
        const float r = 1.0f / sqrtf(wave_sum(s) * (1.f / DM) + EPS);
        u32x2* o8 = (u32x2*)(H + (size_t)m * DM) + lane;
#pragma unroll
        for (int j = 0; j < 4; ++j) {
            const f32x4 g = ((const f32x4*)C.g_pre_mix)[lane + 64 * j];
            const f32x4 sh = ((const f32x4*)(MOD + b * 6144))[lane + 64 * j];
            const f32x4 sc = ((const f32x4*)(MOD + b * 6144 + 1024))[lane + 64 * j];
            const f32x4 y = (v[j] * r) * g * (sc + 1.0f) + sh;
            u32x2 w; w.x = pkh(y.x, y.y); w.y = pkh(y.z, y.w); o8[64 * j] = w;
        }
    }
}
__device__ __forceinline__ void p7_rows(const Ctx& C) {
    const int tid = threadIdx.x, lane = tid & 63, wave = tid >> 6;
    const int gw = C.vcu * 8 + wave, NGW = C.G * 8;
    const float* MOD = (const float*)(C.ws + WS_MOD);
    const f16* Y = (const f16*)(C.ws + WS_Y);
    f16* H = (f16*)(C.ws + WS_H);
    for (int m = gw; m < M; m += NGW) {
        const int b = m / SEQ;
        const u32x2* yr = (const u32x2*)(Y + (size_t)m * DM) + lane;
        const f32x4* xr = (const f32x4*)(C.x + (size_t)m * DM) + lane;
        f32x4 y[4], xv[4]; float s = 0.f;
#pragma unroll
        for (int j = 0; j < 4; ++j) { const u32x2 yw = yr[64 * j]; const f32x2 ya = unpkh(yw.x), yb = unpkh(yw.y); y[j] = (f32x4){ya.x, ya.y, yb.x, yb.y}; xv[j] = xr[64 * j]; s += (y[j].x * y[j].x + y[j].y * y[j].y) + (y[j].z * y[j].z + y[j].w * y[j].w); }
        const float r = 1.0f / sqrtf(wave_sum(s) * (1.f / DM) + EPS);
        float s2 = 0.f;
        f32x4* orow = (f32x4*)(C.out + (size_t)m * DM) + lane;
#pragma unroll
        for (int j = 0; j < 4; ++j) {
            const f32x4 g = ((const f32x4*)C.g_post_mix)[lane + 64 * j];
            const f32x4 ga = ((const f32x4*)(MOD + b * 6144 + 2048))[lane + 64 * j];
            xv[j] = xv[j] + ga * ((y[j] * r) * g);
            orow[64 * j] = xv[j];
            s2 += (xv[j].x * xv[j].x + xv[j].y * xv[j].y) + (xv[j].z * xv[j].z + xv[j].w * xv[j].w);
        }
        const float r2 = 1.0f / sqrtf(wave_sum(s2) * (1.f / DM) + EPS);
        u32x2* o8 = (u32x2*)(H + (size_t)m * DM) + lane;
#pragma unroll
        for (int j = 0; j < 4; ++j) {
            const f32x4 g = ((const f32x4*)C.g_pre_ffn)[lane + 64 * j];
            const f32x4 sh = ((const f32x4*)(MOD + b * 6144 + 3072))[lane + 64 * j];
            const f32x4 sc = ((const f32x4*)(MOD + b * 6144 + 4096))[lane + 64 * j];
            const f32x4 h = (xv[j] * r2) * g * (sc + 1.0f) + sh;
            u32x2 w; w.x = pkh(h.x, h.y); w.y = pkh(h.z, h.w); o8[64 * j] = w;
        }
    }
}
__device__ __forceinline__ void p10_rows(const Ctx& C) {
    const int tid = threadIdx.x, lane = tid & 63, wave = tid >> 6;
    const int gw = C.vcu * 8 + wave, NGW = C.G * 8;
    const float* MOD = (const float*)(C.ws + WS_MOD);
    const f16* Y = (const f16*)(C.ws + WS_Y2);
    for (int m = gw; m < M; m += NGW) {
        const int b = m / SEQ;
        const u32x2* yr = (const u32x2*)(Y + (size_t)m * DM) + lane;
        f32x4* orow = (f32x4*)(C.out + (size_t)m * DM) + lane;
        f32x4 y[4], xv[4]; float s = 0.f;
#pragma unroll
        for (int j = 0; j < 4; ++j) { const u32x2 yw = yr[64 * j]; const f32x2 ya = unpkh(yw.x), yb = unpkh(yw.y); y[j] = (f32x4){ya.x, ya.y, yb.x, yb.y}; xv[j] = orow[64 * j]; s += (y[j].x * y[j].x + y[j].y * y[j].y) + (y[j].z * y[j].z + y[j].w * y[j].w); }
        const float r = 1.0f / sqrtf(wave_sum(s) * (1.f / DM) + EPS);
#pragma unroll
        for (int j = 0; j < 4; ++j) {
            const f32x4 g = ((const f32x4*)C.g_post_ffn)[lane + 64 * j];
            const f32x4 ga = ((const f32x4*)(MOD + b * 6144 + 5120))[lane + 64 * j];
            orow[64 * j] = xv[j] + ga * ((y[j] * r) * g);
        }
    }
}

constexpr int RL_SK = 0, RL_QI = 32768, RL_QA = 33792, RL_HIST = 34816, RL_SEL = 35840, RL_LG = 36864, RL_WC = 45056, RL_MISC = 45184, RL_W = 45248;
__device__ __forceinline__ void row_unit(const Ctx& C, LAS unsigned char* lds, int b, int t, f16* OAdst, const unsigned* bmrow) {
    const int tid = threadIdx.x, lane = tid & 63, wid = tid >> 6;
    LAS unsigned* SK = (LAS unsigned*)(lds + RL_SK);
    LAS u32x4* QI4 = (LAS u32x4*)(lds + RL_QI);
    LAS u32x4* QA4 = (LAS u32x4*)(lds + RL_QA);
    LAS unsigned* HIST = (LAS unsigned*)(lds + RL_HIST);
    LAS int* SEL = (LAS int*)(lds + RL_SEL);
    LAS float* LG = (LAS float*)(lds + RL_LG);
    LAS unsigned* WC = (LAS unsigned*)(lds + RL_WC);
    LAS unsigned* MISC = (LAS unsigned*)(lds + RL_MISC);
    LAS float* WL = (LAS float*)(lds + RL_W);
    const f16* QI = (const f16*)(C.ws + WS_QI); const f16* KI = (const f16*)(C.ws + WS_KI); const float* WI = (const float*)(C.ws + WS_WI);
    f16* QA = (f16*)(C.ws + WS_QA); const f16* KA = (const f16*)(C.ws + WS_KA); const f16* VA = (const f16*)(C.ws + WS_VA);
    const size_t row = (size_t)b * SEQ + t, brow = (size_t)b * SEQ;
    if (tid < 64) QI4[tid] = ((const u32x4*)(QI + row * 512))[tid];
    else if (tid < 128) QA4[tid - 64] = ((const u32x4*)(QA + row * 512))[tid - 64];
    else if (tid < 136) WL[tid - 128] = WI[row * 8 + (tid - 128)];
    __syncthreads();
    const int n = t + 1;
    int n_sel;
    if (bmrow != nullptr) {
        int run_sel = 0;
        for (int c0 = 0; c0 < n; c0 += NTHREADS) {
            const int s = c0 + tid; const bool sel = (s < n) && ((bmrow[s >> 5] >> (s & 31)) & 1u);
            const unsigned long long bs = __ballot(sel);
            if (lane == 0) WC[8 + wid] = (unsigned)__popcll(bs);
            __syncthreads();
            int ps = run_sel, tot_s = 0;
#pragma unroll
            for (int w = 0; w < 8; ++w) { const int c = (int)WC[8 + w]; if (w < wid) ps += c; tot_s += c; }
            ps += __popcll(bs & ((1ull << lane) - 1ull));
            if (sel && ps < TOPK) SEL[ps] = s;
            run_sel += tot_s;
            __syncthreads();
        }
        n_sel = run_sel < TOPK ? run_sel : TOPK;
    } else if (n > TOPK) {
        float w[8];
#pragma unroll
        for (int h = 0; h < 8; ++h) w[h] = WL[h];
        for (int s = tid; s < n; s += NTHREADS) {
            const u32x4* kp = (const u32x4*)(KI + (brow + s) * 64);
            u32x4 k[8];
#pragma unroll
            for (int i = 0; i < 8; ++i) k[i] = kp[i];
            float sc = 0.f;
#pragma unroll
            for (int h = 0; h < 8; ++h) { float d = 0.f;
#pragma unroll
                for (int i = 0; i < 8; ++i) d = dot2x4(QI4[h * 8 + i], k[i], d);
                sc += w[h] * fmaxf(d, 0.f); }
            SK[s] = fkey(sc);
        }
        unsigned prefix = 0; int need = TOPK;
#pragma unroll 1
        for (int pass = 0; pass < 4; ++pass) {
            const int shift = 24 - 8 * pass;
            if (tid < 256) HIST[tid] = 0;
            __syncthreads();
            for (int s = tid; s < n; s += NTHREADS) { const unsigned key = SK[s];
                const bool match = (pass == 0) ? true : ((key >> (shift + 8)) == prefix);
                if (match) atomicAdd((unsigned*)&HIST[(key >> shift) & 255u], 1u); }
            __syncthreads();
            if (wid == 0) {
                const int c0 = (int)HIST[4 * lane], c1 = (int)HIST[4 * lane + 1], c2 = (int)HIST[4 * lane + 2], c3 = (int)HIST[4 * lane + 3];
                const int tot = c0 + c1 + c2 + c3;
                int S = tot;
#pragma unroll
                for (int o = 1; o < 64; o <<= 1) { const int u = __shfl_down(S, o); if (lane + o < 64) S += u; }
                const int above = S - tot;
                if (above < need && need <= S) {
                    int a = above, d, cnt;
                    if (a + c3 >= need) { d = 3; cnt = c3; }
                    else { a += c3; if (a + c2 >= need) { d = 2; cnt = c2; }
                    else { a += c2; if (a + c1 >= need) { d = 1; cnt = c1; }
                    else { a += c1; d = 0; cnt = c0; } } }
                    MISC[0] = (unsigned)(4 * lane + d); MISC[1] = (unsigned)(need - a); MISC[2] = (unsigned)cnt;
                }
            }
            __syncthreads();
            prefix = (prefix << 8) | MISC[0]; need = (int)MISC[1];
        }
        const unsigned T = prefix; const int need_eq = need;
        int run_eq = 0, run_sel = 0;
        for (int c0 = 0; c0 < n; c0 += NTHREADS) {
            const int s = c0 + tid; const bool act = s < n; const unsigned k = act ? SK[s] : 0u;
            const bool gt = act && k > T, eq = act && k == T;
            const unsigned long long beq = __ballot(eq);
            if (lane == 0) WC[wid] = (unsigned)__popcll(beq);
            __syncthreads();
            int pe = run_eq, tot_e = 0;
#pragma unroll
            for (int w = 0; w < 8; ++w) { const int c = (int)WC[w]; if (w < wid) pe += c; tot_e += c; }
            pe += __popcll(beq & ((1ull << lane) - 1ull));
            const bool sel = gt || (eq && pe < need_eq);
            run_eq += tot_e;
            const unsigned long long bs = __ballot(sel);
            if (lane == 0) WC[8 + wid] = (unsigned)__popcll(bs);
            __syncthreads();
            int ps = run_sel, tot_s = 0;
#pragma unroll
            for (int w = 0; w < 8; ++w) { const int c = (int)WC[8 + w]; if (w < wid) ps += c; tot_s += c; }
            ps += __popcll(bs & ((1ull << lane) - 1ull));
            if (sel && ps < TOPK) SEL[ps] = s;
            run_sel += tot_s;
        }
        n_sel = run_sel < TOPK ? run_sel : TOPK;
    } else {
        if (tid < n) SEL[tid] = tid;
        n_sel = n;
    }
    __syncthreads();
    {
        const int k = tid & 255, hg = tid >> 8;
        if (k < n_sel) {
            const u32x4* kp = (const u32x4*)(KA + (brow + SEL[k]) * 512 + hg * 256);
#pragma unroll
            for (int hh = 0; hh < 4; ++hh) { float d = 0.f;
#pragma unroll
                for (int i = 0; i < 8; ++i) d = dot2x4(QA4[(hg * 4 + hh) * 8 + i], kp[hh * 8 + i], d);
                LG[(hg * 4 + hh) * 256 + k] = d; }
        }
    }
    __syncthreads();
    {
        float v[4]; float mx = -INFINITY;
#pragma unroll
        for (int j = 0; j < 4; ++j) { const int k = lane + 64 * j; v[j] = (k < n_sel) ? LG[wid * 256 + k] : -INFINITY; mx = fmaxf(mx, v[j]); }
        mx = wave_max(mx);
        float sum = 0.f;
#pragma unroll
        for (int j = 0; j < 4; ++j) { const int k = lane + 64 * j; v[j] = (k < n_sel) ? exp2f(v[j] - mx) : 0.f; sum += v[j]; }
        sum = wave_sum(sum);
        const float inv = 1.f / sum;
#pragma unroll
        for (int j = 0; j < 4; ++j) LG[wid * 256 + lane + 64 * j] = v[j] * inv;
    }
    __syncthreads();
    {
        float o = 0.f; const f16* vp = VA + brow * 512 + wid * 64 + lane;
#pragma unroll 8
        for (int k = 0; k < n_sel; ++k) o += LG[wid * 256 + k] * (float)vp[(size_t)SEL[k] * 512];
        OAdst[wid * 64 + lane] = (f16)o;
    }
    __syncthreads();
}

__device__ __forceinline__ void row_select_slow(const Ctx& C, LAS unsigned char* lds, int b, int t, unsigned* dst, int nwords) {
    const int tid = threadIdx.x, lane = tid & 63, wid = tid >> 6;
    LAS unsigned* SK = (LAS unsigned*)(lds + RL_SK);
    LAS u32x4* QI4 = (LAS u32x4*)(lds + RL_QI);
    LAS unsigned* HIST = (LAS unsigned*)(lds + RL_HIST);
    LAS unsigned* WC = (LAS unsigned*)(lds + RL_WC);
    LAS unsigned* MISC = (LAS unsigned*)(lds + RL_MISC);
    LAS float* WL = (LAS float*)(lds + RL_W);
    const f16* QI = (const f16*)(C.ws + WS_QI); const f16* KI = (const f16*)(C.ws + WS_KI); const float* WI = (const float*)(C.ws + WS_WI);
    const size_t row = (size_t)b * SEQ + t, brow = (size_t)b * SEQ;
    __syncthreads();
    if (tid < 64) QI4[tid] = ((const u32x4*)(QI + row * 512))[tid];
    else if (tid >= 128 && tid < 136) WL[tid - 128] = WI[row * 8 + (tid - 128)];
    __syncthreads();
    const int n = t + 1;
    unsigned T = 0u; int need_eq = 0x7fffffff;
    {
        float w[8];
#pragma unroll
        for (int h = 0; h < 8; ++h) w[h] = WL[h];
        for (int s = tid; s < n; s += NTHREADS) {
            const u32x4* kp = (const u32x4*)(KI + (brow + s) * 64);
            u32x4 k[8];
#pragma unroll
            for (int i = 0; i < 8; ++i) k[i] = kp[i];
            float sc = 0.f;
#pragma unroll
            for (int h = 0; h < 8; ++h) { float d = 0.f;
#pragma unroll
                for (int i = 0; i < 8; ++i) d = dot2x4(QI4[h * 8 + i], k[i], d);
                sc = fmaf(w[h], fmaxf(d, 0.f), sc); }
            SK[s] = fkey(sc);
        }
    }
    if (n > TOPK) {
        unsigned prefix = 0; int need = TOPK;
#pragma unroll 1
        for (int pass = 0; pass < 4; ++pass) {
            const int shift = 24 - 8 * pass;
            if (tid < 256) HIST[tid] = 0;
            __syncthreads();
            for (int s = tid; s < n; s += NTHREADS) { const unsigned key = SK[s];
                const bool match = (pass == 0) ? true : ((key >> (shift + 8)) == prefix);
                if (match) atomicAdd((unsigned*)&HIST[(key >> shift) & 255u], 1u); }
            __syncthreads();
            if (wid == 0) {
                const int c0 = (int)HIST[4 * lane], c1 = (int)HIST[4 * lane + 1], c2 = (int)HIST[4 * lane + 2], c3 = (int)HIST[4 * lane + 3];
                const int tot = c0 + c1 + c2 + c3;
                int S = tot;
#pragma unroll
                for (int o = 1; o < 64; o <<= 1) { const int u = __shfl_down(S, o); if (lane + o < 64) S += u; }
                const int above = S - tot;
                if (above < need && need <= S) {
                    int a = above, d;
                    if (a + c3 >= need) { d = 3; }
                    else { a += c3; if (a + c2 >= need) { d = 2; }
                    else { a += c2; if (a + c1 >= need) { d = 1; }
                    else { a += c1; d = 0; } } }
                    MISC[0] = (unsigned)(4 * lane + d); MISC[1] = (unsigned)(need - a);
                }
            }
            __syncthreads();
            prefix = (prefix << 8) | MISC[0]; need = (int)MISC[1];
        }
        T = prefix; need_eq = need;
    }
    __syncthreads();
    int run_eq = 0;
    for (int c0 = 0; c0 < nwords * 32; c0 += NTHREADS) {
        const int s = c0 + tid; const bool act = s < n; const unsigned k = act ? SK[s] : 0u;
        const bool gt = act && k > T, eq = act && k == T;
        const unsigned long long beq = __ballot(eq);
        if (lane == 0) WC[wid] = (unsigned)__popcll(beq);
        __syncthreads();
        int pe = run_eq, tot_e = 0;
#pragma unroll
        for (int w = 0; w < 8; ++w) { const int c = (int)WC[w]; if (w < wid) pe += c; tot_e += c; }
        pe += __popcll(beq & ((1ull << lane) - 1ull));
        const bool sel = gt || (eq && pe < need_eq);
        run_eq += tot_e;
        const unsigned long long bs = __ballot(sel);
        const int w0 = (c0 >> 5) + 2 * wid;
        if (lane == 0) { if (w0 < nwords) dst[w0] = (unsigned)bs; if (w0 + 1 < nwords) dst[w0 + 1] = (unsigned)(bs >> 32); }
        __syncthreads();
    }
}

typedef float f32x16 __attribute__((ext_vector_type(16)));
#ifndef IX_CAP
#define IX_CAP 512
#endif
constexpr int IXL_HIST = 0, IXL_KT = 131072, IXL_CNT = 147456, IXL_B1 = 147456 + 128, IXL_NEED = 147456 + 256, IXL_FLAG = 147456 + 384;
struct IxWave { f16x8 a[4]; float wA[8], wB[8]; };
__device__ __forceinline__ float relu_s(float a) { float r; asm("v_max_f32_e32 %0, 0, %1" : "=v"(r) : "v"(a)); return r; }
__device__ __forceinline__ void ix_scores2(const IxWave& W, const LAS unsigned char* kt, int lane, float (&s)[2][2]) {
    const int c = lane & 31, hk = lane >> 5;
    f16x8 bf[2][4];
#pragma unroll
    for (int sub = 0; sub < 2; ++sub) { const int key = 32 * sub + c;
#pragma unroll
        for (int ks = 0; ks < 4; ++ks) { const int chunk = 2 * ks + hk; bf[sub][ks] = *(const LAS f16x8*)(kt + key * 128 + ((chunk ^ (key & 7)) << 4)); } }
    f32x16 acc0 = {0.f, 0.f, 0.f, 0.f, 0.f, 0.f, 0.f, 0.f, 0.f, 0.f, 0.f, 0.f, 0.f, 0.f, 0.f, 0.f}, acc1 = acc0;
#pragma unroll
    for (int ks = 0; ks < 4; ++ks) { acc0 = __builtin_amdgcn_mfma_f32_32x32x16_f16(W.a[ks], bf[0][ks], acc0, 0, 0, 0); acc1 = __builtin_amdgcn_mfma_f32_32x32x16_f16(W.a[ks], bf[1][ks], acc1, 0, 0, 0); }
    asm volatile("s_nop 15\n\ts_nop 7" : "+v"(acc0), "+v"(acc1));
    float a0 = 0.f, a1 = 0.f, b0 = 0.f, b1 = 0.f;
#pragma unroll
    for (int h = 0; h < 8; ++h) { a0 = fmaf(W.wA[h], relu_s(acc0[h]), a0); a1 = fmaf(W.wB[h], relu_s(acc0[8 + h]), a1); b0 = fmaf(W.wA[h], relu_s(acc1[h]), b0); b1 = fmaf(W.wB[h], relu_s(acc1[8 + h]), b1); }
    s[0][0] = a0; s[0][1] = a1; s[1][0] = b0; s[1][1] = b1;
}
__device__ __forceinline__ void ix_stage_load(const f16* KI, size_t brow, int tile, int tid, u32x4& v) { v = *(const u32x4*)(KI + (brow + (size_t)tile * 64 + (tid >> 3)) * 64 + (tid & 7) * 8); }
__device__ __forceinline__ void ix_stage_write(LAS unsigned char* lds, int buf, int tid, const u32x4& v) { const int key = tid >> 3, chunk = tid & 7; *(LAS u32x4*)(lds + IXL_KT + buf * 8192 + key * 128 + ((chunk ^ (key & 7)) << 4)) = v; }

__device__ __forceinline__ void ix_row_bin(const LAS unsigned* HIST, int row, int lane, int& b1, int& need1) {
    const LAS u32x4* hp = (const LAS u32x4*)(HIST + row * 1024 + 16 * lane);
    const u32x4 q0 = hp[0], q1 = hp[1], q2 = hp[2], q3 = hp[3];
    const unsigned wv[16] = {q0.x, q0.y, q0.z, q0.w, q1.x, q1.y, q1.z, q1.w, q2.x, q2.y, q2.z, q2.w, q3.x, q3.y, q3.z, q3.w};
    int tot = 0;
#pragma unroll
    for (int i = 0; i < 16; ++i) tot += (int)(wv[i] & 0xffffu) + (int)(wv[i] >> 16);
    int S = tot;
#pragma unroll
    for (int o = 1; o < 64; o <<= 1) { const int u = __shfl_down(S, o); if (lane + o < 64) S += u; }
    const int above = S - tot; const bool hit = above < TOPK && TOPK <= S;
    int a = above, d = 0, na = 0; bool found = false;
#pragma unroll
    for (int i = 31; i >= 0; --i) { const int cnt = (i & 1) ? (int)(wv[i >> 1] >> 16) : (int)(wv[i >> 1] & 0xffffu);
        if (!found && a + cnt >= TOPK) { found = true; d = i; na = a; } a += cnt; }
    const unsigned long long bm = __ballot(hit);
    if (bm == 0ull) { b1 = -1; need1 = 0; return; }
    const int src = __ffsll((long long)bm) - 1;
    b1 = __shfl(32 * lane + d, src); need1 = TOPK - __shfl(na, src);
}

template <int VAR>
__device__ __forceinline__ void ix_unit(const Ctx& C, LAS unsigned char* lds, int b, int t0, unsigned* BM) {
    const int tid = threadIdx.x, lane = tid & 63, wave = __builtin_amdgcn_readfirstlane(tid >> 6), hi = lane >> 5, c = lane & 31;
    const f16* QI = (const f16*)(C.ws + WS_QI); const f16* KI = (const f16*)(C.ws + WS_KI); const float* WI = (const float*)(C.ws + WS_WI);
    const size_t brow = (size_t)b * SEQ;
    LAS unsigned* HIST = (LAS unsigned*)(lds + IXL_HIST);
    LAS u32x2* LIST = (LAS u32x2*)(lds + IXL_HIST);
    LAS unsigned* CNT = (LAS unsigned*)(lds + IXL_CNT);
    LAS int* B1 = (LAS int*)(lds + IXL_B1);
    LAS int* NEED = (LAS int*)(lds + IXL_NEED);
    LAS unsigned* FLAG = (LAS unsigned*)(lds + IXL_FLAG);
    const int ntile = (t0 + 32 + 63) >> 6;
    const int tA = t0 + 4 * wave + 2 * hi, rA = 4 * wave + 2 * hi;
    IxWave W;
    {
        const int a_ = c >> 3, b_ = (c >> 2) & 1, c_ = c & 3, tok = 2 * b_ + (a_ >> 1), head = 4 * (a_ & 1) + c_;
        const f16* qp = QI + (brow + t0 + 4 * wave + tok) * 512 + head * 64 + 8 * hi;
#pragma unroll
        for (int ks = 0; ks < 4; ++ks) W.a[ks] = *(const f16x8*)(qp + 16 * ks);
        const float* wp = WI + (brow + tA) * 8;
        const f32x4 w0 = *(const f32x4*)(wp), w1 = *(const f32x4*)(wp + 4), w2 = *(const f32x4*)(wp + 8), w3 = *(const f32x4*)(wp + 12);
#pragma unroll
        for (int i = 0; i < 4; ++i) { W.wA[i] = w0[i]; W.wA[4 + i] = w1[i]; W.wB[i] = w2[i]; W.wB[4 + i] = w3[i]; }
    }
    __syncthreads();
    for (int i = tid; i < 8192; i += NTHREADS) ((LAS u32x4*)HIST)[i] = (u32x4){0u, 0u, 0u, 0u};
    if (tid < 32) CNT[tid] = 0u;
    if (tid == 32) FLAG[0] = 0u;
#define IX_LD(R, t_) ix_stage_load(KI, brow, ((t_) < ntile ? (t_) : ntile - 1), tid, R)
#define IX_TILES(BODY) do { if (VAR & 1) { for (int tile = 0; tile < ntile; ++tile) { const LAS unsigned char* kt = lds + IXL_KT + (tile & 1) * 8192; BODY; } break; } \
        u32x4 R0, R1, R2, R3; IX_LD(R0, 0); IX_LD(R1, 1); IX_LD(R2, 2); IX_LD(R3, 3); ix_stage_write(lds, 0, tid, R0); __syncthreads(); \
        for (int t4 = 0; t4 < ntile; t4 += 4) { \
            { const int tile = t4;     IX_LD(R0, tile + 4); const LAS unsigned char* kt = lds + IXL_KT;        BODY; ix_stage_write(lds, 1, tid, R1); __syncthreads(); } if (t4 + 1 >= ntile) break; \
            { const int tile = t4 + 1; IX_LD(R1, tile + 4); const LAS unsigned char* kt = lds + IXL_KT + 8192; BODY; ix_stage_write(lds, 0, tid, R2); __syncthreads(); } if (t4 + 2 >= ntile) break; \
            { const int tile = t4 + 2; IX_LD(R2, tile + 4); const LAS unsigned char* kt = lds + IXL_KT;        BODY; ix_stage_write(lds, 1, tid, R3); __syncthreads(); } if (t4 + 3 >= ntile) break; \
            { const int tile = t4 + 3; IX_LD(R3, tile + 4); const LAS unsigned char* kt = lds + IXL_KT + 8192; BODY; ix_stage_write(lds, 0, tid, R0); __syncthreads(); } \
        } } while (0)
    int bcA = -1, bcB = -1;
#define IX_BODY1 do { \
        float sc2[2][2]; ix_scores2(W, kt, lane, sc2); \
        _Pragma("unroll") for (int sub = 0; sub < 2; ++sub) { \
            const float sA = sc2[sub][0], sB = sc2[sub][1]; \
            const int s = tile * 64 + sub * 32 + c; \
            const int binA = (int)(fkey(sA) >> 21), binB = (int)(fkey(sB) >> 21); \
            if (!(VAR & 2) && s <= tA && binA >= bcA) atomicAdd((unsigned*)&HIST[rA * 1024 + (binA >> 1)], 1u << ((binA & 1) * 16)); \
            if (!(VAR & 2) && s <= tA + 1 && binB >= bcB) atomicAdd((unsigned*)&HIST[(rA + 1) * 1024 + (binB >> 1)], 1u << ((binB & 1) * 16)); \
        } \
        { const int tt = tile + 1; \
          if (!(VAR & 8) && (tt == 4 || tt == 8 || tt == 16 || tt == 24 || tt == 32 || tt == 48 || tt == 64 || tt == 96)) { \
              int r0, r1, r2, r3, nd; ix_row_bin(HIST, 4 * wave + 0, lane, r0, nd); ix_row_bin(HIST, 4 * wave + 1, lane, r1, nd); ix_row_bin(HIST, 4 * wave + 2, lane, r2, nd); ix_row_bin(HIST, 4 * wave + 3, lane, r3, nd); \
              bcA = hi ? r2 : r0; bcB = hi ? r3 : r1; } } \
    } while (0)
    IX_TILES(IX_BODY1);
#pragma unroll 1
    for (int rr = 0; rr < 4; ++rr) {
        const int row = 4 * wave + rr; int b1, need1; ix_row_bin(HIST, row, lane, b1, need1);
        if (lane == 0) { B1[row] = b1; NEED[row] = need1; }
    }
    __syncthreads();
    const int b1A = B1[rA], b1B = B1[rA + 1];
    int lc0 = 0, lc1 = 0, lc2 = 0, lc3 = 0;
    const unsigned ltm = (1u << c) - 1u;
    unsigned* bmw = BM + (brow + t0 + 4 * wave) * 256;
    unsigned mw0 = 0u, mw1 = 0u, mw2 = 0u, mw3 = 0u;
    const int wend = ((t0 >> 8) + 1) * 8;
#define IX_BODY2 do { \
        float sc2[2][2]; ix_scores2(W, kt, lane, sc2); \
        _Pragma("unroll") for (int sub = 0; sub < 2; ++sub) { \
            const float sA = sc2[sub][0], sB = sc2[sub][1]; \
            const int s = tile * 64 + sub * 32 + c; \
            const unsigned kA = fkey(sA), kB = fkey(sB); const int binA = (int)(kA >> 21), binB = (int)(kB >> 21); \
            const bool vA = s <= tA, vB = s <= tA + 1; \
            const bool gA = vA && binA > b1A, gB = vB && binB > b1B, eA = vA && binA == b1A, eB = vB && binB == b1B; \
            const unsigned long long bgA = __ballot(gA), bgB = __ballot(gB); \
            if (!(VAR & 2)) { const int widx = tile * 2 + sub, wj = widx & 63; \
                const bool mine = lane == wj; mw0 = mine ? (unsigned)bgA : mw0; mw2 = mine ? (unsigned)(bgA >> 32) : mw2; \
                mw1 = mine ? (unsigned)bgB : mw1; mw3 = mine ? (unsigned)(bgB >> 32) : mw3; \
                if (wj == 63) { const int g64 = (widx >> 6) * 64 + lane; if (g64 < wend) { bmw[g64] = mw0; bmw[256 + g64] = mw1; bmw[512 + g64] = mw2; bmw[768 + g64] = mw3; } mw0 = 0u; mw1 = 0u; mw2 = 0u; mw3 = 0u; } } \
            const unsigned long long beA = __ballot(eA), beB = __ballot(eB); \
            if (!(VAR & 2)) { \
                if (eA) { const unsigned idx = (unsigned)(hi ? lc2 : lc0) + (unsigned)__popc((hi ? (unsigned)(beA >> 32) : (unsigned)beA) & ltm); if (idx < (unsigned)IX_CAP) LIST[rA * IX_CAP + idx] = (u32x2){kA, (unsigned)s}; } \
                if (eB) { const unsigned idx = (unsigned)(hi ? lc3 : lc1) + (unsigned)__popc((hi ? (unsigned)(beB >> 32) : (unsigned)beB) & ltm); if (idx < (unsigned)IX_CAP) LIST[(rA + 1) * IX_CAP + idx] = (u32x2){kB, (unsigned)s}; } \
                lc0 += __popc((unsigned)beA); lc2 += __popc((unsigned)(beA >> 32)); lc1 += __popc((unsigned)beB); lc3 += __popc((unsigned)(beB >> 32)); } \
        } } while (0)
    IX_TILES(IX_BODY2);
#undef IX_BODY1
#undef IX_BODY2
#undef IX_TILES
#undef IX_LD
    if (!(VAR & 2)) {
        for (int g = (2 * ntile) >> 6; g * 64 < wend; ++g) { const int g64 = g * 64 + lane;
            if (g64 < wend) { bmw[g64] = mw0; bmw[256 + g64] = mw1; bmw[512 + g64] = mw2; bmw[768 + g64] = mw3; }
            mw0 = 0u; mw1 = 0u; mw2 = 0u; mw3 = 0u; }
    }
    asm volatile("s_waitcnt vmcnt(0)" ::: "memory");
    asm volatile("s_waitcnt lgkmcnt(0)" ::: "memory");
#pragma unroll 1
    for (int rr = 0; rr < 4; ++rr) {
        const int row = 4 * wave + rr; const int cnt = (rr == 0) ? lc0 : (rr == 1) ? lc1 : (rr == 2) ? lc2 : lc3; const int need = NEED[row];
        if (need == 0 || (VAR & 4)) continue;
        if (cnt > IX_CAP) { if (lane == 0) atomicOr((unsigned*)FLAG, 1u << row); continue; }
        const LAS u32x2* L = LIST + row * IX_CAP; unsigned* bmr = BM + (brow + t0 + row) * 256;
        unsigned ck[8], cs[8]; const int nch = (cnt + 63) >> 6;
#pragma unroll
        for (int ch = 0; ch < 8; ++ch) { const int i = ch * 64 + lane; u32x2 e = {0u, 0xffffffffu}; if (i < cnt) e = L[i]; ck[ch] = e.x; cs[ch] = e.y; }
        unsigned T = (unsigned)B1[row] << 21;
        int cgt = 0;
        if (need < cnt) {
#pragma unroll 1
            for (int bit = 20; bit >= 0; --bit) { const unsigned trial = T | (1u << bit); int cn = 0;
#pragma unroll
                for (int ch = 0; ch < 8; ++ch) if (ch < nch) cn += __popcll(__ballot(ch * 64 + lane < cnt && ck[ch] >= trial));
                if (cn >= need) T = trial; }
#pragma unroll
            for (int ch = 0; ch < 8; ++ch) if (ch < nch) cgt += __popcll(__ballot(ch * 64 + lane < cnt && ck[ch] > T));
        } else T = 0u;
        int need_eq = need - cgt, ceq = 0;
        if (need < cnt) {
#pragma unroll
            for (int ch = 0; ch < 8; ++ch) if (ch < nch) ceq += __popcll(__ballot(ch * 64 + lane < cnt && ck[ch] == T));
        }
        unsigned taken = 0u;
#pragma unroll
        for (int ch = 0; ch < 8; ++ch) if (ch < nch && ch * 64 + lane < cnt && (ck[ch] > T || (need >= cnt) || (ck[ch] == T && ceq <= need_eq))) taken |= 1u << ch;
        if (need < cnt && ceq > need_eq) {
#pragma unroll 1
            for (int e = 0; e < need_eq; ++e) {
                unsigned mn = 0xffffffffu;
#pragma unroll
                for (int ch = 0; ch < 8; ++ch) if (ch < nch && ch * 64 + lane < cnt && ck[ch] == T && !((taken >> ch) & 1u)) mn = cs[ch] < mn ? cs[ch] : mn;
                unsigned wm = mn;
#pragma unroll
                for (int o = 1; o < 64; o <<= 1) { const unsigned u = (unsigned)__shfl_xor((int)wm, o); wm = u < wm ? u : wm; }
#pragma unroll
                for (int ch = 0; ch < 8; ++ch) if (ch < nch && ch * 64 + lane < cnt && ck[ch] == T && cs[ch] == wm) taken |= 1u << ch;
            }
        }
#pragma unroll
        for (int ch = 0; ch < 8; ++ch) if ((taken >> ch) & 1u) atomicOr(&bmr[cs[ch] >> 5], 1u << (cs[ch] & 31u));
    }
    __syncthreads();
    const unsigned flags = FLAG[0];
    if (flags && VAR == 0) {
#pragma unroll 1
        for (int row = 0; row < 32; ++row) if ((flags >> row) & 1u) row_select_slow(C, lds, b, t0 + row, BM + (brow + t0 + row) * 256, ((t0 >> 8) + 1) * 8);
    }
}

#ifndef IXS_KEEP
#define IXS_KEEP 288
#endif
constexpr int IXS_ROOM = IX_CAP - 64;
__device__ __forceinline__ int ixs_count_ge(const unsigned (&ck)[8], unsigned t) {
    int cn = 0;
#pragma unroll
    for (int ch = 0; ch < 8; ++ch) cn += __popcll(__ballot(ck[ch] >= t));
    return cn;
}
__device__ __forceinline__ unsigned ixs_wave_max(const unsigned (&ck)[8]) {
    unsigned m = ck[0];
#pragma unroll
    for (int ch = 1; ch < 8; ++ch) m = ck[ch] > m ? ck[ch] : m;
#pragma unroll
    for (int o = 1; o < 64; o <<= 1) { const unsigned u = (unsigned)__shfl_xor((int)m, o); m = u > m ? u : m; }
    return m;
}
__device__ __forceinline__ int ixs_compact(LAS u32x2* L, int cnt, unsigned& T, int lane) {
    unsigned ck[8], cs[8];
#pragma unroll
    for (int ch = 0; ch < 8; ++ch) { const int i = ch * 64 + lane; u32x2 e = {0u, 0u}; if (i < cnt) e = L[i]; ck[ch] = e.x; cs[ch] = e.y; }
    unsigned a = T > 0u ? T : 1u, bb = ixs_wave_max(ck); int kept = cnt;
#pragma unroll 1
    while (a < bb) { const unsigned mid = a + ((bb - a + 1u) >> 1); const int cn = ixs_count_ge(ck, mid);
        if (cn >= TOPK) { a = mid; kept = cn; if (cn <= IXS_KEEP) break; } else bb = mid - 1u; }
    int base = 0;
#pragma unroll
    for (int ch = 0; ch < 8; ++ch) { const bool k = ck[ch] >= a; const unsigned long long bm = __ballot(k);
        if (k) L[base + __popcll(bm & ((1ull << lane) - 1ull))] = (u32x2){ck[ch], cs[ch]};
        base += __popcll(bm); }
    asm volatile("s_waitcnt lgkmcnt(0)" ::: "memory");
    T = a;
    return kept;
}

__device__ __forceinline__ void ix_unit_s(const Ctx& C, LAS unsigned char* lds, int b, int t0, unsigned* BM) {
    const int tid = threadIdx.x, lane = tid & 63, wave = __builtin_amdgcn_readfirstlane(tid >> 6), hi = lane >> 5, c = lane & 31;
    const f16* QI = (const f16*)(C.ws + WS_QI); const f16* KI = (const f16*)(C.ws + WS_KI); const float* WI = (const float*)(C.ws + WS_WI);
    const size_t brow = (size_t)b * SEQ;
    LAS u32x2* LIST = (LAS u32x2*)(lds + IXL_HIST);
    LAS unsigned* FLAG = (LAS unsigned*)(lds + IXL_FLAG);
    const int ntile = (t0 + 32 + 63) >> 6;
    const int tA = t0 + 4 * wave + 2 * hi, rA = 4 * wave + 2 * hi;
    IxWave W;
    {
        const int a_ = c >> 3, b_ = (c >> 2) & 1, c_ = c & 3, tok = 2 * b_ + (a_ >> 1), head = 4 * (a_ & 1) + c_;
        const f16* qp = QI + (brow + t0 + 4 * wave + tok) * 512 + head * 64 + 8 * hi;
#pragma unroll
        for (int ks = 0; ks < 4; ++ks) W.a[ks] = *(const f16x8*)(qp + 16 * ks);
        const float* wp = WI + (brow + tA) * 8;
        const f32x4 w0 = *(const f32x4*)(wp), w1 = *(const f32x4*)(wp + 4), w2 = *(const f32x4*)(wp + 8), w3 = *(const f32x4*)(wp + 12);
#pragma unroll
        for (int i = 0; i < 4; ++i) { W.wA[i] = w0[i]; W.wA[4 + i] = w1[i]; W.wB[i] = w2[i]; W.wB[4 + i] = w3[i]; }
    }
    __syncthreads();
    if (tid == 32) FLAG[0] = 0u;
    int lc0 = 0, lc1 = 0, lc2 = 0, lc3 = 0;
    unsigned th0 = 0u, th1 = 0u, th2 = 0u, th3 = 0u;
    bool ovf = false;
    const unsigned ltm = (1u << c) - 1u;
    LAS u32x2* Lw = LIST + (4 * wave) * IX_CAP;
    LAS unsigned* CF = (LAS unsigned*)(lds + IXL_CNT);
    if (tid < 16) CF[tid] = 0u;
#define IX_LD(R, t_) ix_stage_load(KI, brow, ((t_) < ntile ? (t_) : ntile - 1), tid, R)
#define IXS_BODY do { \
          \
        { const u32x4 f0 = *(const LAS u32x4*)(CF + (tile & 1) * 8), f1 = *(const LAS u32x4*)(CF + (tile & 1) * 8 + 4); \
          if ((f0.x | f0.y | f0.z | f0.w | f1.x | f1.y | f1.z | f1.w) != 0u) { \
            if (lc0 > IXS_KEEP + 16) { lc0 = ixs_compact(Lw, lc0, th0, lane); ovf |= lc0 > IXS_ROOM; } \
            if (lc1 > IXS_KEEP + 16) { lc1 = ixs_compact(Lw + IX_CAP, lc1, th1, lane); ovf |= lc1 > IXS_ROOM; } \
            if (lc2 > IXS_KEEP + 16) { lc2 = ixs_compact(Lw + 2 * IX_CAP, lc2, th2, lane); ovf |= lc2 > IXS_ROOM; } \
            if (lc3 > IXS_KEEP + 16) { lc3 = ixs_compact(Lw + 3 * IX_CAP, lc3, th3, lane); ovf |= lc3 > IXS_ROOM; } } } \
        if (ovf) { lc0 = lc0 > IXS_ROOM ? IXS_ROOM : lc0; lc1 = lc1 > IXS_ROOM ? IXS_ROOM : lc1; lc2 = lc2 > IXS_ROOM ? IXS_ROOM : lc2; lc3 = lc3 > IXS_ROOM ? IXS_ROOM : lc3; }     \
        const unsigned thA = hi ? th2 : th0, thB = hi ? th3 : th1; \
        float sc2[2][2]; ix_scores2(W, kt, lane, sc2); \
        _Pragma("unroll") for (int sub = 0; sub < 2; ++sub) { \
            const int s = tile * 64 + sub * 32 + c; \
            const unsigned kA = fkey(sc2[sub][0]), kB = fkey(sc2[sub][1]); \
            const bool eA = s <= tA && kA > thA, eB = s <= tA + 1 && kB > thB; \
            const unsigned long long beA = __ballot(eA), beB = __ballot(eB); \
            if (eA) { const int idx = (hi ? lc2 : lc0) + __popc((hi ? (unsigned)(beA >> 32) : (unsigned)beA) & ltm); LIST[rA * IX_CAP + idx] = (u32x2){kA, (unsigned)s}; } \
            if (eB) { const int idx = (hi ? lc3 : lc1) + __popc((hi ? (unsigned)(beB >> 32) : (unsigned)beB) & ltm); LIST[(rA + 1) * IX_CAP + idx] = (u32x2){kB, (unsigned)s}; } \
            lc0 += __popc((unsigned)beA); lc2 += __popc((unsigned)(beA >> 32)); lc1 += __popc((unsigned)beB); lc3 += __popc((unsigned)(beB >> 32)); \
        } \
        if (lane == 0) CF[((tile + 1) & 1) * 8 + wave] = (lc0 > IXS_ROOM || lc1 > IXS_ROOM || lc2 > IXS_ROOM || lc3 > IXS_ROOM) ? 1u : 0u;     \
        } while (0)
    {
        u32x4 R0, R1, R2, R3; IX_LD(R0, 0); IX_LD(R1, 1); IX_LD(R2, 2); IX_LD(R3, 3); ix_stage_write(lds, 0, tid, R0); __syncthreads();
        for (int t4 = 0; t4 < ntile; t4 += 4) {
            { const int tile = t4;     IX_LD(R0, tile + 4); const LAS unsigned char* kt = lds + IXL_KT;        IXS_BODY; ix_stage_write(lds, 1, tid, R1); __syncthreads(); } if (t4 + 1 >= ntile) break;
            { const int tile = t4 + 1; IX_LD(R1, tile + 4); const LAS unsigned char* kt = lds + IXL_KT + 8192; IXS_BODY; ix_stage_write(lds, 0, tid, R2); __syncthreads(); } if (t4 + 2 >= ntile) break;
            { const int tile = t4 + 2; IX_LD(R2, tile + 4); const LAS unsigned char* kt = lds + IXL_KT;        IXS_BODY; ix_stage_write(lds, 1, tid, R3); __syncthreads(); } if (t4 + 3 >= ntile) break;
            { const int tile = t4 + 3; IX_LD(R3, tile + 4); const LAS unsigned char* kt = lds + IXL_KT + 8192; IXS_BODY; ix_stage_write(lds, 0, tid, R0); __syncthreads(); }
        }
    }
#undef IXS_BODY
#undef IX_LD
    unsigned* bmw = BM + (brow + t0 + 4 * wave) * 256;
    const int wend = ((t0 >> 8) + 1) * 8;
    asm volatile("s_waitcnt lgkmcnt(0)" ::: "memory");
#pragma unroll 1
    for (int rr = 0; rr < 4; ++rr) {
        const int row = 4 * wave + rr; const int cnt = (rr == 0) ? lc0 : (rr == 1) ? lc1 : (rr == 2) ? lc2 : lc3; const unsigned tb = (rr == 0) ? th0 : (rr == 1) ? th1 : (rr == 2) ? th2 : th3;
        if (ovf) { if (lane == 0) atomicOr((unsigned*)FLAG, 1u << row); continue; }
        LAS u32x2* L = LIST + row * IX_CAP; LAS unsigned* IMG = (LAS unsigned*)L;
        unsigned ck[8], cs[8];
#pragma unroll
        for (int ch = 0; ch < 8; ++ch) { const int i = ch * 64 + lane; u32x2 e = {0u, 0u}; if (i < cnt) e = L[i]; ck[ch] = e.x; cs[ch] = e.y; }
        asm volatile("s_waitcnt lgkmcnt(0)" ::: "memory");
#pragma unroll
        for (int j = 0; j < 4; ++j) IMG[j * 64 + lane] = 0u;
        unsigned a = tb > 0u ? tb : 1u; int cgt = 0, ceq = 0; bool exact = (cnt <= TOPK);
        if (!exact) {
            unsigned bb = ixs_wave_max(ck);
#pragma unroll 1
            while (a < bb) { const unsigned mid = a + ((bb - a + 1u) >> 1); const int cn = ixs_count_ge(ck, mid);
                if (cn >= TOPK) { a = mid; if (cn == TOPK) { exact = true; break; } } else bb = mid - 1u; }
            if (!exact) { cgt = ixs_count_ge(ck, a + 1u); ceq = ixs_count_ge(ck, a) - cgt; if (ceq <= TOPK - cgt) exact = true; }
        }
        const int need_eq = TOPK - cgt;
        unsigned taken = 0u;
#pragma unroll
        for (int ch = 0; ch < 8; ++ch) if (ck[ch] >= a && (exact || ck[ch] > a)) taken |= 1u << ch;
        if (!exact) {
#pragma unroll 1
            for (int e = 0; e < need_eq; ++e) {
                unsigned mn = 0xffffffffu;
#pragma unroll
                for (int ch = 0; ch < 8; ++ch) if (ck[ch] == a && !((taken >> ch) & 1u)) mn = cs[ch] < mn ? cs[ch] : mn;
                unsigned wm = mn;
#pragma unroll
                for (int o = 1; o < 64; o <<= 1) { const unsigned u = (unsigned)__shfl_xor((int)wm, o); wm = u < wm ? u : wm; }
#pragma unroll
                for (int ch = 0; ch < 8; ++ch) if (ck[ch] == a && cs[ch] == wm) taken |= 1u << ch;
            }
        }
        asm volatile("s_waitcnt lgkmcnt(0)" ::: "memory");
#pragma unroll
        for (int ch = 0; ch < 8; ++ch) if ((taken >> ch) & 1u) atomicOr((unsigned*)&IMG[cs[ch] >> 5], 1u << (cs[ch] & 31u));
        asm volatile("s_waitcnt lgkmcnt(0)" ::: "memory");
        unsigned* bmr = bmw + rr * 256;
#pragma unroll
        for (int j = 0; j < 4; ++j) { const int w = j * 64 + lane; if (w < wend) bmr[w] = IMG[w]; }
    }
    __syncthreads();
    const unsigned flags = FLAG[0];
    if (flags) {
#pragma unroll 1
        for (int row = 0; row < 32; ++row) if ((flags >> row) & 1u) row_select_slow(C, lds, b, t0 + row, BM + (brow + t0 + row) * 256, ((t0 >> 8) + 1) * 8);
    }
}

namespace attn_body {
typedef _Float16 bf16;
using bf16x8=__attribute__((ext_vector_type(8)))short;
using s16x4=__attribute__((ext_vector_type(4)))short;
using f32x16=__attribute__((ext_vector_type(16)))float;
using u32x4=__attribute__((ext_vector_type(4)))unsigned;
constexpr int BATCH=4,NHEAD=8,SEQ=8192,D=64,DM=NHEAD*D;
constexpr int NW=8,QBLK=32,QB=QBLK*NW,KVBLK=64,NQB=SEQ/QB;
constexpr int ATTN_PITCH=DM, ATTN_UNIT_ROWS=QB;
__device__ __forceinline__ int crow(int r,int hi){return (r&3)+8*(r>>2)+4*hi;}
#define SBAR() __builtin_amdgcn_sched_barrier(0)
#define MFMA16(a,b,c,z0,z1,z2) __builtin_amdgcn_mfma_f32_32x32x16_f16(__builtin_bit_cast(f16x8,(a)),__builtin_bit_cast(f16x8,(b)),(c),0,0,0)
__device__ __forceinline__ void cmask(f32x16&p0,f32x16&p1,int jb,int qrel,int hi){
  const float NEG=-INFINITY; int kb=64*jb+4*hi;
  #pragma unroll
  for(int r=0;r<16;++r){int kv=kb+(r&3)+8*(r>>2); if(kv>qrel)p0[r]=NEG; if(kv+32>qrel)p1[r]=NEG;}
}

constexpr int NSLOT=3, SLOTB=8192;
constexpr int LDS_K=0, LDS_V=NSLOT*SLOTB, LDS_WS=2*NSLOT*SLOTB, LDS_OST=LDS_WS+NW*64*4, LDS_BYTES=LDS_OST+NW*4096;
constexpr float C2=0.125f*1.4426950408889634f;
__device__ __forceinline__ void glds16(const void*gsrc,unsigned lds_dst){unsigned keep;
  asm volatile("s_mov_b32 %0, m0\n\ts_mov_b32 m0, %2\n\ts_nop 0\n\tglobal_load_lds_dwordx4 %1, off\n\ts_mov_b32 m0, %0":"=&s"(keep):"v"(gsrc),"s"(lds_dst):"memory");}
__device__ __forceinline__ float max3f(float a,float b,float c){float r;asm("v_max3_f32 %0, %1, %2, %3":"=v"(r):"v"(a),"v"(b),"v"(c));return r;}
__device__ __forceinline__ float max2f(float a,float b){float r;asm("v_max_f32_e32 %0, %1, %2":"=v"(r):"v"(a),"v"(b));return r;}
__device__ __forceinline__ float fadd_s(float a,float b){float r;asm("v_add_f32_e32 %0, %1, %2":"=v"(r):"v"(a),"v"(b));return r;}
__device__ __forceinline__ float fsub_s(float a,float b){float r;asm("v_sub_f32_e32 %0, %1, %2":"=v"(r):"v"(a),"v"(b));return r;}
typedef float f32x2_t __attribute__((ext_vector_type(2))); typedef _Float16 bf16x2_t __attribute__((ext_vector_type(2)));
__device__ __forceinline__ unsigned cvtpk_s(float lo,float hi){f32x2_t v={lo,hi};bf16x2_t b=__builtin_convertvector(v,bf16x2_t);return __builtin_bit_cast(unsigned,b);}
#define WAIT_BAR(N) asm volatile("s_waitcnt vmcnt(" #N ") lgkmcnt(0)\n\ts_barrier":::"memory")

__device__ __forceinline__ void qkt(f32x16&p0,f32x16&p1,const char*Kslot,const bf16x8*qr,const f32x16&negm,int r32,int hi){
  const char*kb=Kslot+hi*1024+r32*16;
  #pragma unroll
  for(int d0=0;d0<4;++d0){
    const bf16x8 b0=*reinterpret_cast<const bf16x8*>(kb+d0*2048);
    const bf16x8 b1=*reinterpret_cast<const bf16x8*>(kb+d0*2048+512);
    if(d0==0){p0=MFMA16(b0,qr[0],negm,0,0,0);p1=MFMA16(b1,qr[0],negm,0,0,0);}
    else{p0=MFMA16(b0,qr[d0],p0,0,0,0);p1=MFMA16(b1,qr[d0],p1,0,0,0);}}
}
typedef __attribute__((address_space(3))) const char* lds_cptr;
typedef short v4i16_t __attribute__((ext_vector_type(4)));
__device__ __forceinline__ void kload8(bf16x8*kf,lds_cptr kp){
  kf[0]=*(const __attribute__((address_space(3))) bf16x8*)(kp);      kf[1]=*(const __attribute__((address_space(3))) bf16x8*)(kp+512);
  kf[2]=*(const __attribute__((address_space(3))) bf16x8*)(kp+2048); kf[3]=*(const __attribute__((address_space(3))) bf16x8*)(kp+2560);
  kf[4]=*(const __attribute__((address_space(3))) bf16x8*)(kp+4096); kf[5]=*(const __attribute__((address_space(3))) bf16x8*)(kp+4608);
  kf[6]=*(const __attribute__((address_space(3))) bf16x8*)(kp+6144); kf[7]=*(const __attribute__((address_space(3))) bf16x8*)(kp+6656);
}
__device__ __forceinline__ void kload2(bf16x8*kf,lds_cptr kp,int j){ kf[2*j]=*(const __attribute__((address_space(3))) bf16x8*)(kp+j*2048); kf[2*j+1]=*(const __attribute__((address_space(3))) bf16x8*)(kp+j*2048+512); }
__device__ __forceinline__ s16x4 vtr(lds_cptr p){ return __builtin_bit_cast(s16x4,__builtin_amdgcn_ds_read_tr16_b64_v4i16((__attribute__((address_space(3))) v4i16_t*)p)); }
__device__ __forceinline__ float rowmax(const f32x16&p0,const f32x16&p1){
  float a=max3f(p0[0],p0[1],p1[0]),b=max3f(p0[2],p0[3],p1[1]);a=max3f(a,p1[2],p1[3]);
  #pragma unroll
  for(int r=4;r<16;r+=4){a=max3f(a,p0[r],p0[r+1]);b=max3f(b,p0[r+2],p0[r+3]);a=max3f(a,p1[r],p1[r+1]);b=max3f(b,p1[r+2],p1[r+3]);}
  const float m=max2f(a,b);
  auto rr=__builtin_amdgcn_permlane32_swap(__float_as_uint(m),__float_as_uint(m),false,false);
  return max2f(__uint_as_float(rr[0]),__uint_as_float(rr[1]));
}
__device__ __forceinline__ void pv(f32x16*o,int vb,bf16x8 pa0,bf16x8 pa1,bf16x8 pa2,bf16x8 pa3){
  #pragma unroll
  for(int d0=0;d0<2;++d0){s16x4 lo[4],hi[4];
    #pragma unroll
    for(int ks=0;ks<4;++ks){
      asm volatile("ds_read_b64_tr_b16 %0,%1 offset:%c2":"=&v"(lo[ks]):"v"(vb),"i"(d0*4096+ks*1024):"memory");
      asm volatile("ds_read_b64_tr_b16 %0,%1 offset:%c2":"=&v"(hi[ks]):"v"(vb),"i"(d0*4096+ks*1024+512):"memory");}
    asm volatile("s_waitcnt lgkmcnt(0)":::"memory");SBAR();
    #define PK(k) (bf16x8){lo[k][0],lo[k][1],lo[k][2],lo[k][3],hi[k][0],hi[k][1],hi[k][2],hi[k][3]}
    o[d0]=MFMA16(pa0,PK(0),o[d0],0,0,0);
    o[d0]=MFMA16(pa1,PK(1),o[d0],0,0,0);
    o[d0]=MFMA16(pa2,PK(2),o[d0],0,0,0);
    o[d0]=MFMA16(pa3,PK(3),o[d0],0,0,0);
    #undef PK
  }
}

#ifndef ATTN_STORE16
#define ATTN_STORE16(p,v) (*(u32x4*)(p)=(v))
#endif
template<int THRL> __device__ __forceinline__ void attn_unit(int b,int h,int qb,const bf16*Q,const bf16*__restrict__ K,const bf16*__restrict__ V,bf16*O,const unsigned*BM,char*shm){
  const int tid=threadIdx.x,lane=tid&63,r32=lane&31,hi=lane>>5; const int wid=__builtin_amdgcn_readfirstlane(tid>>6);
  const long rowbase=(long)b*SEQ; const int q0=qb*QB;
  const bf16*Qw=Q+(rowbase+q0+wid*QBLK)*DM+h*D;
  const bf16*Kh=K+rowbase*DM+h*D,*Vh=V+rowbase*DM+h*D;
  const unsigned lds0=(unsigned)(uintptr_t)shm;
  float*wsf=(float*)(shm+LDS_WS)+wid*64;
  const bf16*ksrc=Kh+(long)lane*DM+wid*8;
  const bf16*vsrc=Vh+(long)(16*(wid&3)+(lane>>2))*DM+(wid>>2)*32+(lane&3)*8;
  const unsigned kdst=lds0+LDS_K+wid*1024, vdst=lds0+LDS_V+wid*1024;
  #define DMA_K(t,slot) glds16(ksrc+(long)(t)*KVBLK*DM,(unsigned)__builtin_amdgcn_readfirstlane(kdst+(slot)))
  #define DMA_V(t,slot) glds16(vsrc+(long)(t)*KVBLK*DM,(unsigned)__builtin_amdgcn_readfirstlane(vdst+(slot)))
  const int vb0=(int)(lds0+LDS_V)+((lane>>4)&1)*32+(lane&3)*8+(4*hi+((lane&15)>>2))*64;
  const char*Kbase=shm+LDS_K; bf16x8 kf[8];
  const lds_cptr shm3=(lds_cptr)shm; const lds_cptr kp0=shm3+LDS_K+hi*1024+r32*16; const lds_cptr vp0=shm3+LDS_V+((lane>>4)&1)*32+(lane&3)*8+(4*hi+((lane&15)>>2))*64;
  const int NT=(q0+QB)/KVBLK;
  unsigned moff=(unsigned)(rowbase+q0+wid*QBLK+r32)*1024u;
  const int sh4=4*hi;
  u32x2 mkE,mkO;
  #define LDMASK(dst,t) do{ asm volatile("global_load_dwordx2 %0, %1, %2":"=v"(dst):"v"(moff),"s"(BM):"memory"); moff+=8u; }while(0)
  #define MKPIN(V_) do{ asm volatile("":"+v"(V_)); V_[0]>>=sh4; V_[1]>>=sh4; }while(0)
  #define MAND(X,r,mw) X[r]=__uint_as_float(__float_as_uint(X[r])&(unsigned)__builtin_amdgcn_sbfe((int)(mw),((r)&3)+8*((r)>>2),1))
  LDMASK(mkE,0);LDMASK(mkO,1);
  DMA_K(0,0);DMA_V(0,0);DMA_K(1,SLOTB);
  bf16x8 qr[4];
  #pragma unroll
  for(int d0=0;d0<4;++d0)qr[d0]=*reinterpret_cast<const bf16x8*>(&Qw[(long)r32*DM+d0*16+hi*8]);
  float mhat=0.f,l_reg=0.f;f32x16 o[2];o[0]=f32x16{};o[1]=f32x16{};f32x16 negm=f32x16{};asm volatile("":"+v"(negm));
  const int qrel=wid*QBLK+r32;
  #define CMASK(P0,P1,t) do{}while(0)
  bool resc=false;
  #define START(P0,P1) do{ const float rm=rowmax(P0,P1); resc=false; \
    { const float dl=rm; mhat=fadd_s(mhat,dl); \
      _Pragma("unroll") for(int r=0;r<16;++r){P0[r]=fsub_s(P0[r],dl);P1[r]=fsub_s(P1[r],dl);} \
      _Pragma("unroll") for(int r=0;r<16;++r)negm[r]=-mhat; asm volatile("":"+v"(negm)); } \
    _Pragma("unroll") for(int r=0;r<16;++r)P0[r]=__builtin_amdgcn_exp2f(P0[r]); }while(0)
  #define RESC() do{ if(resc){ asm volatile("s_waitcnt lgkmcnt(0)":::"memory"); \
      _Pragma("unroll") for(int d_=0;d_<2;++d_) _Pragma("unroll") for(int r=0;r<16;++r)o[d_][r]*=wsf[crow(r,hi)]; } }while(0)
  f32x16 pA0,pA1,pB0,pB1;
  int sl_prev=0,sl_cur=0,sl_next=SLOTB;
  #define ROT() do{sl_prev=sl_cur;sl_cur=sl_next;sl_next=(sl_next==(NSLOT-1)*SLOTB)?0:sl_next+SLOTB;}while(0)
  DMA_K(2,2*SLOTB);
  WAIT_BAR(3); MKPIN(mkE); MKPIN(mkO);
  qkt(pA0,pA1,Kbase,qr,negm,r32,hi);asm volatile("s_nop 15\n\ts_nop 7":"+v"(pA0),"+v"(pA1));CMASK(pA0,pA1,0);
  START(pA0,pA1);
  _Pragma("unroll") for(int r=0;r<16;++r)pA1[r]=__builtin_amdgcn_exp2f(pA1[r]);
  { _Pragma("unroll") for(int r=0;r<16;++r){MAND(pA0,r,mkE[0]);MAND(pA1,r,mkE[1]);} }
  WAIT_BAR(0);
  DMA_K(3,0);DMA_V(1,SLOTB);
  ROT();
  kload8(kf,kp0+sl_cur);
  WAIT_BAR(2);
  s16x4 vlo[8],vhi[8]; u32x4 pw0,pw1,pw2,pw3;
  #define PKW(P,B) cvtpk_s(P[B],P[B+1])
  #define PAF(k) __builtin_bit_cast(bf16x8,pw##k)
  #define VFR(i) (bf16x8){vlo[i][0],vlo[i][1],vlo[i][2],vlo[i][3],vhi[i][0],vhi[i][1],vhi[i][2],vhi[i][3]}
  #define PIN(x) asm volatile("":"+v"(x))
  #define MX3(a,b,c) __builtin_fmaxf(__builtin_fmaxf((a),(b)),(c))
  #define GAPA(MF,A0,A1,A2,A3,W0,W1,PW) do{ MF; sacc+=A0; sacc+=A1; sacc+=A2; sacc+=A3; PIN(sacc); W0; W1; PIN(PW); SBAR(); }while(0)
  #define EX(v) __builtin_amdgcn_exp2f(v)
  #define GAPB(MF,X,B,MW) do{ MF; X[B]=EX(X[B]); X[B+1]=EX(X[B+1]); X[B+2]=EX(X[B+2]); X[B+3]=EX(X[B+3]); MAND(X,B,MW); MAND(X,B+1,MW); MAND(X,B+2,MW); MAND(X,B+3,MW); PIN(X); SBAR(); }while(0)
  #define VRD(i) do{ vlo[i]=vtr(vp_+(((i)>>2)*4096+((i)&3)*1024)); vhi[i]=vtr(vp_+(((i)>>2)*4096+((i)&3)*1024+512)); }while(0)
  #define KRD(G,j) do{ if(G){ kload2(kf,kp0+sl_next,j); SBAR(); } }while(0)
  #define STEP(C0,C1,P0,P1,t,GK,GV,GL,GM,MK,MKN) do{ SBAR(); \
    if(GM){LDMASK(MKN,(t)+1);} \
    const lds_cptr vp_=vp0+sl_prev; \
    VRD(0); SBAR(); float sacc=(P0[0]+P0[1]); \
    GAPA(C0=MFMA16(kf[0],qr[0],negm,0,0,0), P0[2],P0[3],P0[4],P0[5],     pw0[0]=PKW(P0,0), pw0[1]=PKW(P0,2), pw0); \
    VRD(4); SBAR(); GAPA(C1=MFMA16(kf[1],qr[0],negm,0,0,0), P0[6],P0[7],P0[8],P0[9],     pw0[2]=PKW(P0,4), pw0[3]=PKW(P0,6), pw0); \
    VRD(1); SBAR(); GAPA(C0=MFMA16(kf[2],qr[1],C0,0,0,0),   P0[10],P0[11],P0[12],P0[13], pw1[0]=PKW(P0,8), pw1[1]=PKW(P0,10), pw1); \
    VRD(5); SBAR(); GAPA(C1=MFMA16(kf[3],qr[1],C1,0,0,0),   P0[14],P0[15],P1[0],P1[1],   pw1[2]=PKW(P0,12),pw1[3]=PKW(P0,14), pw1); \
    VRD(2); SBAR(); GAPA(C0=MFMA16(kf[4],qr[2],C0,0,0,0),   P1[2],P1[3],P1[4],P1[5],     pw2[0]=PKW(P1,0), pw2[1]=PKW(P1,2), pw2); \
    VRD(6); SBAR(); GAPA(C1=MFMA16(kf[5],qr[2],C1,0,0,0),   P1[6],P1[7],P1[8],P1[9],     pw2[2]=PKW(P1,4), pw2[3]=PKW(P1,6), pw2); \
    VRD(3); SBAR(); GAPA(C0=MFMA16(kf[6],qr[3],C0,0,0,0),   P1[10],P1[11],P1[12],P1[13], pw3[0]=PKW(P1,8), pw3[1]=PKW(P1,10), pw3); \
    VRD(7); SBAR(); GAPA(C1=MFMA16(kf[7],qr[3],C1,0,0,0),   P1[14],P1[15],0.f,0.f,       pw3[2]=PKW(P1,12),pw3[3]=PKW(P1,14), pw3); \
    l_reg+=sacc; \
    if(GK){DMA_K((t)+3,sl_cur);} if(GV){DMA_V((t)+1,sl_next);} \
    CMASK(C0,C1,t); \
    { float a=MX3(C0[0],C0[1],C1[0]),b=MX3(C0[2],C0[3],C1[1]); a=MX3(a,C1[2],C1[3]); \
      _Pragma("unroll") for(int r=4;r<16;r+=4){a=MX3(a,C0[r],C0[r+1]);b=MX3(b,C0[r+2],C0[r+3]);a=MX3(a,C1[r],C1[r+1]);b=MX3(b,C1[r+2],C1[r+3]);} \
      float rm=__builtin_fmaxf(a,b); { auto rr=__builtin_amdgcn_permlane32_swap(__float_as_uint(rm),__float_as_uint(rm),false,false); rm=__builtin_fmaxf(__uint_as_float(rr[0]),__uint_as_float(rr[1])); } \
      resc=false; \
      if(__builtin_expect(__any(rm>(float)THRL),0)){ const float dl=__builtin_fmaxf(rm,0.f); mhat+=dl; \
        _Pragma("unroll") for(int r=0;r<16;++r){C0[r]-=dl;C1[r]-=dl;} \
        _Pragma("unroll") for(int r=0;r<16;++r)negm[r]=-mhat; asm volatile("":"+v"(negm)); \
        const float f=__builtin_amdgcn_exp2f(-dl); l_reg*=f; if(hi==0)wsf[r32]=f; resc=true; } } \
    SBAR(); \
    GAPB(o[0]=MFMA16(PAF(0),VFR(0),o[0],0,0,0), C0,0,(MK)[0]); \
    GAPB(o[1]=MFMA16(PAF(0),VFR(4),o[1],0,0,0), C0,4,(MK)[0]); \
    KRD(GL,0); GAPB(o[0]=MFMA16(PAF(1),VFR(1),o[0],0,0,0), C0,8,(MK)[0]); \
    KRD(GL,1); GAPB(o[1]=MFMA16(PAF(1),VFR(5),o[1],0,0,0), C0,12,(MK)[0]); \
    KRD(GL,2); GAPB(o[0]=MFMA16(PAF(2),VFR(2),o[0],0,0,0), C1,0,(MK)[1]); \
    KRD(GL,3); GAPB(o[1]=MFMA16(PAF(2),VFR(6),o[1],0,0,0), C1,4,(MK)[1]); \
    GAPB(o[0]=MFMA16(PAF(3),VFR(3),o[0],0,0,0), C1,8,(MK)[1]); \
    GAPB(o[1]=MFMA16(PAF(3),VFR(7),o[1],0,0,0), C1,12,(MK)[1]); \
    }while(0)
  int t=1;
  #undef CMASK
  #define CMASK(P0,P1,t) do{}while(0)
  for(;t+5<NT;t+=2){
    STEP(pB0,pB1,pA0,pA1,t,true,true,true,true,mkO,mkE);     WAIT_BAR(2); MKPIN(mkE); RESC(); ROT();
    STEP(pA0,pA1,pB0,pB1,t+1,true,true,true,true,mkE,mkO);   WAIT_BAR(2); MKPIN(mkO); RESC(); ROT();
  }
  #define ENDW(tt) do{ if((tt)+3<NT){WAIT_BAR(2);} else if((tt)+2<NT){WAIT_BAR(1);} else {WAIT_BAR(0);} }while(0)
  for(;t+1<NT;t+=2){
    STEP(pB0,pB1,pA0,pA1,t,(t+3<NT),(t+1<NT),(t+1<NT),true,mkO,mkE);           ENDW(t);   MKPIN(mkE); RESC(); ROT();
    STEP(pA0,pA1,pB0,pB1,t+1,(t+4<NT),(t+2<NT),(t+2<NT),(t+2<NT),mkE,mkO);     ENDW(t+1); MKPIN(mkO); RESC(); ROT();
  }
  STEP(pB0,pB1,pA0,pA1,NT-1,false,false,false,false,mkO,mkE); RESC();
  { float sacc=pB0[0]+pB0[1]; _Pragma("unroll") for(int r=2;r<16;++r)sacc+=pB0[r]; _Pragma("unroll") for(int r=0;r<16;++r)sacc+=pB1[r]; l_reg+=sacc;
    pw0=(u32x4){PKW(pB0,0),PKW(pB0,2),PKW(pB0,4),PKW(pB0,6)};pw1=(u32x4){PKW(pB0,8),PKW(pB0,10),PKW(pB0,12),PKW(pB0,14)};pw2=(u32x4){PKW(pB1,0),PKW(pB1,2),PKW(pB1,4),PKW(pB1,6)};pw3=(u32x4){PKW(pB1,8),PKW(pB1,10),PKW(pB1,12),PKW(pB1,14)};
    SBAR(); pv(o,vb0+sl_cur,PAF(0),PAF(1),PAF(2),PAF(3)); }
  #undef PKW
  #undef PAF
  #undef VFR
  #undef PIN
  #undef MX3
  #undef GAPA
  #undef GAPB
  #undef EX
  #undef VRD
  #undef KRD
  #undef STEP
  #undef ENDW
  {auto rr=__builtin_amdgcn_permlane32_swap(__float_as_uint(l_reg),__float_as_uint(l_reg),false,false);l_reg=__uint_as_float(rr[0])+__uint_as_float(rr[1]);}
  if(hi==0)wsf[32+r32]=l_reg;asm volatile("s_waitcnt lgkmcnt(0)":::"memory");
  float rli[16];
  #pragma unroll
  for(int r=0;r<16;++r)rli[r]=__builtin_amdgcn_rcpf(wsf[32+crow(r,hi)]);
  bf16*Ow=O+(rowbase+q0+wid*QBLK)*DM+h*D;
  { bf16*stg=(bf16*)(shm+LDS_OST)+wid*2048;
    #pragma unroll
    for(int r=0;r<16;++r){const int orow=crow(r,hi);
      #pragma unroll
      for(int d0=0;d0<2;++d0)stg[orow*64+d0*32+r32]=(bf16)(o[d0][r]*rli[r]);}
    asm volatile("s_waitcnt lgkmcnt(0)":::"memory");
    #pragma unroll
    for(int i=0;i<4;++i){const int row=i*8+(lane>>3),ch=lane&7; const u32x4 v=*(const u32x4*)(stg+row*64+ch*8); ATTN_STORE16(Ow+(long)row*DM+ch*8,v);} }
  asm volatile("s_waitcnt lgkmcnt(0)\n\ts_barrier":::"memory");
  #undef LDMASK
  #undef MKPIN
  #undef MAND
  #undef DMA_K
  #undef DMA_V
  #undef CMASK
  #undef START
  #undef RESC
  #undef ROT
}
constexpr int ATTN_LDS_BYTES=LDS_BYTES;
struct AttnTensors { const bf16* Q; const bf16* K; const bf16* V; bf16* O; const unsigned* BM; };
struct AttnUnit { int bh; int qb; };
struct StaticOrder {
  int vcu;
  __device__ __forceinline__ explicit StaticOrder(int grid,int block):vcu((block%8)*(grid/8)+block/8){}
  __device__ __forceinline__ bool next(int i,AttnUnit&u)const{ if(i>=4)return false; const int s=vcu&7; u.bh=vcu>>3; u.qb=(i==0)?s:(i==1)?15-s:(i==2)?16+s:31-s; return true; }
  __device__ __forceinline__ void a_ready(const AttnUnit&)const{}
  __device__ __forceinline__ void done(const AttnUnit&)const{}
};
template<class Sched,int THRL=8> __device__ __forceinline__ void attn_phase(char*lds,const AttnTensors&T,const Sched&S){
  AttnUnit u;
  for(int i=0;S.next(i,u);++i){ S.a_ready(u); attn_unit<THRL>(u.bh/NHEAD,u.bh%NHEAD,u.qb,T.Q,T.K,T.V,T.O,T.BM,lds); S.done(u); }
}

constexpr float STICK_STOP=-30.0f;
__device__ __forceinline__ void stick_unit(int b,int h,int qb,const bf16*Q,const bf16*__restrict__ K,const bf16*__restrict__ V,bf16*O,char*shm){
  const int tid=threadIdx.x,lane=tid&63,r32=lane&31,hi=lane>>5; const int wid=__builtin_amdgcn_readfirstlane(tid>>6);
  const long rowbase=(long)b*SEQ; const int q0=qb*QB,q0w=q0+wid*QBLK,trow=q0w+r32;
  const bf16*Qw=Q+(rowbase+q0w)*DM+h*D;
  const bf16*Kh=K+rowbase*DM+h*D,*Vh=V+rowbase*DM+h*D;
  const unsigned lds0=(unsigned)(uintptr_t)shm;
  const bf16*ksrc=Kh+(long)lane*DM+wid*8;
  const bf16*vsrc=Vh+(long)(16*(wid&3)+(lane>>2))*DM+(wid>>2)*32+(lane&3)*8;
  const unsigned kdst=lds0+LDS_K+wid*1024, vdst=lds0+LDS_V+wid*1024;
  #define DMA_K(t,slot) glds16(ksrc+(long)(t)*KVBLK*DM,(unsigned)__builtin_amdgcn_readfirstlane(kdst+(slot)))
  #define DMA_V(t,slot) glds16(vsrc+(long)(t)*KVBLK*DM,(unsigned)__builtin_amdgcn_readfirstlane(vdst+(slot)))
  const int vb0=(int)(lds0+LDS_V)+((lane>>4)&1)*32+(lane&3)*8+(4*hi+((lane&15)>>2))*64;
  volatile __attribute__((address_space(3))) unsigned*flags=(volatile __attribute__((address_space(3))) unsigned*)((__attribute__((address_space(3))) char*)shm+LDS_WS);
  const int Thi=4*qb+3,Tw0=(q0w+31)>>6;
  DMA_K(Thi,0);DMA_V(Thi,0); if(Thi>0){DMA_K(Thi-1,SLOTB);DMA_V(Thi-1,SLOTB);}
  bf16x8 qr[4];
  #pragma unroll
  for(int d0=0;d0<4;++d0)qr[d0]=*reinterpret_cast<const bf16x8*>(&Qw[(long)r32*DM+d0*16+hi*8]);
  f32x16 o[2];o[0]=f32x16{};o[1]=f32x16{}; f32x16 zero16=f32x16{};
  float carry=0.f; bool done=false;
  if(Thi>0){WAIT_BAR(2);}else{WAIT_BAR(0);}
  int slot=0,slot1=SLOTB,slot2=2*SLOTB;
  for(int T=Thi;;--T){
    const int par=(Thi-T)&1;
    if(T>1){DMA_K(T-2,slot2);DMA_V(T-2,slot2);}
    if(T<=Tw0&&!done){
      f32x16 p0,p1; qkt(p0,p1,shm+LDS_K+slot,qr,zero16,r32,hi);
      const int kb=T*KVBLK+4*hi;
      f32x16 l0,l1;
      #pragma unroll
      for(int r=0;r<16;++r){ const int key=kb+(r&3)+8*(r>>2);
        { const float z=p0[r],sp=__builtin_fmaxf(z,0.f)+__builtin_amdgcn_logf(1.f+__builtin_amdgcn_exp2f(-__builtin_fabsf(z))); const bool v=key<trow; l0[r]=v?-sp:0.f; p0[r]=v?z-sp:-INFINITY; }
        { const float z=p1[r],sp=__builtin_fmaxf(z,0.f)+__builtin_amdgcn_logf(1.f+__builtin_amdgcn_exp2f(-__builtin_fabsf(z))); const bool v=key+32<trow; l1[r]=v?-sp:0.f; p1[r]=v?z-sp:-INFINITY; } }
      float GE[8],GO[8];
      #pragma unroll
      for(int j=0;j<8;++j){ const float g=(j<4)?((l0[4*j]+l0[4*j+1])+(l0[4*j+2]+l0[4*j+3])):((l1[4*(j-4)]+l1[4*(j-4)+1])+(l1[4*(j-4)+2]+l1[4*(j-4)+3]));
        auto rr=__builtin_amdgcn_permlane32_swap(__float_as_uint(g),__float_as_uint(g),false,false); GE[j]=__uint_as_float(rr[0]); GO[j]=__uint_as_float(rr[1]); }
      float run=0.f,base[8];
      #pragma unroll
      for(int j=7;j>=0;--j){ const float so=run; run+=GO[j]; const float se=run; run+=GE[j]; base[j]=carry+(hi?so:se); }
      #pragma unroll
      for(int j=0;j<4;++j){
        { const float a3=base[j],a2=a3+l0[4*j+3],a1=a2+l0[4*j+2],a0=a1+l0[4*j+1];
          p0[4*j+3]=__builtin_amdgcn_exp2f(p0[4*j+3]+a3); p0[4*j+2]=__builtin_amdgcn_exp2f(p0[4*j+2]+a2); p0[4*j+1]=__builtin_amdgcn_exp2f(p0[4*j+1]+a1); p0[4*j]=__builtin_amdgcn_exp2f(p0[4*j]+a0); }
        { const float a3=base[4+j],a2=a3+l1[4*j+3],a1=a2+l1[4*j+2],a0=a1+l1[4*j+1];
          p1[4*j+3]=__builtin_amdgcn_exp2f(p1[4*j+3]+a3); p1[4*j+2]=__builtin_amdgcn_exp2f(p1[4*j+2]+a2); p1[4*j+1]=__builtin_amdgcn_exp2f(p1[4*j+1]+a1); p1[4*j]=__builtin_amdgcn_exp2f(p1[4*j]+a0); } }
      carry+=run;
      u32x4 pw0,pw1,pw2,pw3;
      #define PKW(P,B) cvtpk_s(P[B],P[B+1])
      pw0=(u32x4){PKW(p0,0),PKW(p0,2),PKW(p0,4),PKW(p0,6)};pw1=(u32x4){PKW(p0,8),PKW(p0,10),PKW(p0,12),PKW(p0,14)};pw2=(u32x4){PKW(p1,0),PKW(p1,2),PKW(p1,4),PKW(p1,6)};pw3=(u32x4){PKW(p1,8),PKW(p1,10),PKW(p1,12),PKW(p1,14)};
      #undef PKW
      SBAR(); pv(o,vb0+slot,__builtin_bit_cast(bf16x8,pw0),__builtin_bit_cast(bf16x8,pw1),__builtin_bit_cast(bf16x8,pw2),__builtin_bit_cast(bf16x8,pw3));
      done=__all(carry<STICK_STOP);
    }
    if(T==0)done=true;
    if(lane==0)flags[par*8+wid]=done?1u:0u;
    if(T>1){WAIT_BAR(2);}else{WAIT_BAR(0);}
    { const int s_=slot; slot=slot1; slot1=slot2; slot2=s_; }
    unsigned alld=1u;
    #pragma unroll
    for(int w=0;w<8;++w)alld&=flags[par*8+w];
    if(alld)break;
  }
  asm volatile("s_waitcnt vmcnt(0)":::"memory");
  bf16*Ow=O+(rowbase+q0w)*DM+h*D;
  { bf16*stg=(bf16*)(shm+LDS_OST)+wid*2048;
    #pragma unroll
    for(int r=0;r<16;++r){const int orow=crow(r,hi);
      #pragma unroll
      for(int d0=0;d0<2;++d0)stg[orow*64+d0*32+r32]=(bf16)(o[d0][r]);}
    asm volatile("s_waitcnt lgkmcnt(0)":::"memory");
    #pragma unroll
    for(int i=0;i<4;++i){const int row=i*8+(lane>>3),ch=lane&7; const u32x4 v=*(const u32x4*)(stg+row*64+ch*8); ATTN_STORE16(Ow+(long)row*DM+ch*8,v);} }
  asm volatile("s_waitcnt lgkmcnt(0)\n\ts_barrier":::"memory");
  #undef DMA_K
  #undef DMA_V
}
#undef SBAR
#undef WAIT_BAR
#undef MFMA16
}

__device__ __forceinline__ void stick_item(const Ctx& C, LAS float* attw, int b, int t, int h, int lane) {
    f16* QB = (f16*)(C.ws + WS_QB); const f16* KB = (const f16*)(C.ws + WS_KB); const f16* VB = (const f16*)(C.ws + WS_VB);
    const size_t brow = (size_t)b * SEQ, row = brow + t;
    u32x4 q[8];
#pragma unroll
    for (int i = 0; i < 8; ++i) q[i] = ((const u32x4*)(QB + row * 512 + h * 64))[i];
    float o = 0.f, carry = 0.f;
    for (int base = 0; base < t; base += 64) {
        const int s = t - 1 - base - lane; const bool valid = s >= 0;
        float z = 0.f;
        if (valid) { const u32x4* kp = (const u32x4*)(KB + (brow + s) * 512 + h * 64);
#pragma unroll
            for (int i = 0; i < 8; ++i) z = dot2x4(q[i], kp[i], z); }
        z *= 0.6931471805599453f;
        const float L = log1pf(expf(-fabsf(z)));
        const float l1m = valid ? -(fmaxf(z, 0.f) + L) : 0.f;
        const float lsg = fminf(z, 0.f) - L;
        float incl = l1m;
#pragma unroll
        for (int ofs = 1; ofs < 64; ofs <<= 1) { const float u = __shfl_up(incl, ofs); if (lane >= ofs) incl += u; }
        const float after = carry + (incl - l1m);
        const float att = valid ? expf(lsg + after) : 0.f;
        carry += __shfl(incl, 63);
        attw[lane] = att;
        asm volatile("s_waitcnt lgkmcnt(0)" ::: "memory");
        const int cnt = (t - base) < 64 ? (t - base) : 64;
        const f16* vp = VB + (brow + (t - 1 - base)) * 512 + h * 64 + lane;
#pragma unroll 8
        for (int l = 0; l < cnt; ++l) o += attw[l] * (float)vp[-(ptrdiff_t)l * 512];
        asm volatile("s_waitcnt lgkmcnt(0)" ::: "memory");
        if (carry < -105.f) break;
    }
    ((f16*)(C.ws + WS_OB))[row * 512 + h * 64 + lane] = (f16)o;
}

#ifndef DIAG
#define DIAG 0
#endif
#if DIAG
constexpr size_t WS_DIAG = 500 * MiB;
__device__ __forceinline__ unsigned hash_u(unsigned x) { x ^= x >> 16; x *= 0x7feb352dU; x ^= x >> 15; x *= 0x846ca68bU; x ^= x >> 16; return x; }
__device__ __forceinline__ bool close_(float got, float ref) { return fabsf(got - ref) <= 0.02f * fabsf(ref) + 0.01f; }
#endif
constexpr size_t WS_CTL = 36 * MiB;
constexpr int LDS_MISC = LDS_BYTES - 64;
#define XB_TMO      128
#define XB_XCNT(j)  (256  + 64 * (j))
#define XB_XSUB(j)  (1280 + 64 * (j))
#define XB_XGEN(j)  (2304 + 64 * (j))
#define XB_TOP      3328
#define XB_TOPGEN   3392
#define XCD_BAR_WORDS 3456
#define XB_SPIN_CAP (1u << 18)

__device__ __forceinline__ unsigned xb_ld(unsigned* p)              { return __hip_atomic_load(p, __ATOMIC_RELAXED, __HIP_MEMORY_SCOPE_AGENT); }
__device__ __forceinline__ unsigned xb_add(unsigned* p, unsigned v) { return __hip_atomic_fetch_add(p, v, __ATOMIC_RELAXED, __HIP_MEMORY_SCOPE_AGENT); }
__device__ __forceinline__ unsigned xb_xcc_id() { return (unsigned)__builtin_amdgcn_s_getreg((3 << 11) | 20) & 0xFu; }
#define XB_SPIN(cond, bar) do { unsigned _sp = 0; while (cond) { __builtin_amdgcn_s_sleep(1); \
    if ((++_sp & 255u) == 0u) { if (xb_ld(&(bar)[XB_TMO])) break; if (_sp > XB_SPIN_CAP) { atomicAdd(&(bar)[XB_TMO], 1u); break; } } } } while (0)

struct XcdBarrier {
    unsigned* bar; unsigned x;
    volatile LAS unsigned* st;
};

__device__ __forceinline__ XcdBarrier xcd_barrier_post(unsigned* bar, volatile LAS unsigned* st) {
    XcdBarrier b; b.bar = bar; b.x = xb_xcc_id(); b.st = st;
    if (threadIdx.x == 0) (void)xb_add(&bar[XB_XCNT(b.x)], 1u);
    return b;
}
__device__ __forceinline__ void xcd_barrier_complete(unsigned* bar, unsigned x, unsigned& nloc, unsigned& nx) {
    const unsigned G = gridDim.x * gridDim.y * gridDim.z;
    unsigned sum, cnt, mine, sp = 0u;
    for (;;) {
        sum = 0u; cnt = 0u; mine = 0u;
#pragma unroll
        for (unsigned j = 0; j < 16; ++j) { const unsigned c = xb_ld(&bar[XB_XCNT(j)]); sum += c; cnt += (c > 0u) ? 1u : 0u; mine = (j == x) ? c : mine; }
        if (sum == G) break;
        __builtin_amdgcn_s_sleep(1);
        if ((++sp & 255u) == 0u) { if (xb_ld(&bar[XB_TMO])) break; if (sp > XB_SPIN_CAP) { atomicAdd(&bar[XB_TMO], 1u); break; } }
    }
    nloc = mine > 0u ? mine : 1u; nx = cnt > 0u ? cnt : 1u;
}

__device__ __forceinline__ void xcd_barrier(const XcdBarrier& b) {
    asm volatile("s_waitcnt vmcnt(0)" ::: "memory");
    __syncthreads();
    if (threadIdx.x == 0) {
        unsigned* bar = b.bar;
        __builtin_amdgcn_s_waitcnt(0);
        unsigned nloc = b.st[0], nx = b.st[1];
        if (nloc == 0u) { xcd_barrier_complete(bar, b.x, nloc, nx); b.st[0] = nloc; b.st[1] = nx; }
        const unsigned old = xb_add(&bar[XB_XSUB(b.x)], 1u);
        const unsigned gen = old / nloc;
        if (old + 1u == (gen + 1u) * nloc) {
            __builtin_amdgcn_fence(__ATOMIC_RELEASE, "agent");
            asm volatile("s_waitcnt vmcnt(0)" ::: "memory");
            const unsigned og = xb_add(&bar[XB_TOP], 1u);
            const unsigned tg = og / nx;
            if (og + 1u == (tg + 1u) * nx) xb_add(&bar[XB_TOPGEN], 1u);
            else XB_SPIN(xb_ld(&bar[XB_TOPGEN]) == tg, bar);
            __builtin_amdgcn_fence(__ATOMIC_ACQUIRE, "agent");
            xb_add(&bar[XB_XGEN(b.x)], 1u);
            asm volatile("s_waitcnt vmcnt(0)" ::: "memory");
        } else {
            XB_SPIN(xb_ld(&bar[XB_XGEN(b.x)]) == gen, bar);
            __builtin_amdgcn_fence(__ATOMIC_ACQUIRE, "agent");
            asm volatile("s_waitcnt vmcnt(0)" ::: "memory");
        }
    }
    __syncthreads();
}


struct Args { const float* in[14]; float* out; unsigned char* ws; int ph_lo, ph_hi; };
constexpr int NPHASES = 12;

__global__ void __launch_bounds__(NTHREADS, 2) hyb_fwd(Args args) {
    extern __shared__ __attribute__((aligned(16))) unsigned char lds_raw[];
    LAS unsigned char* lds = (LAS unsigned char*)lds_raw;
    cg::grid_group grid = cg::this_grid();
    Ctx C;
    C.x = args.in[0]; C.c = args.in[1]; C.w_ada = args.in[2]; C.b_ada = args.in[3]; C.g_pre_mix = args.in[4]; C.w_in = args.in[5]; C.w_up_a = args.in[6]; C.w_up_b = args.in[7];
    C.w_out = args.in[8]; C.g_post_mix = args.in[9]; C.g_pre_ffn = args.in[10]; C.w_ff1 = args.in[11]; C.w_ff2 = args.in[12]; C.g_post_ffn = args.in[13];
    C.out = args.out; C.ws = args.ws; C.G = gridDim.x;
    { const int bx = blockIdx.x; C.vcu = (C.G % 8 == 0) ? (bx % 8) * (C.G / 8) + bx / 8 : bx; }
    const int lo = args.ph_lo, hi = args.ph_hi;
    const int tid = threadIdx.x, lane = tid & 63, wave = tid >> 6;
    if (tid < 16) ((LAS unsigned*)(lds + LDS_MISC))[tid] = 0u;
    __syncthreads();
    XcdBarrier xbar = xcd_barrier_post((unsigned*)(args.ws + WS_CTL), (volatile LAS unsigned*)(lds + LDS_MISC));
#ifndef REP_MASK
#define REP_MASK 0
#endif
#define REPS(k) (((REP_MASK >> (k)) & 1) ? 2 : 1)
#define IN(k) (lo <= (k) && (k) < hi)
#define SEAM(k) do { if (IN(k) && IN((k) + 1)) { if ((k) == 0) grid.sync(); else xcd_barrier(xbar); } } while (0)
    unsigned char* ws = C.ws;

    if (IN(0)) { p0_prologue(C, lds); } SEAM(0);
    if (IN(1)) { p1_norm_rows(C); } SEAM(1);
    if (IN(2)) {
        pg8::Gemm g{(const f16*)(ws + WS_H), (const f16*)(ws + WS_WIN), M, NPROJ, DM}; pg8::StaticOrder S; S.init(M, NPROJ, C.G, (int)blockIdx.x);
        EpiProj E{ws}; pg8::gemm_phase<EpiProj>(lds, g, S, E);
#ifdef DUP_PROJ
        pg8::gemm_phase<EpiProj>(lds, g, S, E);
#endif
    } SEAM(2);
    if (IN(3)) {
        for (int i = C.vcu; i < 1024; i += C.G) { const int b = i >> 8, j = i & 255, blk = (b & 1) ? 255 - j : j; ix_unit_s(C, lds, b, 32 * blk, (unsigned*)(ws + WS_BM)); }
#ifdef IXVAR
        for (int i = C.vcu; i < 1024; i += C.G) { const int b = i >> 8, j = i & 255, blk = (b & 1) ? 255 - j : j; ix_unit<IXVAR>(C, lds, b, 32 * blk, (unsigned*)(ws + WS_H)); }
#endif
#if DIAG
        __syncthreads();
        for (int i = C.vcu; i < 256; i += C.G) { const int row = (int)(hash_u(i * 2654435761u + 17u) % (unsigned)M); row_select_slow(C, lds, row / SEQ, row % SEQ, (unsigned*)(ws + WS_DIAG + MiB) + i * 256, 256); }
#endif
    } SEAM(3);
    if (IN(4)) {
        __syncthreads();
        {
            const attn_body::AttnTensors AT{(const attn_body::bf16*)(ws + WS_QA), (const attn_body::bf16*)(ws + WS_KA), (const attn_body::bf16*)(ws + WS_VA), (attn_body::bf16*)(ws + WS_OA), (const unsigned*)(ws + WS_BM)};
            for (int rp = 0; rp < REPS(4); ++rp)
            if (C.G == 256) { const attn_body::StaticOrder S((int)C.G, (int)blockIdx.x); attn_body::attn_phase<attn_body::StaticOrder>((char*)lds_raw, AT, S); }
            else { for (int i = C.vcu; i < 1024; i += C.G) attn_body::attn_unit<8>((i >> 5) / 8, (i >> 5) % 8, i & 31, AT.Q, AT.K, AT.V, AT.O, AT.BM, (char*)lds_raw); }
        }
        __syncthreads();
        for (int rp = 0; rp < REPS(12); ++rp)
        for (int i = C.vcu; i < 1024; i += C.G) attn_body::stick_unit((i >> 5) / 8, (i >> 5) % 8, i & 31, (const attn_body::bf16*)(ws + WS_QB), (const attn_body::bf16*)(ws + WS_KB), (const attn_body::bf16*)(ws + WS_VB), (attn_body::bf16*)(ws + WS_OB), (char*)lds_raw);
        (void)wave; (void)lane;
#if DIAG
        __syncthreads();
        for (int i = C.vcu; i < 256; i += C.G) { const int row = (int)(hash_u(i * 2654435761u + 17u) % (unsigned)M); row_unit(C, lds, row / SEQ, row % SEQ, (f16*)(ws + WS_DIAG + 2 * MiB) + i * 512, (const unsigned*)(ws + WS_BM) + (size_t)row * 256); }
#endif
    } SEAM(4);
    if (IN(5)) {
        pg8::Gemm g{(const f16*)(ws + WS_OA), (const f16*)(ws + WS_WUPA), M, DM, 512}; pg8::StaticOrder S; S.init(M, DM, C.G, (int)blockIdx.x);
        EpiGate<0> E{(const f16*)(ws + WS_GA), nullptr, (f16*)(ws + WS_T1)}; pg8::gemm_phase<EpiGate<0>>(lds, g, S, E);
    } SEAM(5);
    if (IN(6)) {
        pg8::Gemm g{(const f16*)(ws + WS_OB), (const f16*)(ws + WS_WUPB), M, DM, 512}; pg8::StaticOrder S; S.init(M, DM, C.G, (int)blockIdx.x);
        EpiGate<1> E{(const f16*)(ws + WS_GB), (const f16*)(ws + WS_T1), (f16*)(ws + WS_MG)}; pg8::gemm_phase<EpiGate<1>>(lds, g, S, E);
    } SEAM(6);
    if (IN(7)) {
        pg8::Gemm g{(const f16*)(ws + WS_MG), (const f16*)(ws + WS_WOUT), M, DM, DM}; pg8::StaticOrder S; S.init(M, DM, C.G, (int)blockIdx.x);
        EpiF16 E{(f16*)(ws + WS_Y), DM}; pg8::gemm_phase<EpiF16>(lds, g, S, E);
    } SEAM(7);
    if (IN(8)) { p7_rows(C); } SEAM(8);
    if (IN(9)) {
        pg8::Gemm g{(const f16*)(ws + WS_H), (const f16*)(ws + WS_WFF1), M, DFF, DM}; pg8::StaticOrder S; S.init(M, DFF, C.G, (int)blockIdx.x);
        EpiSqRelu E{(f16*)(ws + WS_U), DFF}; pg8::gemm_phase<EpiSqRelu>(lds, g, S, E);
#ifdef DUP_FFN
        pg8::gemm_phase<EpiSqRelu>(lds, g, S, E);
#endif
    } SEAM(9);
    if (IN(10)) {
        pg8::Gemm g{(const f16*)(ws + WS_U), (const f16*)(ws + WS_WFF2), M, DM, DFF}; pg8::StaticOrder S; S.init(M, DM, C.G, (int)blockIdx.x);
        EpiF16 E{(f16*)(ws + WS_Y2), DM}; pg8::gemm_phase<EpiF16>(lds, g, S, E);
#ifdef DUP_FFN
        pg8::gemm_phase<EpiF16>(lds, g, S, E);
#endif
    } SEAM(10);
    if (IN(11)) { p10_rows(C); }
#undef IN
#undef SEAM
}


#if DIAG
__device__ __forceinline__ float projdot(const Args& a, int row, int n) {
    const f16* H = (const f16*)(a.ws + WS_H); const float* w = a.in[5]; const int sc = win_src(n); float s = 0.f;
    for (int k = 0; k < DM; ++k) s += (float)H[(size_t)row * DM + k] * w[(size_t)k * 5704 + sc];
    return s;
}
__global__ void diag_kernel(Args a, int test, int nsamp) {
    const int i = blockIdx.x * blockDim.x + threadIdx.x; if (i >= nsamp) return;
    unsigned char* ws = a.ws; unsigned* cnt = (unsigned*)(ws + WS_DIAG);
    const float* MOD = (const float*)(ws + WS_MOD);
    int bad = 0;
    const int row = (int)(hash_u(i * 2654435761u + 17u) % (unsigned)M), b = row / SEQ, pos = row % SEQ;
    if (test == 0) {
        const int bb = i & 3, n = (int)(hash_u(i + 99u) % 6144u); float s = a.in[3][n];
        for (int k = 0; k < DM; ++k) { const float v = a.in[1][bb * DM + k]; s += (v / (1.f + expf(-v))) * a.in[2][(size_t)k * 6144 + n]; }
        bad = !close_(MOD[bb * 6144 + n], s);
    } else if (test == 1) {
        float ss = 0.f; for (int k = 0; k < DM; ++k) { const float v = a.in[0][(size_t)row * DM + k]; ss += v * v; }
        const float r = 1.f / sqrtf(ss / DM + EPS); const f16* H = (const f16*)(ws + WS_H);
        for (int j = 0; j < 4; ++j) { const int col = (int)(hash_u(i * 4 + j + 5u) % 1024u);
            const float ref = a.in[0][(size_t)row * DM + col] * r * a.in[4][col] * (1.f + MOD[b * 6144 + 1024 + col]) + MOD[b * 6144 + col];
            bad |= !close_((float)H[(size_t)row * DM + col], ref); }
    } else if (test == 2) {
        const int n = (int)(hash_u(i * 7u + 1u) % 5704u);
        float ref = projdot(a, row, n), got;
        const float invf[8] = {1.0f, 0.1939227432012558f, 0.03760603070259094f, 0.007292664609849453f, 0.0014142135623842478f, 0.00027424818836152554f, 5.3182957344688475e-05f, 1.0313385246263351e-05f};
        if (n < 3584) {
            const int t = n / 512, cl = n % 512, d = cl & 63;
            if ((t == 0 || t == 1 || t == 6) && d < 16) { const float rp = projdot(a, row, d < 8 ? n + 8 : n - 8);
                float f = 1.f; for (int q = 0; q < 8; ++q) if ((d & 7) == q) f = invf[q];
                const float ang = (float)pos * f, cs = cosf(ang), sn = sinf(ang); ref = d < 8 ? ref * cs - rp * sn : ref * cs + rp * sn; }
            if (t == 0 || t == 3) ref *= 0.125f * 1.4426950408889634f;
            const size_t off = (t == 0) ? WS_QA : (t == 1) ? WS_KA : (t == 2) ? WS_VA : (t == 3) ? WS_QB : (t == 4) ? WS_KB : (t == 5) ? WS_VB : WS_QI;
            got = (float)((const f16*)(ws + off))[(size_t)row * 512 + cl];
        } else if (n < 5632) { const int g = n - 3584; got = (g < 1024) ? (float)((const f16*)(ws + WS_GA))[(size_t)row * 1024 + g] : (float)((const f16*)(ws + WS_GB))[(size_t)row * 1024 + g - 1024]; }
        else { const int k = n - 5632;
            if (k < 64) { if (k < 16) { const float rp = projdot(a, row, k < 8 ? n + 8 : n - 8); float f = 1.f; for (int q = 0; q < 8; ++q) if ((k & 7) == q) f = invf[q];
                    const float ang = (float)pos * f, cs = cosf(ang), sn = sinf(ang); ref = k < 8 ? ref * cs - rp * sn : ref * cs + rp * sn; }
                got = (float)((const f16*)(ws + WS_KI))[(size_t)row * 64 + k]; }
            else got = ((const float*)(ws + WS_WI))[(size_t)row * 8 + (k - 64)]; }
        bad = !close_(got, ref);
    } else if (test == 3) {
        const int h = i & 7; const f16* QB = (const f16*)(ws + WS_QB); const f16* KB = (const f16*)(ws + WS_KB); const f16* VB = (const f16*)(ws + WS_VB); const f16* OB = (const f16*)(ws + WS_OB);
        const int d0 = (int)(hash_u(i + 1234u) % 16u) * 4;
        double o0 = 0, o1 = 0, o2 = 0, o3 = 0, after = 0;
        for (int s = pos - 1; s >= 0 && after > -200.0; --s) {
            const f16* kp = KB + ((size_t)b * SEQ + s) * 512 + h * 64; const f16* qp = QB + (size_t)row * 512 + h * 64; double z = 0;
            for (int d = 0; d < 64; ++d) z += (double)(float)qp[d] * (double)(float)kp[d];
            z *= 0.6931471805599453;
            const double L = log1p(exp(-fabs(z))), lsg = fmin(z, 0.0) - L, l1m = -(fmax(z, 0.0) + L), att = exp(lsg + after);
            const f16* vp = VB + ((size_t)b * SEQ + s) * 512 + h * 64 + d0;
            o0 += att * (double)(float)vp[0]; o1 += att * (double)(float)vp[1]; o2 += att * (double)(float)vp[2]; o3 += att * (double)(float)vp[3];
            after += l1m; }
        const f16* op = OB + (size_t)row * 512 + h * 64 + d0;
        bad = !close_((float)op[0], (float)o0) || !close_((float)op[1], (float)o1) || !close_((float)op[2], (float)o2) || !close_((float)op[3], (float)o3);
    } else if (test == 4) {
        const int col = (int)(hash_u(i * 3u + 7u) % 1024u); const f16* OA = (const f16*)(ws + WS_OA); const f16* OB = (const f16*)(ws + WS_OB);
        float ya = 0.f, yb = 0.f; for (int k = 0; k < 512; ++k) { ya += (float)OA[(size_t)row * 512 + k] * a.in[6][(size_t)k * 1024 + col]; yb += (float)OB[(size_t)row * 512 + k] * a.in[7][(size_t)k * 1024 + col]; }
        const float ga = (float)((const f16*)(ws + WS_GA))[(size_t)row * 1024 + col], gb = (float)((const f16*)(ws + WS_GB))[(size_t)row * 1024 + col];
        const float ref = ya / (1.f + expf(-ga)) + yb / (1.f + expf(-gb));
        bad = !close_((float)((const f16*)(ws + WS_MG))[(size_t)row * 1024 + col], ref);
    } else if (test == 5) {
        const int col = (int)(hash_u(i * 3u + 11u) % 1024u); const f16* MG = (const f16*)(ws + WS_MG);
        float y = 0.f; for (int k = 0; k < 1024; ++k) y += (float)MG[(size_t)row * 1024 + k] * a.in[8][(size_t)k * 1024 + col];
        bad = !close_((float)((const f16*)(ws + WS_Y))[(size_t)row * 1024 + col], y);
    } else if (test == 6) {
        const f16* Y = (const f16*)(ws + WS_Y); float ss = 0.f; for (int k = 0; k < DM; ++k) { const float v = (float)Y[(size_t)row * DM + k]; ss += v * v; }
        const float r = 1.f / sqrtf(ss / DM + EPS); float s2 = 0.f;
        for (int k = 0; k < DM; ++k) { const float x1 = a.in[0][(size_t)row * DM + k] + MOD[b * 6144 + 2048 + k] * ((float)Y[(size_t)row * DM + k] * r * a.in[9][k]); s2 += x1 * x1; }
        const float r2 = 1.f / sqrtf(s2 / DM + EPS); const f16* H = (const f16*)(ws + WS_H);
        for (int j = 0; j < 4; ++j) { const int k = (int)(hash_u(i * 4 + j + 55u) % 1024u);
            const float x1 = a.in[0][(size_t)row * DM + k] + MOD[b * 6144 + 2048 + k] * ((float)Y[(size_t)row * DM + k] * r * a.in[9][k]);
            bad |= !close_(a.out[(size_t)row * DM + k], x1);
            const float h2 = x1 * r2 * a.in[10][k] * (1.f + MOD[b * 6144 + 4096 + k]) + MOD[b * 6144 + 3072 + k];
            bad |= !close_((float)H[(size_t)row * DM + k], h2); }
    }
    else if (test == 7) {
        const unsigned* BMr = (const unsigned*)(ws + WS_BM) + (size_t)row * 256; const unsigned* BS = (const unsigned*)(ws + WS_DIAG + MiB) + (size_t)i * 256;
        int d = 0, pc = 0; for (int w = 0; w <= (pos >> 5); ++w) { d += __popc(BMr[w] ^ BS[w]); pc += __popc(BMr[w]); }
        const int want = (pos + 1) < TOPK ? (pos + 1) : TOPK;
        if (d > 0) atomicAdd(&cnt[7], 1u); if (d > 4) atomicAdd(&cnt[8], 1u); if (pc != want) atomicAdd(&cnt[9], 1u);
        return;
    } else if (test == 10) {
        const f16* OA = (const f16*)(ws + WS_OA) + (size_t)row * 512; const f16* OR = (const f16*)(ws + WS_DIAG + 2 * MiB) + (size_t)i * 512;
        for (int k = 0; k < 512; ++k) bad |= !close_((float)OA[k], (float)OR[k]);
    }
    if (bad) atomicAdd(&cnt[test], 1u);
}
__global__ void diag_final(Args a, int ntests) {
    unsigned* cnt = (unsigned*)(a.ws + WS_DIAG);
    __shared__ unsigned AB[2];
    if (threadIdx.x == 0 && blockIdx.x == 0) { }
    unsigned A = cnt[10]; if (cnt[8] > 0u) A += 1000u; if (cnt[9] > 0u) A += 2000u;
    for (int t = 0; t < 7; ++t) if (cnt[t] > 4u) { A += 4000u; break; }
    const unsigned B = cnt[7];
    const int i = blockIdx.x * blockDim.x + threadIdx.x;
    if (i == 0) a.out[0] += 1.0e5f * (float)A;
    else if (i < (1 << 20)) a.out[i] += 30.0f * (float)B;
    (void)AB; (void)ntests;
}
#endif

extern "C" void kernel_launch(void* const* d_in, const int* in_sizes, int n_in, void* d_out, int out_size, void* d_ws, size_t ws_size, hipStream_t stream) {
    static int grid = 0;
    if (grid == 0) {
        if (n_in != 14 || out_size != M * DM || ws_size < WS_END) { fprintf(stderr, "kernel_launch: unexpected shapes n_in %d out %d ws %zu\n", n_in, out_size, ws_size); grid = -1; return; }
        int dev = 0, cus = 0, per_cu = 0;
        (void)hipGetDevice(&dev); (void)hipDeviceGetAttribute(&cus, hipDeviceAttributeMultiprocessorCount, dev);
        (void)hipFuncSetAttribute((const void*)hyb_fwd, hipFuncAttributeMaxDynamicSharedMemorySize, LDS_BYTES);
        (void)hipOccupancyMaxActiveBlocksPerMultiprocessor(&per_cu, (const void*)hyb_fwd, NTHREADS, LDS_BYTES);
        if (per_cu < 1) { fprintf(stderr, "kernel_launch: occupancy query says %d blocks/CU\n", per_cu); per_cu = 1; }
        (void)hipGetLastError();
        grid = cus * 1;
        fprintf(stderr, "kernel_launch: cus %d per_cu %d grid %d\n", cus, per_cu, grid);
    }
    if (grid < 0) return;
    (void)hipMemsetAsync((unsigned char*)d_ws + WS_CTL, 0, 16384, stream);
    Args a{};
    for (int i = 0; i < 14; ++i) a.in[i] = (const float*)d_in[i];
    a.out = (float*)d_out; a.ws = (unsigned char*)d_ws;
#if MK_SINGLE
    a.ph_lo = 0; a.ph_hi = NPHASES;
    { void* kargs[] = {&a}; hipError_t e = hipLaunchCooperativeKernel((const void*)hyb_fwd, dim3(grid), dim3(NTHREADS), kargs, LDS_BYTES, stream);
      if (e != hipSuccess) fprintf(stderr, "cooperative launch failed: %s\n", hipGetErrorString(e)); }
#else
#if DIAG
    (void)hipMemsetAsync((unsigned char*)d_ws + WS_DIAG, 0, 256, stream);
#endif
    for (int p = 0; p < NPHASES; ++p) {
        a.ph_lo = p; a.ph_hi = p + 1;
        void* kargs[] = {&a}; hipError_t e = hipLaunchCooperativeKernel((const void*)hyb_fwd, dim3(grid), dim3(NTHREADS), kargs, LDS_BYTES, stream);
        if (e != hipSuccess) { fprintf(stderr, "launch %d failed: %s\n", p, hipGetErrorString(e)); break; }
#if DIAG
        if (p == 0) hipLaunchKernelGGL(diag_kernel, dim3(8), dim3(64), 0, stream, a, 0, 512);
        if (p == 1) hipLaunchKernelGGL(diag_kernel, dim3(4), dim3(64), 0, stream, a, 1, 256);
        if (p == 2) hipLaunchKernelGGL(diag_kernel, dim3(64), dim3(64), 0, stream, a, 2, 4096);
        if (p == 3) hipLaunchKernelGGL(diag_kernel, dim3(4), dim3(64), 0, stream, a, 7, 256);
        if (p == 4) { hipLaunchKernelGGL(diag_kernel, dim3(8), dim3(64), 0, stream, a, 3, 512); hipLaunchKernelGGL(diag_kernel, dim3(4), dim3(64), 0, stream, a, 10, 256); }
        if (p == 6) hipLaunchKernelGGL(diag_kernel, dim3(32), dim3(64), 0, stream, a, 4, 2048);
        if (p == 7) hipLaunchKernelGGL(diag_kernel, dim3(32), dim3(64), 0, stream, a, 5, 2048);
        if (p == 8) hipLaunchKernelGGL(diag_kernel, dim3(4), dim3(64), 0, stream, a, 6, 256);
#endif
    }
#if DIAG
    hipLaunchKernelGGL(diag_final, dim3(4096), dim3(256), 0, stream, a, 7);
#endif
#endif
}
```
